# Optimizing an MI355X kernel written in HIP

```python
import math
import jax, jax.numpy as jnp
from jax import lax
import numpy as np

D_MODEL = 1024
BATCH = 16
SEQ = 2048
DEPTH = 2

MEM_LEN = 256
N_MOBA_LAYERS = (DEPTH + 1) // 2
N_SSD_LAYERS = DEPTH // 2

MOBA_HEADS = 12
MOBA_HD = 128
MOBA_WIDTH = MOBA_HEADS * MOBA_HD
MOBA_BLOCK = 256
MOBA_TOPK = 3
MOBA_QCHUNK = 128

REL_BUCKETS = 32
REL_MAX_DIST = 128

MEM_HEADS = 4
MEM_HD = 128
MEM_WIDTH = MEM_HEADS * MEM_HD

SSD_HEADS = 24
SSD_HD = 64
SSD_INNER = SSD_HEADS * SSD_HD
SSD_GROUPS = 4
SSD_STATE = 128
SSD_CONV = 4
SSD_CHUNK = 128
SSD_CONV_DIM = SSD_INNER + 2 * SSD_GROUPS * SSD_STATE

MIX_WIDTH = MOBA_WIDTH + MEM_WIDTH
IN_MOBA = 3 * MOBA_WIDTH + MEM_WIDTH
IN_SSD = SSD_INNER + SSD_CONV_DIM + SSD_HEADS + MEM_WIDTH

D_FF = 3584
N_EXPERTS = 8
TOP_K = 2
EXP_CHUNK = 256

EPS = 1e-6

kernel_name = 'hybrid_moba_ssd_moe_block'


def rms_norm(x, g):
    xf = x.astype(jnp.float32)
    y = xf * lax.rsqrt(jnp.mean(xf * xf, axis=-1, keepdims=True) + EPS)
    return (y * g.astype(jnp.float32)).astype(x.dtype)


def t5_bucket(dist):
    n = jnp.maximum(dist, 0)
    max_exact = REL_BUCKETS // 2
    large = max_exact + (jnp.log(jnp.maximum(n, 1).astype(jnp.float32) / max_exact)
                         / math.log(REL_MAX_DIST / max_exact)
                         * (REL_BUCKETS - max_exact)).astype(jnp.int32)
    large = jnp.minimum(large, REL_BUCKETS - 1)
    return jnp.where(n < max_exact, n, large)


def bucket_layout(ids, valid, n_buckets, chunk, n_buf):
    n_items = ids.shape[0]
    oh = ((ids[:, None] == jnp.arange(n_buckets)[None, :]) & valid[:, None]).astype(jnp.int32)
    counts = oh.sum(axis=0)
    rank = jnp.take_along_axis(jnp.cumsum(oh, axis=0) - oh, ids[:, None], axis=1)[:, 0]
    padded = (counts + chunk - 1) // chunk * chunk
    ends = jnp.cumsum(padded)
    starts = ends - padded
    dest = jnp.where(valid, starts[ids] + rank, n_buf)
    src = jnp.full((n_buf,), n_items, jnp.int32).at[dest].set(jnp.arange(n_items, dtype=jnp.int32), mode='drop')
    chunk_start = jnp.arange(n_buf // chunk) * chunk
    chunk_ids = jnp.minimum(jnp.sum(chunk_start[:, None] >= ends[None, :], axis=1), n_buckets - 1)
    return dest, src, chunk_ids


def moba_head(q, k, v, bias_h):
    s_pad = q.shape[0]
    nb = s_pad // MOBA_BLOCK
    n_sel = min(MOBA_TOPK, nb - 1)
    scale = MOBA_HD ** -0.5
    qb = q.reshape(nb, MOBA_BLOCK, MOBA_HD)
    kb = k.reshape(nb, MOBA_BLOCK, MOBA_HD)
    vb = v.reshape(nb, MOBA_BLOCK, MOBA_HD)
    loc = jnp.arange(MOBA_BLOCK)
    dist_self = loc[:, None] - loc[None, :]
    s_self = jnp.einsum('nqd,nkd->nqk', qb, kb).astype(jnp.float32) * scale + bias_h[t5_bucket(dist_self)]
    s_self = jnp.where(dist_self >= 0, s_self, -jnp.inf)
    lse_self = jax.nn.logsumexp(s_self, axis=-1)
    o_self = jnp.einsum('nqk,nkd->nqd', jnp.exp(s_self - lse_self[..., None]).astype(v.dtype), vb)
    o_self = o_self.reshape(s_pad, MOBA_HD)
    if n_sel == 0:
        return o_self
    lse_self = lse_self.reshape(s_pad)
    pos = jnp.arange(s_pad)
    k_mean = kb.mean(axis=1)
    gate = (q @ k_mean.T).astype(jnp.float32)
    past = jnp.arange(nb)[None, :] < (pos // MOBA_BLOCK)[:, None]
    gate = jnp.where(past, gate, -jnp.inf)
    top_s, top_i = lax.top_k(gate, n_sel)
    valid = jnp.isfinite(top_s).reshape(-1)
    ids = top_i.reshape(-1).astype(jnp.int32)
    pair_q = jnp.repeat(pos, n_sel).astype(jnp.int32)
    n_buf = s_pad * n_sel + nb * MOBA_QCHUNK
    n_ch = n_buf // MOBA_QCHUNK
    dest, src, cid = bucket_layout(ids, valid, nb, MOBA_QCHUNK, n_buf)
    buf_q = jnp.concatenate([pair_q, jnp.zeros((1,), jnp.int32)])[src]
    qg = q[buf_q].reshape(n_ch, MOBA_QCHUNK, MOBA_HD)
    kg = kb[cid]
    vg = vb[cid]
    kpos = cid[:, None] * MOBA_BLOCK + loc[None, :]
    dist = buf_q.reshape(n_ch, MOBA_QCHUNK)[:, :, None] - kpos[:, None, :]
    s_r = jnp.einsum('cqd,ckd->cqk', qg, kg).astype(jnp.float32) * scale + bias_h[t5_bucket(dist)]
    lse_r = jax.nn.logsumexp(s_r, axis=-1)
    o_r = jnp.einsum('cqk,ckd->cqd', jnp.exp(s_r - lse_r[..., None]).astype(v.dtype), vg)
    o_r = o_r.reshape(n_buf, MOBA_HD)
    take = jnp.minimum(dest, n_buf - 1)
    o_pair = o_r[take].reshape(s_pad, n_sel, MOBA_HD)
    lse_pair = jnp.where(valid, lse_r.reshape(n_buf)[take], -jnp.inf).reshape(s_pad, n_sel)
    w = jax.nn.softmax(jnp.concatenate([lse_self[:, None], lse_pair], axis=1), axis=-1)
    o_all = jnp.concatenate([o_self[:, None], o_pair], axis=1)
    return jnp.einsum('sj,sjd->sd', w.astype(o_all.dtype), o_all)


def moba_attention(qkv, rel_bias):
    bsz, s, _ = qkv.shape
    s_pad = -(-s // MOBA_BLOCK) * MOBA_BLOCK
    q, k, v = jnp.split(qkv, 3, axis=-1)

    def to_heads(t):
        t = t.reshape(bsz, s, MOBA_HEADS, MOBA_HD).transpose(0, 2, 1, 3)
        return jnp.pad(t, ((0, 0), (0, 0), (0, s_pad - s), (0, 0)))

    q, k, v = to_heads(q), to_heads(k), to_heads(v)
    bias_heads = rel_bias.T
    per_head = jax.vmap(moba_head, in_axes=(0, 0, 0, 0))

    def per_batch(args):
        qb, kb, vb = args
        return per_head(qb, kb, vb, bias_heads)

    o = lax.map(per_batch, (q, k, v))
    return o[:, :, :s].transpose(0, 2, 1, 3).reshape(bsz, s, MOBA_WIDTH)


def memory_cross_attention(q, mem_n, w_kv):
    bsz, s, _ = q.shape
    kv = mem_n @ w_kv
    k, v = jnp.split(kv, 2, axis=-1)
    q = q.reshape(bsz, s, MEM_HEADS, MEM_HD)
    k = k.reshape(bsz, -1, MEM_HEADS, MEM_HD)
    v = v.reshape(bsz, -1, MEM_HEADS, MEM_HD)
    sc = jnp.einsum('bshd,bmhd->bhsm', q, k).astype(jnp.float32) * (MEM_HD ** -0.5)
    p = jax.nn.softmax(sc, axis=-1).astype(v.dtype)
    return jnp.einsum('bhsm,bmhd->bshd', p, v).reshape(bsz, s, MEM_WIDTH)


def causal_dwconv(x, w, b):
    ksz = w.shape[0]
    y = lax.conv_general_dilated(x, w[:, None, :].astype(x.dtype), window_strides=(1,),
                                 padding=[(ksz - 1, 0)], dimension_numbers=('NWC', 'WIO', 'NWC'),
                                 feature_group_count=x.shape[-1])
    return y + b.astype(x.dtype)


def ssd_scan(x, dt, a, b_in, c_in):
    bsz, s = x.shape[0], x.shape[1]
    s_pad = -(-s // SSD_CHUNK) * SSD_CHUNK

    def pad(t):
        return jnp.pad(t, ((0, 0), (0, s_pad - s)) + ((0, 0),) * (t.ndim - 2))

    x, dt, b_in, c_in = pad(x), pad(dt), pad(b_in), pad(c_in)
    nc = s_pad // SSD_CHUNK
    e = SSD_HEADS // SSD_GROUPS
    xdt = (x * dt[..., None]).reshape(bsz, nc, SSD_CHUNK, SSD_GROUPS, e, SSD_HD)
    la = (dt * a).reshape(bsz, nc, SSD_CHUNK, SSD_GROUPS, e)
    la_cs = jnp.cumsum(la, axis=2)
    bc = b_in.reshape(bsz, nc, SSD_CHUNK, SSD_GROUPS, SSD_STATE)
    cc = c_in.reshape(bsz, nc, SSD_CHUNK, SSD_GROUPS, SSD_STATE)
    causal = (jnp.arange(SSD_CHUNK)[:, None] >= jnp.arange(SSD_CHUNK)[None, :])[None, None, :, :, None, None]
    decay = jnp.exp(jnp.where(causal, la_cs[:, :, :, None] - la_cs[:, :, None], -jnp.inf))
    scores = jnp.einsum('bclgn,bcsgn->bclsg', cc, bc)[..., None] * decay
    y_diag = jnp.einsum('bclsge,bcsgep->bclgep', scores, xdt)
    decay_to_end = jnp.exp(la_cs[:, :, -1:] - la_cs)
    states = jnp.einsum('bclgn,bclge,bclgep->bcgepn', bc, decay_to_end, xdt)
    chunk_decay = jnp.exp(la_cs[:, :, -1])

    def step(h, inp):
        st, dec = inp
        return dec[..., None, None] * h + st, h

    h0 = jnp.zeros((bsz, SSD_GROUPS, e, SSD_HD, SSD_STATE), jnp.float32)
    _, h_prev = lax.scan(step, h0, (states.transpose(1, 0, 2, 3, 4, 5), chunk_decay.transpose(1, 0, 2, 3)))
    h_prev = h_prev.transpose(1, 0, 2, 3, 4, 5)
    y_off = jnp.einsum('bclgn,bcgepn,bclge->bclgep', cc, h_prev, jnp.exp(la_cs))
    y = (y_diag + y_off).reshape(bsz, s_pad, SSD_HEADS, SSD_HD)
    return y[:, :s]


def ssd_mixer(zxbcdt, conv_w, conv_b, dt_bias, a_log, d_skip, g_out):
    bsz, s, _ = zxbcdt.shape
    z = zxbcdt[..., :SSD_INNER]
    xbc = zxbcdt[..., SSD_INNER:SSD_INNER + SSD_CONV_DIM]
    dt_raw = zxbcdt[..., SSD_INNER + SSD_CONV_DIM:]
    xbc = jax.nn.silu(causal_dwconv(xbc, conv_w, conv_b)).astype(jnp.float32)
    xs = xbc[..., :SSD_INNER]
    b_in = xbc[..., SSD_INNER:SSD_INNER + SSD_GROUPS * SSD_STATE].reshape(bsz, s, SSD_GROUPS, SSD_STATE)
    c_in = xbc[..., SSD_INNER + SSD_GROUPS * SSD_STATE:].reshape(bsz, s, SSD_GROUPS, SSD_STATE)
    dt = jax.nn.softplus(dt_raw.astype(jnp.float32) + dt_bias.astype(jnp.float32))
    a = -jnp.exp(a_log.astype(jnp.float32))
    xh = xs.reshape(bsz, s, SSD_HEADS, SSD_HD)
    y = ssd_scan(xh, dt, a, b_in, c_in) + xh * d_skip.astype(jnp.float32)[:, None]
    u = (y.reshape(bsz, s, SSD_INNER) * jax.nn.silu(z.astype(jnp.float32))).reshape(bsz, s, SSD_GROUPS, -1)
    u = u * lax.rsqrt(jnp.mean(u * u, axis=-1, keepdims=True) + EPS)
    return (u.reshape(bsz, s, SSD_INNER) * g_out.astype(jnp.float32)).astype(zxbcdt.dtype)


def swiglu(h, w_gate, w_up, w_down):
    return (jax.nn.silu(h @ w_gate) * (h @ w_up)) @ w_down


def moe_swiglu(h, w_router, b_router, w_gate, w_up, w_down):
    bsz, s, d = h.shape
    n_tok = bsz * s
    xf = h.reshape(n_tok, d)
    logits = (xf @ w_router).astype(jnp.float32) + b_router.astype(jnp.float32)
    top_l, top_e = lax.top_k(logits, TOP_K)
    gates = jax.nn.softmax(top_l, axis=-1)
    ids = top_e.reshape(-1).astype(jnp.int32)
    tok = jnp.repeat(jnp.arange(n_tok, dtype=jnp.int32), TOP_K)
    n_buf = n_tok * TOP_K + N_EXPERTS * EXP_CHUNK
    dest, src, cid = bucket_layout(ids, jnp.ones_like(ids, dtype=bool), N_EXPERTS, EXP_CHUNK, n_buf)
    buf_tok = jnp.concatenate([tok, jnp.zeros((1,), jnp.int32)])[src]
    xb = xf[buf_tok].reshape(n_buf // EXP_CHUNK, EXP_CHUNK, d)

    def expert_chunk(args):
        xc, e = args
        return (jax.nn.silu(xc @ w_gate[e]) * (xc @ w_up[e])) @ w_down[e]

    yb = lax.map(expert_chunk, (xb, cid)).reshape(n_buf, d)
    y_pair = yb[dest].reshape(n_tok, TOP_K, d)
    y = jnp.einsum('tk,tkd->td', gates.astype(y_pair.dtype), y_pair)
    return y.reshape(bsz, s, d)


def setup_inputs(seed: int = 0) -> dict:
    key = jax.random.key(seed)
    ks = iter(jax.random.split(key, 32))
    f32 = jnp.float32

    def nrm(shape, scale):
        return jax.random.normal(next(ks), shape, f32) * scale

    def gain(shape):
        return jnp.ones(shape, f32) + nrm(shape, 0.02)

    dt0 = jnp.exp(jax.random.uniform(next(ks), (N_SSD_LAYERS, SSD_HEADS), f32)
                  * (math.log(0.1) - math.log(0.001)) + math.log(0.001))
    return {
        'x': nrm((BATCH, SEQ, D_MODEL), 1.0),
        'mem': nrm((BATCH, MEM_LEN, D_MODEL), 1.0),
        'g_mix': gain((DEPTH, D_MODEL)),
        'g_mem': gain((DEPTH, D_MODEL)),
        'w_in_moba': nrm((N_MOBA_LAYERS, D_MODEL, IN_MOBA), D_MODEL ** -0.5),
        'w_in_ssd': nrm((N_SSD_LAYERS, D_MODEL, IN_SSD), D_MODEL ** -0.5),
        'w_mem_kv': nrm((DEPTH, D_MODEL, 2 * MEM_WIDTH), D_MODEL ** -0.5),
        'w_out': nrm((DEPTH, MIX_WIDTH, D_MODEL), MIX_WIDTH ** -0.5),
        'rel_bias': nrm((REL_BUCKETS, MOBA_HEADS), 0.2),
        'conv_w': nrm((N_SSD_LAYERS, SSD_CONV, SSD_CONV_DIM), SSD_CONV ** -0.5),
        'conv_b': nrm((N_SSD_LAYERS, SSD_CONV_DIM), 0.02),
        'dt_bias': dt0 + jnp.log(-jnp.expm1(-dt0)),
        'a_log': jnp.log(jax.random.uniform(next(ks), (N_SSD_LAYERS, SSD_HEADS), f32, 1.0, 16.0)),
        'd_skip': jnp.ones((N_SSD_LAYERS, SSD_HEADS), f32) + nrm((N_SSD_LAYERS, SSD_HEADS), 0.1),
        'g_ssd_out': gain((N_SSD_LAYERS, SSD_INNER)),
        'g_ffn': gain((DEPTH, D_MODEL)),
        'w_ffn_gate': nrm((N_MOBA_LAYERS, D_MODEL, D_FF), D_MODEL ** -0.5),
        'w_ffn_up': nrm((N_MOBA_LAYERS, D_MODEL, D_FF), D_MODEL ** -0.5),
        'w_ffn_down': nrm((N_MOBA_LAYERS, D_FF, D_MODEL), D_FF ** -0.5),
        'w_router': nrm((N_SSD_LAYERS, D_MODEL, N_EXPERTS), D_MODEL ** -0.5),
        'b_router': nrm((N_SSD_LAYERS, N_EXPERTS), 0.01),
        'w_exp_gate': nrm((N_SSD_LAYERS, N_EXPERTS, D_MODEL, D_FF), D_MODEL ** -0.5),
        'w_exp_up': nrm((N_SSD_LAYERS, N_EXPERTS, D_MODEL, D_FF), D_MODEL ** -0.5),
        'w_exp_down': nrm((N_SSD_LAYERS, N_EXPERTS, D_FF, D_MODEL), D_FF ** -0.5),
        'g_final': gain((D_MODEL,)),
    }


def reference(x, mem, g_mix, g_mem, w_in_moba, w_in_ssd, w_mem_kv, w_out, rel_bias, conv_w, conv_b,
              dt_bias, a_log, d_skip, g_ssd_out, g_ffn, w_ffn_gate, w_ffn_up, w_ffn_down, w_router,
              b_router, w_exp_gate, w_exp_up, w_exp_down, g_final):
    for i in range(DEPTH):
        j = i // 2
        h = rms_norm(x, g_mix[i])
        mem_n = rms_norm(mem, g_mem[i])
        if i % 2 == 0:
            proj = h @ w_in_moba[j]
            y_tok = moba_attention(proj[..., :3 * MOBA_WIDTH], rel_bias)
            q_mem = proj[..., 3 * MOBA_WIDTH:]
        else:
            proj = h @ w_in_ssd[j]
            y_tok = ssd_mixer(proj[..., :IN_SSD - MEM_WIDTH], conv_w[j], conv_b[j], dt_bias[j],
                              a_log[j], d_skip[j], g_ssd_out[j])
            q_mem = proj[..., IN_SSD - MEM_WIDTH:]
        y_mem = memory_cross_attention(q_mem, mem_n, w_mem_kv[i])
        x = x + jnp.concatenate([y_tok, y_mem], axis=-1) @ w_out[i]
        h = rms_norm(x, g_ffn[i])
        if i % 2 == 0:
            x = x + swiglu(h, w_ffn_gate[j], w_ffn_up[j], w_ffn_down[j])
        else:
            x = x + moe_swiglu(h, w_router[j], b_router[j], w_exp_gate[j], w_exp_up[j], w_exp_down[j])
    return rms_norm(x, g_final)
```

```cpp
#include <hip/hip_runtime.h>
#include <cstdio>
#include <cstdint>

#define GAS __attribute__((address_space(1)))
#define LAS __attribute__((address_space(3)))
typedef unsigned short bf16;
typedef short bf16x8 __attribute__((ext_vector_type(8)));
typedef float f32x2 __attribute__((ext_vector_type(2)));
typedef float f32x4 __attribute__((ext_vector_type(4)));
typedef float f32x16 __attribute__((ext_vector_type(16)));
typedef unsigned u32x2 __attribute__((ext_vector_type(2)));
typedef unsigned u32x4 __attribute__((ext_vector_type(4)));
typedef int i32x4 __attribute__((ext_vector_type(4)));
typedef int i32x8 __attribute__((ext_vector_type(8)));
typedef __bf16 bf16x2_t __attribute__((ext_vector_type(2)));
typedef GAS unsigned gu32;

constexpr int D = 1024, BATCH = 16, SEQ = 2048, T = BATCH * SEQ;
constexpr int MEM_LEN = 256, MROWS = BATCH * MEM_LEN;
constexpr int MOBA_H = 12, HD = 128, MOBA_W = 1536, NBLK = 8;
constexpr int MEM_H = 4, MEM_W = 512;
constexpr int SSD_H = 24, SSD_P = 64, SSD_IN = 1536, SSD_G = 4, SSD_N = 128, SSD_CH = 128, NCHUNK = SEQ / SSD_CH, CONV_DIM = 2560;
constexpr int IN_MOBA = 5120, IN_SSD = 4632, MIXW = 2048, FF = 3584, NEXP = 8;
constexpr int P0W = 3584;
constexpr int P1W = 4864;
constexpr int P1_XBC = 2048, P1_DT = 4608;
constexpr float EPS = 1e-6f;
constexpr float LOG2E = 1.4426950408889634f;
constexpr int MOE_CAP = T;
constexpr int MOE_MAXP = 272;

constexpr size_t MiB = 1u << 20;
constexpr size_t WS_CTL = 0, WS_KMEAN = 1 * MiB, ZERO_BYTES = 2 * MiB;
constexpr size_t WS_SS = 2 * MiB;
constexpr size_t WS_MEMSS = 4 * MiB;
constexpr size_t WS_GW = 5 * MiB;
constexpr size_t WS_LIST = 6 * MiB;
constexpr size_t WS_CDEC = 8 * MiB;
constexpr size_t WS_WM1 = 9 * MiB;
constexpr size_t WS_WV = 16 * MiB;
constexpr size_t WS_WS = 19 * MiB;
constexpr size_t WS_WMK = 29 * MiB;
constexpr size_t WS_WMV = 31 * MiB;
constexpr size_t WS_WO = 33 * MiB;
constexpr size_t WS_WGU = 41 * MiB;
constexpr size_t WS_WD = 55 * MiB;
constexpr size_t WS_MEMB = 62 * MiB;
constexpr size_t WS_KMEM = 70 * MiB;
constexpr size_t WS_VMEMT = 78 * MiB;
constexpr size_t WS_XB = 86 * MiB;
constexpr size_t WS_BIG = 150 * MiB;
constexpr size_t WS_PROJ = WS_BIG;
constexpr size_t WS_VT = 374 * MiB;
constexpr size_t WS_ACT = WS_BIG;
constexpr size_t WS_STATES = 454 * MiB;
constexpr size_t WS_ACTM = WS_BIG;
constexpr size_t WS_WED = 388 * MiB;
constexpr size_t WS_WEGU = 416 * MiB;
constexpr size_t WS_XB8 = 472 * MiB;
constexpr size_t WS_YP0 = 416 * MiB;
constexpr size_t WS_YP1 = 480 * MiB;
constexpr size_t WS_RSG = 544 * MiB;
constexpr size_t WS_END = 555 * MiB;
static_assert(WS_PROJ + (size_t)T * P0W * 2 <= WS_VT && WS_VT + (size_t)MOBA_W * T * 2 <= 470 * MiB, "layer 0 map");
static_assert(WS_PROJ + (size_t)T * P1W * 2 <= WS_STATES && WS_STATES + (size_t)BATCH * NCHUNK * SSD_H * SSD_P * SSD_N * 2 <= 550 * MiB, "layer 1 map");
static_assert(WS_ACTM + (size_t)MOE_MAXP * 256 * FF <= WS_WED && WS_WED + (size_t)NEXP * 1024 * FF <= WS_WEGU && WS_WEGU + (size_t)NEXP * 7168 * 1024 <= WS_XB8 && WS_XB8 + (size_t)T * D <= WS_RSG && WS_YP0 + (size_t)T * D * 2 <= WS_YP1 && WS_YP1 + (size_t)T * D * 2 <= WS_RSG && WS_RSG + (size_t)T * 4 <= WS_END && WS_XB8 >= WS_PROJ + (size_t)T * P1W * 2, "moe map");
constexpr int CW_BAR = 4096;
constexpr int CW_CNT = 16384;

constexpr int RING_BYTES = 131072;
constexpr int MISC_OFF = RING_BYTES;
constexpr int PAN_OFF = RING_BYTES + 1024;
constexpr int ROWTAB_OFF = RING_BYTES + 3072;
constexpr int LDS_BYTES = ROWTAB_OFF + 16 * 1024 + 4096;
constexpr int NWAVES = 8, NTHR = 512;

__device__ __forceinline__ unsigned pk2(float lo, float hi) { f32x2 v = {lo, hi}; bf16x2_t b = __builtin_convertvector(v, bf16x2_t); return __builtin_bit_cast(unsigned, b); }
__device__ __forceinline__ float bf2f(unsigned short b) { return __uint_as_float(((unsigned)b) << 16); }
__device__ __forceinline__ float bflo(unsigned w) { return __uint_as_float(w << 16); }
__device__ __forceinline__ float bfhi(unsigned w) { return __uint_as_float(w & 0xffff0000u); }
__device__ __forceinline__ float fast_exp2(float x) { return __builtin_amdgcn_exp2f(x); }
__device__ __forceinline__ float fast_rcp(float x) { return __builtin_amdgcn_rcpf(x); }
__device__ __forceinline__ float silu_f(float x) { return x * fast_rcp(1.0f + fast_exp2(-x * LOG2E)); }
__device__ __forceinline__ float wave_sum(float v) {
#pragma unroll
    for (int o = 1; o < 64; o <<= 1) v += __shfl_xor(v, o);
    return v;
}
__device__ __forceinline__ int opaque_tid(int wv) { int l = __builtin_amdgcn_mbcnt_hi(~0u, __builtin_amdgcn_mbcnt_lo(~0u, 0u)); asm volatile("" : "+v"(l)); return wv * 64 + l; }
struct Args { const float* in[25]; float* out; unsigned char* ws; int ph_lo, ph_hi; };
static_assert(sizeof(Args) == 25 * 8 + 8 + 8 + 8, "Args has no padding");

typedef const __attribute__((address_space(4))) Args* kargs_t;
__device__ __forceinline__ kargs_t kargs() { kargs_t p = (kargs_t)__builtin_amdgcn_kernarg_segment_ptr(); asm volatile("" : "+s"(p)); return p; }
#define LDS_WAIT() asm volatile("s_waitcnt lgkmcnt(0)" ::: "memory")
#define VM_WAIT() asm volatile("s_waitcnt vmcnt(0)" ::: "memory")
#define MFMA32(a, b, c) __builtin_amdgcn_mfma_f32_32x32x16_bf16((a), (b), (c), 0, 0, 0)

#define XB_TMO      128
#define XB_XCNT(j)  (256  + 64 * (j))
#define XB_XSUB(j)  (1280 + 64 * (j))
#define XB_XGEN(j)  (2304 + 64 * (j))
#define XB_TOP      3328
#define XB_TOPGEN   3392
#define XCD_BAR_WORDS 3456
#define XB_SPIN_CAP (1u << 18)

__device__ __forceinline__ unsigned xb_ld(unsigned* p)              { return __hip_atomic_load(p, __ATOMIC_RELAXED, __HIP_MEMORY_SCOPE_AGENT); }
__device__ __forceinline__ unsigned xb_add(unsigned* p, unsigned v) { return __hip_atomic_fetch_add(p, v, __ATOMIC_RELAXED, __HIP_MEMORY_SCOPE_AGENT); }
__device__ __forceinline__ unsigned xb_xcc_id() { return (unsigned)__builtin_amdgcn_s_getreg((3 << 11) | 20) & 0xFu; }
#define XB_SPIN(cond, bar) do { unsigned _sp = 0; while (cond) { __builtin_amdgcn_s_sleep(1); \
    if ((++_sp & 255u) == 0u) { if (xb_ld(&(bar)[XB_TMO])) break; if (_sp > XB_SPIN_CAP) { atomicAdd(&(bar)[XB_TMO], 1u); break; } } } } while (0)

struct XcdBarrier {
    unsigned* bar; unsigned x;
    volatile LAS unsigned* st;
};

__device__ __forceinline__ XcdBarrier xcd_barrier_post(unsigned* bar, volatile LAS unsigned* st) {
    XcdBarrier b; b.bar = bar; b.x = xb_xcc_id(); b.st = st;
    if (threadIdx.x == 0) (void)xb_add(&bar[XB_XCNT(b.x)], 1u);
    return b;
}
__device__ __forceinline__ void xcd_barrier_complete(unsigned* bar, unsigned x, unsigned& nloc, unsigned& nx) {
    const unsigned G = gridDim.x * gridDim.y * gridDim.z;
    unsigned sum, cnt, mine, sp = 0u;
    for (;;) {
        sum = 0u; cnt = 0u; mine = 0u;
#pragma unroll
        for (unsigned j = 0; j < 16; ++j) { const unsigned c = xb_ld(&bar[XB_XCNT(j)]); sum += c; cnt += (c > 0u) ? 1u : 0u; mine = (j == x) ? c : mine; }
        if (sum == G) break;
        __builtin_amdgcn_s_sleep(1);
        if ((++sp & 255u) == 0u) { if (xb_ld(&bar[XB_TMO])) break; if (sp > XB_SPIN_CAP) { atomicAdd(&bar[XB_TMO], 1u); break; } }
    }
    nloc = mine > 0u ? mine : 1u; nx = cnt > 0u ? cnt : 1u;
}

__device__ __forceinline__ void xcd_barrier(const XcdBarrier& b) {
    asm volatile("s_waitcnt vmcnt(0)" ::: "memory");
    __syncthreads();
    if (threadIdx.x == 0) {
        unsigned* bar = b.bar;
        __builtin_amdgcn_s_waitcnt(0);
        unsigned nloc = b.st[0], nx = b.st[1];
        if (nloc == 0u) { xcd_barrier_complete(bar, b.x, nloc, nx); b.st[0] = nloc; b.st[1] = nx; }
        const unsigned old = xb_add(&bar[XB_XSUB(b.x)], 1u);
        const unsigned gen = old / nloc;
        if (old + 1u == (gen + 1u) * nloc) {
            __builtin_amdgcn_fence(__ATOMIC_RELEASE, "agent");
            asm volatile("s_waitcnt vmcnt(0)" ::: "memory");
            const unsigned og = xb_add(&bar[XB_TOP], 1u);
            const unsigned tg = og / nx;
            if (og + 1u == (tg + 1u) * nx) xb_add(&bar[XB_TOPGEN], 1u);
            else XB_SPIN(xb_ld(&bar[XB_TOPGEN]) == tg, bar);
            __builtin_amdgcn_fence(__ATOMIC_ACQUIRE, "agent");
            xb_add(&bar[XB_XGEN(b.x)], 1u);
            asm volatile("s_waitcnt vmcnt(0)" ::: "memory");
        } else {
            XB_SPIN(xb_ld(&bar[XB_XGEN(b.x)]) == gen, bar);
            __builtin_amdgcn_fence(__ATOMIC_ACQUIRE, "agent");
            asm volatile("s_waitcnt vmcnt(0)" ::: "memory");
        }
    }
    __syncthreads();
}


namespace pg8 {
constexpr int BM = 256, BK = 64, HALF = 128, HTB = HALF * BK * 2, STAGE_BYTES = 8 * HTB, NXCD = 8, WGM = 8;
__host__ __device__ __forceinline__ int lds_byte(int r, int c) { const int st = (r >> 4) * 2 + (c >> 5), rr = r & 15, cc = c & 31, ob = rr * 64 + cc * 2; return st * 1024 + (ob ^ (((ob >> 9) & 1) << 5)); }
__host__ __device__ __forceinline__ void stage_rc(int b, int& R, int& C) { const int st = b / 1024, sb = b % 1024, swz = sb ^ (((sb >> 9) & 1) << 5); R = (st >> 1) * 16 + swz / 64; C = (st & 1) * 32 + (swz % 64) / 2; }
__host__ __device__ __forceinline__ int perm32(int rho) { const int n = rho >> 4, i = rho & 15; return 8 * (i >> 2) + 4 * n + (i & 3); }

struct Unit { int pm, pn, ui, kt0, nkt, ti; };
struct Gemm { const bf16* A; const bf16* Bt; int lda, K; };

struct StaticOrder {
    int nM, nN, nwg, G, c;
    __device__ __forceinline__ void init(int nM_, int nN_, int G_, int c_) { nM = nM_; nN = nN_; nwg = nM * nN; G = G_; c = c_; }
    __device__ __forceinline__ void decode(int wgid, Unit& u) const {
        { const int q = nwg / NXCD, r = nwg % NXCD, xcd = wgid % NXCD, off = wgid / NXCD; wgid = (xcd < r ? xcd * (q + 1) : r * (q + 1) + (xcd - r) * q) + off; }
        const int nig = WGM * nN, gid = wgid / nig, fm = gid * WGM, gsz = (nM - fm) < WGM ? (nM - fm) : WGM;
        u.pm = fm + ((wgid % nig) % gsz); u.pn = (wgid % nig) / gsz;
    }
    __device__ __forceinline__ bool next(int i, Unit& u) const {
        const int L = i * G + c; if (L >= nwg) return false;
        decode(L, u); u.ui = i; u.kt0 = 0; u.nkt = 0; u.ti = -1; return true;
    }
};

template <class Epi, class Sched, bool GATHER, bool KSPLIT = false, int ESZ = 2>
__device__ __forceinline__ void gemm_phase(LAS unsigned char* lds, const Gemm g, const Sched& S, const Epi& E, const LAS unsigned short* rowtab, int wv) {
    const int tid = opaque_tid(wv), wid = wv, lane = tid & 63, wr = wid >> 2, wc = wid & 3, fr = lane & 15, fq = lane >> 4;
    const int K = g.K, nt = K * ESZ / 128, lda = g.lda;
    unsigned voffB[2];
    unsigned vA00, vA01, vA10, vA11;
#pragma unroll
    for (int i = 0; i < 2; ++i) { int R, C; stage_rc(tid * 16 + i * 8192, R, C); const int Rb = Epi::PERM ? ((R & ~31) + perm32(R & 31)) : R;
        voffB[i] = (unsigned)(Rb * K * ESZ + C * 2); }
#define PG8_RC() int RA0, CA0, RA1, CA1; { int t_ = tid; asm volatile("" : "+v"(t_)); stage_rc(t_ * 16, RA0, CA0); stage_rc(t_ * 16 + 8192, RA1, CA1); }
    const size_t kstep = (size_t)(BK * 2);
    const size_t hstepB = (size_t)HALF * K * ESZ, tstepB = 2 * hstepB;
    const size_t tstepA = (size_t)BM * lda * ESZ;
    const size_t hA = GATHER ? 0 : (size_t)HALF * lda * ESZ;
    const unsigned ldsw = (unsigned)wid * 1024u;
    const int aoff = lds_byte(wr * 64 + fr, fq * 8), boff = lds_byte(wc * 32 + fr, fq * 8);
#define PG8_SA(b, h) (((b) * 2 + (h)) * HTB)
#define PG8_SB(b, h) ((4 + (b) * 2 + (h)) * HTB)
#define PG8_GLDS(gptr, ldsoff) __builtin_amdgcn_global_load_lds((const unsigned*)(gptr), (LAS unsigned*)(lds + (ldsoff)), 16, 0, 0)
#define PG8_GLDS_S(gbase, voff, ldsoff) do { unsigned keep_; asm volatile("s_mov_b32 %0, m0\n\ts_mov_b32 m0, %3\n\ts_nop 0\n\tglobal_load_lds_dwordx4 %1, %2\n\ts_mov_b32 m0, %0" \
        : "=&s"(keep_) : "v"(voff), "s"(gbase), "s"((unsigned)(size_t)(lds + (ldsoff))) : "memory"); } while (0)
#define PG8_STAGE_B(bufoff, gbase) do { if constexpr (ESZ == 1) { PG8_GLDS_S((const char*)(gbase), voffB[0], (bufoff) + ldsw); PG8_GLDS_S((const char*)(gbase) + (size_t)64 * K * ESZ, voffB[0], (bufoff) + ldsw + 8192); } \
        else { PG8_GLDS((const char*)(gbase) + voffB[0], (bufoff) + ldsw); PG8_GLDS((const char*)(gbase) + voffB[1], (bufoff) + ldsw + 8192); } } while (0)
#define PG8_STAGE_A(bufoff, gbase, v0, v1) do { if constexpr (ESZ == 1) { PG8_GLDS_S((const char*)(gbase), (v0), (bufoff) + ldsw); \
            if constexpr (GATHER) PG8_GLDS_S((const char*)(gbase), (v1), (bufoff) + ldsw + 8192); else PG8_GLDS_S((const char*)(gbase) + (size_t)64 * lda * ESZ, (v0), (bufoff) + ldsw + 8192); } \
        else { PG8_GLDS((const char*)(gbase) + (v0), (bufoff) + ldsw); PG8_GLDS((const char*)(gbase) + (v1), (bufoff) + ldsw + 8192); } } while (0)
#define PG8_STAGE_AG(bufoff, gbase, half, uix, v0, v1) do { if constexpr (GATHER) { const LAS unsigned short* q_ = rtp0 + (uix) * 256 + (half) * 128; int t0_ = q_[0], t1_ = q_[64]; \
            t0_ = t0_ == 0xFFFF ? 0 : t0_; t1_ = t1_ == 0xFFFF ? 0 : t1_;        \
            PG8_GLDS_S((const char*)(gbase), (unsigned)(t0_ * lda * ESZ) + cb2, (bufoff) + ldsw); PG8_GLDS_S((const char*)(gbase), (unsigned)(t1_ * lda * ESZ) + cb2, (bufoff) + ldsw + 8192); } \
        else PG8_STAGE_A(bufoff, (gbase) + ((half) ? hA : 0), v0, v1); } while (0)
#define PG8_LDA(dst, b, h) do { _Pragma("unroll") for (int m = 0; m < 4; ++m) { \
        if constexpr (ESZ == 2) { _Pragma("unroll") for (int k = 0; k < 2; ++k) dst[m][k] = *(const LAS bf16x8*)(lds + PG8_SA(b, h) + aoff + m * 2048 + k * 1024); } \
        else dst##8[m] = __builtin_shufflevector(*(const LAS i32x4*)(lds + PG8_SA(b, h) + aoff + m * 2048), *(const LAS i32x4*)(lds + PG8_SA(b, h) + aoff + m * 2048 + 1024), 0, 1, 2, 3, 4, 5, 6, 7); } } while (0)
#define PG8_LDB(dst, b, h) do { _Pragma("unroll") for (int n = 0; n < 2; ++n) { \
        if constexpr (ESZ == 2) { _Pragma("unroll") for (int k = 0; k < 2; ++k) dst[n][k] = *(const LAS bf16x8*)(lds + PG8_SB(b, h) + boff + n * 2048 + k * 1024); } \
        else dst##8[n] = __builtin_shufflevector(*(const LAS i32x4*)(lds + PG8_SB(b, h) + boff + n * 2048), *(const LAS i32x4*)(lds + PG8_SB(b, h) + boff + n * 2048 + 1024), 0, 1, 2, 3, 4, 5, 6, 7); } } while (0)
#define PG8_MMA(ai, bj, At, Bt) do { __builtin_amdgcn_s_setprio(1); _Pragma("unroll") for (int m = 0; m < 4; ++m) _Pragma("unroll") for (int n = 0; n < 2; ++n) { \
        if constexpr (ESZ == 2) { _Pragma("unroll") for (int k = 0; k < 2; ++k) acc[ai][bj][m][n] = __builtin_amdgcn_mfma_f32_16x16x32_bf16(Bt[n][k], At[m][k], acc[ai][bj][m][n], 0, 0, 0); } \
        else acc[ai][bj][m][n] = __builtin_amdgcn_mfma_scale_f32_16x16x128_f8f6f4(Bt##8[n], At##8[m], acc[ai][bj][m][n], 0, 0, 0, 0, 0, 0); } \
        __builtin_amdgcn_s_setprio(0); } while (0)
#define PG8_WAIT_V(n) asm volatile("s_waitcnt vmcnt(" #n ")" ::: "memory")
#define PG8_WAIT_L(n) asm volatile("s_waitcnt lgkmcnt(" #n ")" ::: "memory")
#define PG8_BAR __builtin_amdgcn_s_barrier()
#define PG8_SCHED __builtin_amdgcn_sched_barrier(0)
    Unit cur, nxt; int ui = 0;
    if (!S.next(0, cur)) return;
    f32x4 acc[2][2][4][2];
#pragma unroll
    for (int a = 0; a < 2; ++a)
#pragma unroll
        for (int b = 0; b < 2; ++b)
#pragma unroll
            for (int m = 0; m < 4; ++m)
#pragma unroll
                for (int n = 0; n < 2; ++n) acc[a][b][m][n] = (f32x4){0.f, 0.f, 0.f, 0.f};
    bf16x8 At[4][2], B0[2][2], B1[2][2];
    i32x8 At8[4], B08[2], B18[2];
    const char* cA; const char* cB = (const char*)g.Bt + (size_t)cur.pn * tstepB + (KSPLIT ? (size_t)cur.kt0 * kstep : 0);
    const LAS unsigned short* rtp0 = rowtab; unsigned cb2 = 0;
    if constexpr (GATHER) {
        static_assert(!GATHER || ESZ == 1, "gathered A rows: fp8 body only");
        cA = (const char*)g.A; PG8_RC();
        rtp0 = rowtab + RA0; cb2 = (unsigned)(CA0 * 2); vA00 = vA01 = vA10 = vA11 = 0;
    } else {
        cA = (const char*)g.A + (size_t)cur.pm * tstepA + (KSPLIT ? (size_t)cur.kt0 * kstep : 0); PG8_RC();
        vA00 = (unsigned)(RA0 * lda * ESZ + CA0 * 2); vA01 = (unsigned)(RA1 * lda * ESZ + CA1 * 2);
        vA10 = vA00; vA11 = vA01;
    }
    PG8_STAGE_B(PG8_SB(0, 0), cB); PG8_STAGE_B(PG8_SB(0, 1), cB + hstepB); PG8_STAGE_AG(PG8_SA(0, 0), cA, 0, cur.ui, vA00, vA01); PG8_STAGE_AG(PG8_SA(0, 1), cA, 1, cur.ui, vA10, vA11);
    if (wr == 1) PG8_BAR;
    PG8_WAIT_V(2); PG8_BAR;
    PG8_STAGE_B(PG8_SB(1, 0), cB + kstep); PG8_STAGE_AG(PG8_SA(1, 0), cA + kstep, 0, cur.ui, vA00, vA01); PG8_STAGE_B(PG8_SB(1, 1), cB + hstepB + kstep);
    PG8_WAIT_V(6); PG8_BAR;
    for (;;) {
        const bool has_next = S.next(ui + 1, nxt);
        const char* nA; const char* nB = has_next ? (const char*)g.Bt + (size_t)nxt.pn * tstepB + (KSPLIT ? (size_t)nxt.kt0 * kstep : 0) : cB;
        const int cnt = KSPLIT ? cur.nkt : nt;
        if constexpr (GATHER) {
            nA = cA;
        } else {
            nA = has_next ? (const char*)g.A + (size_t)nxt.pm * tstepA + (KSPLIT ? (size_t)nxt.kt0 * kstep : 0) : cA;
        }
        for (int t = 0; t < cnt; t += 2) {
            const bool last = (t == cnt - 2);
            const char* a1 = cA + (size_t)(t + 1) * kstep;
            const char* a2 = last ? nA : cA + (size_t)(t + 2) * kstep; const char* b2 = last ? nB : cB + (size_t)(t + 2) * kstep;
            const char* a3 = a2 + kstep; const char* b3 = b2 + kstep;
            unsigned w00 = vA00, w01 = vA01, w10 = vA10, w11 = vA11;
            const int uiN = (last && has_next) ? nxt.ui : cur.ui;
            PG8_LDB(B0, 0, 0); PG8_LDB(B1, 0, 1); PG8_SCHED; PG8_LDA(At, 0, 0); PG8_STAGE_AG(PG8_SA(1, 1), a1, 1, cur.ui, vA10, vA11);
            PG8_WAIT_V(8); PG8_WAIT_L(0); PG8_BAR; PG8_MMA(0, 0, At, B0); PG8_MMA(0, 1, At, B1); PG8_BAR; PG8_SCHED;
            PG8_LDA(At, 0, 1); PG8_STAGE_B(PG8_SB(0, 0), b2); PG8_STAGE_B(PG8_SB(0, 1), b2 + hstepB); PG8_STAGE_AG(PG8_SA(0, 0), a2, 0, uiN, w00, w01);
            PG8_WAIT_V(8); PG8_WAIT_L(0); PG8_BAR; PG8_MMA(1, 0, At, B0); PG8_MMA(1, 1, At, B1); PG8_BAR; PG8_SCHED;
            PG8_LDB(B0, 1, 0); PG8_LDB(B1, 1, 1); PG8_SCHED; PG8_LDA(At, 1, 0); PG8_STAGE_AG(PG8_SA(0, 1), a2, 1, uiN, w10, w11);
            PG8_WAIT_V(8); PG8_WAIT_L(0); PG8_BAR; PG8_MMA(0, 0, At, B0); PG8_MMA(0, 1, At, B1); PG8_BAR; PG8_SCHED;
            PG8_LDA(At, 1, 1); PG8_STAGE_B(PG8_SB(1, 0), b3); PG8_STAGE_B(PG8_SB(1, 1), b3 + hstepB); PG8_STAGE_AG(PG8_SA(1, 0), a3, 0, uiN, w00, w01);
            PG8_WAIT_V(8); PG8_WAIT_L(0); PG8_BAR; PG8_MMA(1, 0, At, B0); PG8_MMA(1, 1, At, B1); PG8_BAR; PG8_SCHED;
        }
        if (wr == 0) PG8_BAR;
        if constexpr (ESZ == 1) { const int l2_ = opaque_tid(wv) & 63; E(acc, cur, wr, wc, l2_ & 15, l2_ >> 4); }
        else E(acc, cur, wr, wc, fr, fq);
        if (!has_next) break;
#pragma unroll
        for (int a = 0; a < 2; ++a)
#pragma unroll
            for (int b = 0; b < 2; ++b)
#pragma unroll
                for (int m = 0; m < 4; ++m)
#pragma unroll
                    for (int n = 0; n < 2; ++n) acc[a][b][m][n] = (f32x4){0.f, 0.f, 0.f, 0.f};
        cur = nxt; cA = nA; cB = nB; ++ui;
        if (wr == 1) PG8_BAR;
    }
    PG8_WAIT_V(0);
    PG8_BAR;
#undef PG8_SA
#undef PG8_SB
#undef PG8_GLDS
#undef PG8_RC
#undef PG8_GLDS_S
#undef PG8_STAGE_A
#undef PG8_STAGE_AG
#undef PG8_STAGE_B
#undef PG8_LDA
#undef PG8_LDB
#undef PG8_MMA
#undef PG8_WAIT_V
#undef PG8_WAIT_L
#undef PG8_BAR
#undef PG8_SCHED
}
}

constexpr int MOE_NKT = FF / 128;
#ifndef MOE_NSLICE
#define MOE_NSLICE 7
#endif
using pg8::Unit;
__device__ __forceinline__ f32x4 row_ss_load(const float* SS, int row, int fq) { return *(const f32x4*)(SS + (unsigned)(row * 16 + 4 * fq)); }
__device__ __forceinline__ float row_rs_from(const f32x4 p) {
    float s = (p.x + p.y) + (p.z + p.w);
    s += __shfl_xor(s, 16); s += __shfl_xor(s, 32);
    return __builtin_amdgcn_rsqf(s + 1024.0f * EPS) * 32.0f;
}
constexpr float F8_SX = 8.f, F8_SW1 = 64.f, F8_SH = 4.f, F8_SW2 = 128.f;
template <bool CLAMP = false> __device__ __forceinline__ unsigned pk4_fp8(float a, float b, float c, float d) {
    if (CLAMP) { a = __builtin_amdgcn_fmed3f(a, -448.f, 448.f); b = __builtin_amdgcn_fmed3f(b, -448.f, 448.f); c = __builtin_amdgcn_fmed3f(c, -448.f, 448.f); d = __builtin_amdgcn_fmed3f(d, -448.f, 448.f); }
    int r = 0; r = __builtin_amdgcn_cvt_pk_fp8_f32(a, b, r, false); r = __builtin_amdgcn_cvt_pk_fp8_f32(c, d, r, true); return (unsigned)r; }
__device__ __forceinline__ u32x4 pack8(const f32x4 a, const f32x4 b) { u32x4 w; w.x = pk2(a[0], a[1]); w.y = pk2(a[2], a[3]); w.z = pk2(b[0], b[1]); w.w = pk2(b[2], b[3]); return w; }

struct EpiScale {
    static constexpr bool PERM = true;
    bf16* O; int ldc; const float* SS; float* kmean; int kcol0;
    __device__ __forceinline__ void operator()(const f32x4 (&acc)[2][2][4][2], const Unit& u, int wr, int wc, int fr, int fq) const {
        const int row0 = u.pm * 256 + wr * 64 + fr, col0 = u.pn * 256 + wc * 32 + 8 * fq;
        const bool dok = (kmean != nullptr) && (u.pn * 256 >= kcol0);
        f32x4 ks[2][2];
#pragma unroll
        for (int bj = 0; bj < 2; ++bj)
#pragma unroll
            for (int n = 0; n < 2; ++n) ks[bj][n] = (f32x4){0.f, 0.f, 0.f, 0.f};
        f32x4 pp[2][4];
#pragma unroll
        for (int ai = 0; ai < 2; ++ai)
#pragma unroll
            for (int m = 0; m < 4; ++m) pp[ai][m] = row_ss_load(SS, row0 + ai * 128 + m * 16, fq);
#pragma unroll
        for (int ai = 0; ai < 2; ++ai)
#pragma unroll
            for (int m = 0; m < 4; ++m) {
                const int row = row0 + ai * 128 + m * 16; const float rs = row_rs_from(pp[ai][m]);
                bf16* rowp = O + (size_t)row * ldc + col0;
#pragma unroll
                for (int bj = 0; bj < 2; ++bj) { const f32x4 v0 = acc[ai][bj][m][0] * rs, v1 = acc[ai][bj][m][1] * rs;
                    ks[bj][0] += v0; ks[bj][1] += v1;
                    *(u32x4*)(rowp + bj * 128) = pack8(v0, v1); }
            }
        if (dok) {
#pragma unroll
            for (int bj = 0; bj < 2; ++bj)
#pragma unroll
                for (int n = 0; n < 2; ++n)
#pragma unroll
                    for (int j = 0; j < 4; ++j) { float v = ks[bj][n][j];
                        v += __shfl_xor(v, 1); v += __shfl_xor(v, 2); v += __shfl_xor(v, 4); v += __shfl_xor(v, 8);
                        if (fr == 0) unsafeAtomicAdd(kmean + (size_t)u.pm * MOBA_W + (col0 + bj * 128 + 4 * n + j - kcol0), v); }
        }
    }
};
struct EpiVT {
    static constexpr bool PERM = true;
    bf16* O; int ldc; const float* RS;
    __device__ __forceinline__ void operator()(const f32x4 (&acc)[2][2][4][2], const Unit& u, int wr, int wc, int fr, int fq) const {
        const int row0 = u.pm * 256 + wr * 64 + fr, col0 = u.pn * 256 + wc * 32 + 8 * fq;
        f32x4 rs[2][2];
#pragma unroll
        for (int bj = 0; bj < 2; ++bj) { rs[bj][0] = *(const f32x4*)(RS + col0 + bj * 128); rs[bj][1] = *(const f32x4*)(RS + col0 + bj * 128 + 4); }
#pragma unroll
        for (int ai = 0; ai < 2; ++ai)
#pragma unroll
            for (int m = 0; m < 4; ++m) {
                bf16* rowp = O + (size_t)(row0 + ai * 128 + m * 16) * ldc + col0;
#pragma unroll
                for (int bj = 0; bj < 2; ++bj) *(u32x4*)(rowp + bj * 128) = pack8(acc[ai][bj][m][0] * rs[bj][0], acc[ai][bj][m][1] * rs[bj][1]);
            }
    }
};
template <bool F8, bool BASEBF, bool WF32> struct EpiResid {
    static constexpr bool PERM = true;
    const float* base; float* out; bf16* xb; float* SS; unsigned char* xb8;
    __device__ __forceinline__ void operator()(const f32x4 (&acc)[2][2][4][2], const Unit& u, int wr, int wc, int fr, int fq) const {
        const int row0 = u.pm * 256 + wr * 64 + fr, col0 = u.pn * 256 + wc * 32 + 8 * fq;
        static_assert(BASEBF, "EpiResid: the residual base is the bf16 stream");
        u32x4 bw[2][4][2];
#pragma unroll
        for (int ai = 0; ai < 2; ++ai)
#pragma unroll
            for (int m = 0; m < 4; ++m)
#pragma unroll
                for (int bj = 0; bj < 2; ++bj) bw[ai][m][bj] = *(const u32x4*)(xb + (unsigned)((row0 + ai * 128 + m * 16) * D + col0 + bj * 128));
#pragma unroll
        for (int ai = 0; ai < 2; ++ai)
#pragma unroll
            for (int m = 0; m < 4; ++m) {
                const int row = row0 + ai * 128 + m * 16; const unsigned off = (unsigned)(row * D + col0); float sq = 0.f;
#pragma unroll
                for (int bj = 0; bj < 2; ++bj) {
                    const u32x4 b = bw[ai][m][bj];
                    const f32x4 b0 = (f32x4){bflo(b.x), bfhi(b.x), bflo(b.y), bfhi(b.y)}, b1 = (f32x4){bflo(b.z), bfhi(b.z), bflo(b.w), bfhi(b.w)};
                    const f32x4 v0 = acc[ai][bj][m][0] + b0, v1 = acc[ai][bj][m][1] + b1;
                    if (WF32) { *(f32x4*)(out + off + bj * 128) = v0; *(f32x4*)(out + off + bj * 128 + 4) = v1; }
                    else *(u32x4*)(xb + off + bj * 128) = pack8(v0, v1);
                    if (F8) { u32x2 t8; t8.x = pk4_fp8(v0[0] * F8_SX, v0[1] * F8_SX, v0[2] * F8_SX, v0[3] * F8_SX); t8.y = pk4_fp8(v1[0] * F8_SX, v1[1] * F8_SX, v1[2] * F8_SX, v1[3] * F8_SX); *(u32x2*)(xb8 + off + bj * 128) = t8; }
                    sq += (v0[0] * v0[0] + v0[1] * v0[1]) + (v0[2] * v0[2] + v0[3] * v0[3]) + (v1[0] * v1[0] + v1[1] * v1[1]) + (v1[2] * v1[2] + v1[3] * v1[3]);
                }
                sq += __shfl_xor(sq, 16); sq += __shfl_xor(sq, 32);
                if (fq == 0) SS[(unsigned)(row * 16 + u.pn * 4 + wc)] = sq;
            }
    }
};
template <bool MOE> struct EpiGateUp {
    static constexpr bool PERM = true;
    bf16* O; const float* SS; const LAS unsigned short* rowtab;
    __device__ __forceinline__ void operator()(const f32x4 (&acc)[2][2][4][2], const Unit& u, int wr, int wc, int fr, int fq) const {
        if (MOE) asm volatile("" : "+v"(fr), "+v"(fq));
        const int pnl = MOE ? (u.pn % 28) : u.pn, colo = pnl * 128 + wc * 32 + 8 * fq;
        f32x4 pp[2][4]; float rsm[2][4];
        const float* rsg_ = MOE ? (const float*)((*kargs()).ws + WS_RSG) : nullptr;
#pragma unroll
        for (int ai = 0; ai < 2; ++ai)
#pragma unroll
            for (int m = 0; m < 4; ++m) { const int orow = u.pm * 256 + ai * 128 + wr * 64 + m * 16 + fr;
                if (MOE) { int tk_ = rowtab[u.ui * 256 + ai * 128 + wr * 64 + m * 16 + fr]; tk_ = tk_ == 0xFFFF ? 0 : tk_; rsm[ai][m] = rsg_[(unsigned)tk_]; } else pp[ai][m] = row_ss_load(SS, orow, fq); }
#pragma unroll
        for (int ai = 0; ai < 2; ++ai)
#pragma unroll
            for (int m = 0; m < 4; ++m) {
                const int rl = ai * 128 + wr * 64 + m * 16 + fr, orow = u.pm * 256 + rl;
                const float rs = MOE ? rsm[ai][m] * (1.0f / (F8_SX * F8_SW1)) : row_rs_from(pp[ai][m]);
                const f32x4 g0 = acc[ai][0][m][0] * rs, g1 = acc[ai][0][m][1] * rs, u0 = acc[ai][1][m][0] * rs, u1 = acc[ai][1][m][1] * rs;
                f32x4 h0, h1;
#pragma unroll
                for (int j = 0; j < 4; ++j) { h0[j] = silu_f(g0[j]) * u0[j]; h1[j] = silu_f(g1[j]) * u1[j]; }
                if (MOE) { u32x2 t8; t8.x = pk4_fp8(h0[0] * F8_SH, h0[1] * F8_SH, h0[2] * F8_SH, h0[3] * F8_SH); t8.y = pk4_fp8(h1[0] * F8_SH, h1[1] * F8_SH, h1[2] * F8_SH, h1[3] * F8_SH);
                           *(u32x2*)((unsigned char*)O + (unsigned)(orow * FF + colo)) = t8; }
                else *(u32x4*)(O + (size_t)orow * FF + colo) = pack8(h0, h1);
            }
    }
};
struct EpiMoeDown {
    static constexpr bool PERM = true;
    bf16* yp0; unsigned ypstride; const float* GW; const LAS int* pan; const LAS unsigned short* rowtab; float* scr; int nsl;
    __device__ __forceinline__ void operator()(const f32x4 (&acc)[2][2][4][2], const Unit& u, int wr, int wc, int fr, int fq) const {
        asm volatile("" : "+v"(fr), "+v"(fq));
        const int pnl = u.pn & 3, col0 = pnl * 256 + wc * 32 + 8 * fq;
        if (u.ti >= 0) {
            float* sp = scr + ((size_t)(u.ti * nsl + u.kt0 / u.nkt)) * 65536 + wc * 32 + 8 * fq;
#pragma unroll
            for (int ai = 0; ai < 2; ++ai)
#pragma unroll
                for (int m = 0; m < 4; ++m) { float* rp = sp + (ai * 128 + wr * 64 + m * 16 + fr) * 256;
#pragma unroll
                    for (int bj = 0; bj < 2; ++bj) { *(f32x4*)(rp + bj * 128) = acc[ai][bj][m][0]; *(f32x4*)(rp + bj * 128 + 4) = acc[ai][bj][m][1]; } }
            return;
        }
        const int k = (pan[u.pm] >> 19) & 1;
        bf16* yp = yp0 + (size_t)k * ypstride;
        int tk[2][4]; float wt[2][4];
#pragma unroll
        for (int ai = 0; ai < 2; ++ai)
#pragma unroll
            for (int m = 0; m < 4; ++m) tk[ai][m] = rowtab[u.ui * 256 + ai * 128 + wr * 64 + m * 16 + fr];
#pragma unroll
        for (int ai = 0; ai < 2; ++ai)
#pragma unroll
            for (int m = 0; m < 4; ++m) wt[ai][m] = GW[(unsigned)((tk[ai][m] == 0xFFFF ? 0 : tk[ai][m]) * 2 + k)];
#pragma unroll
        for (int ai = 0; ai < 2; ++ai)
#pragma unroll
            for (int m = 0; m < 4; ++m) {
                const int tok = tk[ai][m];
                if (tok != 0xFFFF) { const float w = wt[ai][m] * (1.0f / (F8_SH * F8_SW2)); bf16* p = yp + (unsigned)(tok * D + col0);
#pragma unroll
                    for (int bj = 0; bj < 2; ++bj) *(u32x4*)(p + bj * 128) = pack8(acc[ai][bj][m][0] * w, acc[ai][bj][m][1] * w); }
                asm volatile("" ::: "memory");
            }
    }
};

struct CvtJ { const float* s0; const float* s1; const float* g; bf16* d; int ld, K, nr, c0, md, nv, n, f8; float sc; };
__device__ __forceinline__ void cvt_load(const CvtJ& J, int item, int lane, f32x4 (&v)[8]) {
    const int nblk = J.nr / 32, kb = item / nblk, nb = item % nblk, k0 = 64 * kb, n0 = 32 * nb;
    const float* src = J.s0; int col = J.c0 + n0;
    if (J.md == 1) { const int blk = n0 >> 8, r = n0 & 255; src = (r < 128) ? J.s0 : J.s1; col = blk * 128 + (r & 127); }
    const int lr = lane >> 3, lc = (lane & 7) * 4;
    const bool ok = (n0 + lc) < J.nv;
#pragma unroll
    for (int i = 0; i < 8; ++i) { v[i] = (f32x4){0.f, 0.f, 0.f, 0.f}; if (ok) v[i] = *(const GAS f32x4*)(src + (size_t)(k0 + 8 * i + lr) * J.ld + col + lc); }
    if (J.g) {
#pragma unroll
        for (int i = 0; i < 8; ++i) v[i] = v[i] * J.g[k0 + 8 * i + lr];
    }
}
__device__ __forceinline__ void cvt_store(const CvtJ& J, int item, int lane, LAS float* scr, const f32x4 (&v)[8]) {
    const int nblk = J.nr / 32, kb = item / nblk, nb = item % nblk, k0 = 64 * kb, n0 = 32 * nb;
    const int lr = lane >> 3, lc = (lane & 7) * 4;
#pragma unroll
    for (int i = 0; i < 8; ++i) { LAS float* sp = scr + (8 * i + lr) * 33 + lc; sp[0] = v[i].x; sp[1] = v[i].y; sp[2] = v[i].z; sp[3] = v[i].w; }
    LDS_WAIT(); asm volatile("" ::: "memory");
    if (J.f8) {
        const int c4 = lane & 3; const float sc = J.sc;
#pragma unroll
        for (int j = 0; j < 2; ++j) { const int n = (lane >> 2) + 16 * j; const LAS float* s = scr + (16 * c4) * 33 + n;
            u32x4 o; o.x = pk4_fp8<true>(s[0 * 33] * sc, s[1 * 33] * sc, s[2 * 33] * sc, s[3 * 33] * sc); o.y = pk4_fp8<true>(s[4 * 33] * sc, s[5 * 33] * sc, s[6 * 33] * sc, s[7 * 33] * sc);
            o.z = pk4_fp8<true>(s[8 * 33] * sc, s[9 * 33] * sc, s[10 * 33] * sc, s[11 * 33] * sc); o.w = pk4_fp8<true>(s[12 * 33] * sc, s[13 * 33] * sc, s[14 * 33] * sc, s[15 * 33] * sc);
            *(GAS u32x4*)((unsigned char*)J.d + (size_t)(n0 + n) * J.K + k0 + 16 * c4) = o; }
    } else {
    const int c = lane & 7;
#pragma unroll
    for (int j = 0; j < 4; ++j) { const int n = (lane >> 3) + 8 * j; const LAS float* s = scr + (8 * c) * 33 + n;
        u32x4 o; o.x = pk2(s[0 * 33], s[1 * 33]); o.y = pk2(s[2 * 33], s[3 * 33]); o.z = pk2(s[4 * 33], s[5 * 33]); o.w = pk2(s[6 * 33], s[7 * 33]);
        *(GAS u32x4*)(J.d + (size_t)(n0 + n) * J.K + k0 + 8 * c) = o; }
    }
    LDS_WAIT(); asm volatile("" ::: "memory");
}
#define CVT_DECL() CvtJ J; J.s0 = nullptr; J.s1 = nullptr; J.g = nullptr; J.d = nullptr; J.ld = 0; J.K = 64; J.nr = 32; J.c0 = 0; J.md = 0; J.nv = 0; J.n = 0; J.f8 = 0; J.sc = 1.f; bool j_found = false;
#define CVT_JOB(src0, src1, gain, dst, ld_, K_, nrows, col0, mode, nvalid) { const int _n = ((K_) / 64) * ((nrows) / 32); \
    if (!j_found) { if (r < _n) { J.s0 = (src0); J.s1 = (src1); J.g = (gain); J.d = (dst); J.ld = (ld_); J.K = (K_); J.nr = (nrows); J.c0 = (col0); J.md = (mode); J.nv = (nvalid); J.n = _n; j_found = true; } else r -= _n; } }
#define CVT_JOB8(src0, src1, gain, dst, ld_, K_, nrows, col0, mode, nvalid, scale) { const int _n = ((K_) / 64) * ((nrows) / 32); \
    if (!j_found) { if (r < _n) { J.s0 = (src0); J.s1 = (src1); J.g = (gain); J.d = (bf16*)(dst); J.ld = (ld_); J.K = (K_); J.nr = (nrows); J.c0 = (col0); J.md = (mode); J.nv = (nvalid); J.n = _n; J.f8 = 1; J.sc = (scale); j_found = true; } else r -= _n; } }
#define CVT_RUN(it, end) do { int m_ = J.n - r; if ((end) - (it) < m_) m_ = (end) - (it); if (!j_found || m_ < 1) m_ = 1; \
    if (j_found) { f32x4 va[8], vb[8], vc[8]; cvt_load(J, r, lane, va); if (m_ > 1) cvt_load(J, r + 1, lane, vb);       \
        for (int j_ = 0; j_ < m_; j_ += 3) { \
            if (j_ + 2 < m_) cvt_load(J, r + j_ + 2, lane, vc); cvt_store(J, r + j_, lane, scr, va); \
            if (j_ + 1 < m_) { if (j_ + 3 < m_) cvt_load(J, r + j_ + 3, lane, va); cvt_store(J, r + j_ + 1, lane, scr, vb); } \
            if (j_ + 2 < m_) { if (j_ + 4 < m_) cvt_load(J, r + j_ + 4, lane, vb); cvt_store(J, r + j_ + 2, lane, scr, vc); } } } \
    (it) += m_; } while (0)

namespace att {
constexpr int KBUF = 0, VBUF = 32768, LUT_OFF = 65536, KM_OFF = 65536 + 1024;
__device__ __forceinline__ int ks_off(int row, int chunk) { return row * 256 + ((chunk ^ ((row & 3) | (((row >> 3) & 3) << 2))) << 4); }
__device__ __forceinline__ int vs_off(int row, int chunk) { return row * 128 + ((chunk ^ (((row >> 1) & 1) | (((row >> 3) & 3) << 1))) << 4); }
constexpr float C1 = 0.08838834764831845f * LOG2E;
__device__ __forceinline__ int qt_base(int w) { return w < 7 ? 73728 + w * 8192 : 133120; }
__device__ __forceinline__ int qt_off(int row, int piece) { return row * 256 + ((piece ^ (row & 15)) << 4); }

template <bool MOBA>
__device__ __forceinline__ void attn_unit(LAS unsigned char* lds, int wv, bf16* Qb, int ldq, const bf16* Kb, int ldk, const bf16* VTb, int ldvt, int ntiles,
                                          int nblk, const float* ksum_bh, const float* rel_bias, int head, bool dry = false) {
    const int tid = opaque_tid(wv), lane = tid & 63, w = wv, c = lane & 31, hi = lane >> 5;
    int kofs0, kofs1, vofs0, vofs1;
    { const int r0 = w * 4 + (lane >> 4), r1 = r0 + 32, cs = lane & 15;
      kofs0 = r0 * ldk + ((cs ^ ((r0 & 3) | (((r0 >> 3) & 3) << 2))) << 3); kofs1 = r1 * ldk + ((cs ^ ((r1 & 3) | (((r1 >> 3) & 3) << 2))) << 3);
      const int v0 = w * 8 + (lane >> 3), v1 = v0 + 64, cv = lane & 7;
      vofs0 = v0 * ldvt + ((cv ^ (((v0 >> 1) & 1) | (((v0 >> 3) & 3) << 1))) << 3); vofs1 = v1 * ldvt + ((cv ^ (((v1 >> 1) & 1) | (((v1 >> 3) & 3) << 1))) << 3); }
#define ATT_GLDS(gptr, ldsoff) __builtin_amdgcn_global_load_lds((const unsigned*)(gptr), (LAS unsigned*)(lds + (ldsoff)), 16, 0, 0)
#define ATT_STAGE_K(ti) do { const bf16* kt_ = Kb + (size_t)(64 * (ti)) * ldk; const int b_ = ((ti) & 1) * 16384; \
        ATT_GLDS(kt_ + kofs0, b_ + KBUF + w * 1024); ATT_GLDS(kt_ + kofs1, b_ + KBUF + 8192 + w * 1024); } while (0)
#define ATT_STAGE_V(ti) do { const bf16* vt_ = VTb + 64 * (ti); const int b_ = ((ti) & 1) * 16384; \
        ATT_GLDS(vt_ + vofs0, b_ + VBUF + w * 1024); ATT_GLDS(vt_ + vofs1, b_ + VBUF + 8192 + w * 1024); } while (0)
#define ATT_PAIR(t) do { if ((t) <= ntiles) { if ((t) < ntiles) ATT_STAGE_K(t); ATT_STAGE_V((t) - 1); } } while (0)
#define ATT_BARRIER() do { asm volatile("s_waitcnt lgkmcnt(0)" ::: "memory"); __builtin_amdgcn_s_barrier(); asm volatile("" ::: "memory"); } while (0)
    ATT_STAGE_K(0); ATT_PAIR(1);
    LAS float* lut = (LAS float*)(lds + LUT_OFF);
    LAS float* km = (LAS float*)(lds + KM_OFF);
    if (MOBA) {
        if (tid < 130) { float v;
            if (tid == 0) v = -__builtin_inff();
            else { const int d = tid - 1; int bk;
                if (d < 16) bk = d; else if (d >= 128) bk = 31;
                else bk = 16 + (d >= 19) + (d >= 21) + (d >= 24) + (d >= 27) + (d >= 31) + (d >= 35) + (d >= 40) + (d >= 46) + (d >= 52) + (d >= 59) + (d >= 67) + (d >= 77) + (d >= 87) + (d >= 99) + (d >= 113);
                v = rel_bias[bk * MOBA_H + head] * LOG2E; }
            lut[tid] = v; }
        for (int idx = tid; idx < nblk * 128; idx += NTHR) km[idx] = ksum_bh[(size_t)(idx >> 7) * MOBA_W + (idx & 127)];
    }
    LAS unsigned char* qt = lds + qt_base(w);
    bf16* qtile = Qb + (size_t)(32 * w) * ldq;
    const int qr = lane >> 4, qp = lane & 15;
    { u32x4 qq[8];
#pragma unroll
      for (int i = 0; i < 8; ++i) qq[i] = *(const u32x4*)(qtile + (size_t)(4 * i + qr) * ldq + 8 * qp);
#pragma unroll
      for (int i = 0; i < 8; ++i) *(LAS u32x4*)(qt + qt_off(4 * i + qr, qp)) = qq[i]; }
    LDS_WAIT(); asm volatile("" ::: "memory");
    bf16x8 qf[8];
#pragma unroll
    for (int ks = 0; ks < 8; ++ks) qf[ks] = *(const LAS bf16x8*)(qt + qt_off(c, 2 * ks + hi));
    LDS_WAIT(); asm volatile("" ::: "memory");
    VM_WAIT();
    __syncthreads();
    unsigned selmask = 0;
    if (MOBA) {
        if (nblk <= 3) selmask = (1u << nblk) - 1u;
        else {
            float g[7];
#pragma unroll
            for (int j = 0; j < 7; ++j) { g[j] = -__builtin_inff();
                if (j < nblk) { float s = 0.f;
#pragma unroll
                    for (int ks = 0; ks < 8; ++ks) { const LAS float* kp = km + j * 128 + 16 * ks + 8 * hi; const f32x4 k0 = *(const LAS f32x4*)kp, k1 = *(const LAS f32x4*)(kp + 4);
                        const u32x4 qw = __builtin_bit_cast(u32x4, qf[ks]);
                        s += bflo(qw.x) * k0[0] + bfhi(qw.x) * k0[1] + bflo(qw.y) * k0[2] + bfhi(qw.y) * k0[3] + bflo(qw.z) * k1[0] + bfhi(qw.z) * k1[1] + bflo(qw.w) * k1[2] + bfhi(qw.w) * k1[3]; }
                    s += __shfl_xor(s, 32); g[j] = s; } }
#pragma unroll
            for (int pick = 0; pick < 3; ++pick) { float best = -__builtin_inff(); int bi = 0;
#pragma unroll
                for (int j = 0; j < 7; ++j) { const bool cand = (j < nblk) && !((selmask >> j) & 1u) && (g[j] > best); best = cand ? g[j] : best; bi = cand ? j : bi; }
                selmask |= 1u << bi; }
        }
    }
    const int pi = (c & ~0xC) | ((c & 4) << 1) | ((c & 8) >> 1);
    const int kra = ks_off(pi, 0) & ~0xF0, kxa = (pi & 3) | (((pi >> 3) & 3) << 2);
    const int vxa = ((c >> 1) & 1) | (((c >> 3) & 3) << 1);
    float m_run = -1e30f, l_run = 0.f;
    f32x16 o0, o1, o2, o3;
#pragma unroll
    for (int r = 0; r < 16; ++r) { o0[r] = 0.f; o1[r] = 0.f; o2[r] = 0.f; o3[r] = 0.f; }
    const int qpos = 256 * nblk + 32 * w + c;
    const float bfar = MOBA ? lut[129] : 0.f;
#define ATT_SKIP(t) (MOBA && (((t) >> 2) == nblk) && (64 * (t) > 256 * nblk + 32 * w + 31))
#define ATT_QK(t) do { const LAS unsigned char* kbase = lds + ((t) & 1) * 16384 + KBUF + kra; \
        _Pragma("unroll") for (int r = 0; r < 16; ++r) { p0[r] = 0.f; p1[r] = 0.f; } \
        _Pragma("unroll") for (int ks = 0; ks < 8; ++ks) { const int co = ((2 * ks + hi) ^ kx) << 4; \
            const bf16x8 a0 = *(const LAS bf16x8*)(kbase + co), a1 = *(const LAS bf16x8*)(kbase + 8192 + co); \
            p0 = MFMA32(a0, qf[ks], p0); p1 = MFMA32(a1, qf[ks], p1); \
            if (ks == 3) __builtin_amdgcn_sched_barrier(0); } } while (0)
    const bool gB = w >= 4;
    f32x16 p0, p1;
    { int kx = kxa; asm volatile("" : "+v"(kx)); if (!ATT_SKIP(0)) ATT_QK(0); }
    if (gB) ATT_BARRIER();
#pragma unroll 1
    for (int ti = 0; ti < ntiles; ++ti) {
        int kx = kxa, vx = vxa; asm volatile("" : "+v"(kx), "+v"(vx));
        const int kb = 64 * ti;
        bool skip = false, nearb = false, own = false;
        if (MOBA) { own = ((ti >> 2) == nblk); const int qlo = 256 * nblk + 32 * w;
            skip = own && (kb > qlo + 31);
            nearb = (qlo - (kb + 63)) < 128; }
        if (gB) ATT_PAIR(ti + 2);
        bf16x8 pf[4];
        if (!skip) {
            float offs = 0.f;
            if (MOBA) { const bool sel = own || ((selmask >> (ti >> 2)) & 1u); offs = sel ? 0.f : -__builtin_inff(); }
            if (MOBA && nearb) {
#pragma unroll
                for (int r = 0; r < 16; ++r) { const int kl = (r & 7) + 8 * hi + 16 * (r >> 3);
                    int i0 = qpos - (kb + kl) + 1, i1 = i0 - 32;
                    i0 = i0 < 0 ? 0 : (i0 > 129 ? 129 : i0); i1 = i1 < 0 ? 0 : (i1 > 129 ? 129 : i1);
                    p0[r] = __builtin_fmaf(p0[r], C1, lut[i0] + offs); p1[r] = __builtin_fmaf(p1[r], C1, lut[i1] + offs);
                    if ((r & 3) == 3) __builtin_amdgcn_sched_barrier(0); }
            } else {
                const float ob = bfar + offs;
#pragma unroll
                for (int r = 0; r < 16; ++r) { p0[r] = __builtin_fmaf(p0[r], C1, ob); p1[r] = __builtin_fmaf(p1[r], C1, ob); }
            }
            float mx = p0[0];
#pragma unroll
            for (int r = 1; r < 16; ++r) mx = fmaxf(mx, p0[r]);
#pragma unroll
            for (int r = 0; r < 16; ++r) mx = fmaxf(mx, p1[r]);
            mx = fmaxf(mx, __shfl_xor(mx, 32));
            float mn = m_run;
            if (!__all(mx - m_run <= 8.0f)) {
                mn = fmaxf(m_run, mx); const float alpha = fast_exp2(m_run - mn); m_run = mn;
                l_run *= alpha; o0 *= alpha; o1 *= alpha; o2 *= alpha; o3 *= alpha; }
            float ls = 0.f;
#pragma unroll
            for (int r = 0; r < 16; ++r) { p0[r] = fast_exp2(p0[r] - mn); p1[r] = fast_exp2(p1[r] - mn); ls += p0[r] + p1[r]; }
            l_run += ls;
            { u32x4 t;
              t.x = pk2(p0[0], p0[1]); t.y = pk2(p0[2], p0[3]); t.z = pk2(p0[4], p0[5]); t.w = pk2(p0[6], p0[7]); pf[0] = __builtin_bit_cast(bf16x8, t);
              t.x = pk2(p0[8], p0[9]); t.y = pk2(p0[10], p0[11]); t.z = pk2(p0[12], p0[13]); t.w = pk2(p0[14], p0[15]); pf[1] = __builtin_bit_cast(bf16x8, t);
              t.x = pk2(p1[0], p1[1]); t.y = pk2(p1[2], p1[3]); t.z = pk2(p1[4], p1[5]); t.w = pk2(p1[6], p1[7]); pf[2] = __builtin_bit_cast(bf16x8, t);
              t.x = pk2(p1[8], p1[9]); t.y = pk2(p1[10], p1[11]); t.z = pk2(p1[12], p1[13]); t.w = pk2(p1[14], p1[15]); pf[3] = __builtin_bit_cast(bf16x8, t); }
        }
        if (!gB) VM_WAIT();
        ATT_BARRIER();
        if (!gB) ATT_PAIR(ti + 2);
        if (!skip) {
            const LAS unsigned char* vbase = lds + (ti & 1) * 16384 + VBUF + c * 128;
#pragma unroll
            for (int q = 0; q < 4; ++q) { const int co = ((2 * q + hi) ^ vx) << 4;
                o0 = MFMA32(*(const LAS bf16x8*)(vbase + co), pf[q], o0);
                o1 = MFMA32(*(const LAS bf16x8*)(vbase + 4096 + co), pf[q], o1);
                o2 = MFMA32(*(const LAS bf16x8*)(vbase + 8192 + co), pf[q], o2);
                o3 = MFMA32(*(const LAS bf16x8*)(vbase + 12288 + co), pf[q], o3);
                if (q == 1) __builtin_amdgcn_sched_barrier(0); }
        }
        if (ti + 1 < ntiles && !ATT_SKIP(ti + 1)) ATT_QK(ti + 1);
        if (gB) VM_WAIT();
        ATT_BARRIER();
    }
    if (!gB) ATT_BARRIER();
#undef ATT_QK
#undef ATT_SKIP
    const float inv = 1.0f / (l_run + __shfl_xor(l_run, 32));
    int l2 = lane; asm volatile("" : "+v"(l2));
    const int c2 = l2 & 31, h2 = l2 >> 5, qr2 = l2 >> 4, qp2 = l2 & 15;
#pragma unroll
    for (int a = 0; a < 4; ++a) {
        u32x2 t;
        t.x = pk2(o0[4 * a] * inv, o0[4 * a + 1] * inv); t.y = pk2(o0[4 * a + 2] * inv, o0[4 * a + 3] * inv); *(LAS u32x2*)(qt + qt_off(c2, a) + 8 * h2) = t;
        t.x = pk2(o1[4 * a] * inv, o1[4 * a + 1] * inv); t.y = pk2(o1[4 * a + 2] * inv, o1[4 * a + 3] * inv); *(LAS u32x2*)(qt + qt_off(c2, 4 + a) + 8 * h2) = t;
        t.x = pk2(o2[4 * a] * inv, o2[4 * a + 1] * inv); t.y = pk2(o2[4 * a + 2] * inv, o2[4 * a + 3] * inv); *(LAS u32x2*)(qt + qt_off(c2, 8 + a) + 8 * h2) = t;
        t.x = pk2(o3[4 * a] * inv, o3[4 * a + 1] * inv); t.y = pk2(o3[4 * a + 2] * inv, o3[4 * a + 3] * inv); *(LAS u32x2*)(qt + qt_off(c2, 12 + a) + 8 * h2) = t;
    }
    LDS_WAIT(); asm volatile("" ::: "memory");
#pragma unroll
    for (int i = 0; i < 8; ++i) { const u32x4 oq = *(const LAS u32x4*)(qt + qt_off(4 * i + qr2, qp2)); if (!dry) *(u32x4*)(qtile + (size_t)(4 * i + qr2) * ldq + 8 * qp2) = oq; }
    LDS_WAIT(); asm volatile("" ::: "memory");
#undef ATT_GLDS
#undef ATT_STAGE_K
#undef ATT_STAGE_V
#undef ATT_PAIR
#undef ATT_BARRIER
}
}

namespace ssd {
constexpr int DT_OFF = 0, CS_OFF = 3072, SSP_OFF = 6144;
constexpr int A_BMT = 8192, A_XT = 8192 + 32768;
constexpr int C_BM = 8192, C_CM = 8192 + 32768, C_XT = 8192 + 65536;
__device__ __forceinline__ int sw_off(int row, int chunk) { return row * 256 + ((chunk ^ ((row & 3) | (((row >> 3) & 3) << 2))) << 4); }

__device__ __forceinline__ int zt_base(int w) { return w < 6 ? 106496 + w * 4096 : 133120 + (w - 6) * 4096; }
__device__ __forceinline__ int zt_off(int row, int piece) { return row * 128 + ((piece ^ (row & 7)) << 4); }
struct Par { const bf16* proj; const float* conv_w; const float* conv_b; const float* dt_bias; const float* a_log; const float* d_skip; const float* g_out; bf16* states; float* cdec; };

__device__ __forceinline__ void dtcs(LAS unsigned char* lds, int wv, const Par& P, int b, int c, int g, bool write_cdec) {
    const int tid = opaque_tid(wv), lane = tid & 63, w = wv;
    if (w < 6) {
        const int hd = g * 6 + w; const size_t row0 = (size_t)b * SEQ + c * SSD_CH + 2 * lane;
        const float r0 = bf2f(P.proj[row0 * P1W + P1_DT + hd]), r1 = bf2f(P.proj[(row0 + 1) * P1W + P1_DT + hd]);
        const float bias = P.dt_bias[hd], A = -expf(P.a_log[hd]);
        const float x0 = r0 + bias, x1 = r1 + bias;
        const float d0 = x0 > 20.f ? x0 : log1pf(expf(x0)), d1 = x1 > 20.f ? x1 : log1pf(expf(x1));
        const float la0 = d0 * A, la1 = d1 * A; const float s1 = la0 + la1; float v = s1;
#pragma unroll
        for (int off = 1; off < 64; off <<= 1) { const float t = __shfl_up(v, off); if (lane >= off) v += t; }
        LAS float* dt = (LAS float*)(lds + DT_OFF) + w * 128; LAS float* cs = (LAS float*)(lds + CS_OFF) + w * 128;
        dt[2 * lane] = d0; dt[2 * lane + 1] = d1; cs[2 * lane] = v - s1 + la0; cs[2 * lane + 1] = v;
        if (write_cdec && lane == 63) P.cdec[((size_t)b * NCHUNK + c) * SSD_H + hd] = expf(v);
    }
}
__device__ __forceinline__ void conv8(const Par& P, int b, int s0, int chx, float (&y0)[8], float (&y1)[8]) {
    float x0[11], x1[11];
    const bf16* base = P.proj + ((size_t)b * SEQ) * P1W + P1_XBC + chx;
#pragma unroll
    for (int j = 0; j < 11; ++j) { const int s = s0 - 3 + j; unsigned wv = 0u; if (s >= 0) wv = *(const unsigned*)(base + (size_t)s * P1W); x0[j] = bflo(wv); x1[j] = bfhi(wv); }
    f32x2 wj[4];
#pragma unroll
    for (int j = 0; j < 4; ++j) wj[j] = *(const f32x2*)(P.conv_w + j * CONV_DIM + chx);
    const f32x2 bb = *(const f32x2*)(P.conv_b + chx);
#pragma unroll
    for (int i = 0; i < 8; ++i) {
        const float a0 = bb.x + wj[0].x * x0[i] + wj[1].x * x0[i + 1] + wj[2].x * x0[i + 2] + wj[3].x * x0[i + 3];
        const float a1 = bb.y + wj[0].y * x1[i] + wj[1].y * x1[i + 1] + wj[2].y * x1[i + 2] + wj[3].y * x1[i + 3];
        y0[i] = silu_f(a0); y1[i] = silu_f(a1); }
}
__device__ __forceinline__ u32x4 pack8f(const float (&y)[8]) { u32x4 t; t.x = pk2(y[0], y[1]); t.y = pk2(y[2], y[3]); t.z = pk2(y[4], y[5]); t.w = pk2(y[6], y[7]); return t; }

constexpr int A_WT = 90112, A_SC = 100352;
__device__ __forceinline__ void conv_load(const Par& P, int b, int s0, int chx, unsigned (&r)[11]) {
    const bf16* base = P.proj + ((size_t)b * SEQ) * P1W + P1_XBC + chx;
#pragma unroll
    for (int j = 0; j < 11; ++j) { const int s = s0 - 3 + j; r[j] = *(const unsigned*)(base + (size_t)(s < 0 ? 0 : s) * P1W); }
}
__device__ __forceinline__ void conv_math(const LAS float* wt, int lc, int s0, const unsigned (&r)[11], float (&y0)[8], float (&y1)[8]) {
    float x0[11], x1[11];
#pragma unroll
    for (int j = 0; j < 11; ++j) { x0[j] = bflo(r[j]); x1[j] = bfhi(r[j]); }
    if (s0 == 0) {
#pragma unroll
        for (int j = 0; j < 3; ++j) { x0[j] = 0.f; x1[j] = 0.f; } }
    f32x2 wj[4];
#pragma unroll
    for (int j = 0; j < 4; ++j) wj[j] = *(const LAS f32x2*)(wt + j * 512 + lc);
    const f32x2 bb = *(const LAS f32x2*)(wt + 4 * 512 + lc);
#pragma unroll
    for (int i = 0; i < 8; ++i) {
        const float a0 = bb.x + wj[0].x * x0[i] + wj[1].x * x0[i + 1] + wj[2].x * x0[i + 2] + wj[3].x * x0[i + 3];
        const float a1 = bb.y + wj[0].y * x1[i] + wj[1].y * x1[i + 1] + wj[2].y * x1[i + 2] + wj[3].y * x1[i + 3];
        y0[i] = silu_f(a0); y1[i] = silu_f(a1); }
}
__device__ __forceinline__ void phase_a(LAS unsigned char* lds, int wv, const Par& P, int vcu, int G) {
    const int tid = opaque_tid(wv), lane = tid & 63, w = wv;
    constexpr int NIT = BATCH * NCHUNK * SSD_G;
    unsigned rB[2][11], rX[6][11], dr0 = 0, dr1 = 0;
#define A_DEC(it_) const int g = (it_) & 3, c = ((it_) >> 2) & 15, b = (it_) >> 6
#define A_LD_DT(it_) { A_DEC(it_); if (w < 6) { const size_t row0 = (size_t)b * SEQ + c * SSD_CH + 2 * lane; dr0 = P.proj[row0 * P1W + P1_DT + g * 6 + w]; dr1 = P.proj[(row0 + 1) * P1W + P1_DT + g * 6 + w]; } }
#define A_LD_B(it_) { A_DEC(it_); int t_ = tid; asm volatile("" : "+v"(t_)); _Pragma("unroll") for (int j = 0; j < 2; ++j) { const int i2 = t_ + NTHR * j, cp = i2 & 63, tg = i2 >> 6; conv_load(P, b, c * SSD_CH + 8 * tg, SSD_IN + g * SSD_N + 2 * cp, rB[j]); } }
#define A_LD_X(it_, hg) { A_DEC(it_); int t_ = tid; asm volatile("" : "+v"(t_)); _Pragma("unroll") for (int j = 0; j < 3; ++j) { const int i2 = t_ + NTHR * j, cp = i2 % 96, tg = i2 / 96; conv_load(P, b, c * SSD_CH + 8 * tg, (g * 6 + 3 * (hg) + (cp >> 5)) * SSD_P + 2 * (cp & 31), rX[3 * (hg) + j]); } }
    int it = vcu, gtab = -1;
    if (it < NIT) { A_LD_DT(it) A_LD_B(it) A_LD_X(it, 0) A_LD_X(it, 1) }
    const LAS float* wt = (const LAS float*)(lds + A_WT); const LAS float* sct = (const LAS float*)(lds + A_SC);
#pragma unroll 1
    for (; it < NIT; it += G) {
        A_DEC(it); const int itc = (it + G < NIT) ? it + G : it;
        if (g != gtab) { gtab = g;
            const int ch = tid < 128 ? SSD_IN + g * SSD_N + tid : g * 6 * SSD_P + (tid - 128);
#pragma unroll
            for (int j = 0; j < 4; ++j) ((LAS float*)(lds + A_WT))[j * 512 + tid] = P.conv_w[j * CONV_DIM + ch];
            ((LAS float*)(lds + A_WT))[4 * 512 + tid] = P.conv_b[ch];
            __syncthreads(); }
        if (w < 6) {
            const int hd = g * 6 + w; const float bias = P.dt_bias[hd], A = -expf(P.a_log[hd]);
            const float x0 = bf2f((unsigned short)dr0) + bias, x1 = bf2f((unsigned short)dr1) + bias;
            const float d0 = x0 > 20.f ? x0 : log1pf(expf(x0)), d1 = x1 > 20.f ? x1 : log1pf(expf(x1));
            const float la0 = d0 * A, la1 = d1 * A; const float s1 = la0 + la1; float v = s1;
#pragma unroll
            for (int off = 1; off < 64; off <<= 1) { const float t = __shfl_up(v, off); if (lane >= off) v += t; }
            const float cend = __shfl(v, 63);
            LAS float* sc = (LAS float*)(lds + A_SC) + w * 128;
            sc[2 * lane] = d0 * expf(cend - (v - s1 + la0)); sc[2 * lane + 1] = d1 * expf(cend - v);
            if (lane == 63) P.cdec[((size_t)b * NCHUNK + c) * SSD_H + hd] = expf(v);
        }
        int tb = tid; asm volatile("" : "+v"(tb));
#pragma unroll
        for (int j = 0; j < 2; ++j) { const int i2 = tb + NTHR * j, cp = i2 & 63, tg = i2 >> 6; float y0[8], y1[8];
            conv_math(wt, 2 * cp, c * SSD_CH + 8 * tg, rB[j], y0, y1);
            *(LAS u32x4*)(lds + A_BMT + sw_off(2 * cp, tg)) = pack8f(y0); *(LAS u32x4*)(lds + A_BMT + sw_off(2 * cp + 1, tg)) = pack8f(y1); }
        { A_LD_DT(itc) A_LD_B(itc) }
        __syncthreads();
#pragma unroll
        for (int hg = 0; hg < 2; ++hg) {
            int tx = tid; asm volatile("" : "+v"(tx));
#pragma unroll
            for (int j = 0; j < 3; ++j) { const int i2 = tx + NTHR * j, cp = i2 % 96, tg = i2 / 96; const int e3 = cp >> 5, e = 3 * hg + e3, pp = 2 * (cp & 31); float y0[8], y1[8];
                conv_math(wt, 128 + e * SSD_P + pp, c * SSD_CH + 8 * tg, rX[3 * hg + j], y0, y1);
                const f32x4 sa = *(const LAS f32x4*)(sct + e * 128 + 8 * tg), sb = *(const LAS f32x4*)(sct + e * 128 + 8 * tg + 4);
#pragma unroll
                for (int i = 0; i < 4; ++i) { y0[i] *= sa[i]; y1[i] *= sa[i]; y0[4 + i] *= sb[i]; y1[4 + i] *= sb[i]; }
                *(LAS u32x4*)(lds + A_XT + e3 * 16384 + sw_off(pp, tg)) = pack8f(y0); *(LAS u32x4*)(lds + A_XT + e3 * 16384 + sw_off(pp + 1, tg)) = pack8f(y1); }
            { if (hg == 0) A_LD_X(itc, 0) else A_LD_X(itc, 1) }
            __syncthreads();
            const int nt = w & 3, pt = w >> 2;
            int clm = tid & 31; asm volatile("" : "+v"(clm));
            const int cl = clm, hi = (tid >> 5) & 1;
            const int xo = (cl & 3) | (((cl >> 3) & 3) << 2);
#pragma unroll
            for (int e3 = 0; e3 < 3; ++e3) {
                f32x16 acc;
#pragma unroll
                for (int r = 0; r < 16; ++r) acc[r] = 0.f;
                const LAS unsigned char* ab = lds + A_BMT + (32 * nt + cl) * 256; const LAS unsigned char* bb = lds + A_XT + e3 * 16384 + (32 * pt + cl) * 256;
#pragma unroll
                for (int ks = 0; ks < 8; ++ks) { const int co = ((2 * ks + hi) ^ xo) << 4;
                    acc = MFMA32(*(const LAS bf16x8*)(ab + co), *(const LAS bf16x8*)(bb + co), acc); }
                const int hd = g * 6 + 3 * hg + e3;
                bf16* dst = P.states + ((((size_t)b * NCHUNK + c) * SSD_H + hd) * SSD_P + 32 * pt + cl) * SSD_N + 32 * nt + 4 * hi;
#pragma unroll
                for (int a = 0; a < 4; ++a) { u32x2 t; t.x = pk2(acc[4 * a], acc[4 * a + 1]); t.y = pk2(acc[4 * a + 2], acc[4 * a + 3]); *(u32x2*)(dst + 8 * a) = t; }
            }
            __syncthreads();
        }
    }
#undef A_DEC
#undef A_LD_DT
#undef A_LD_B
#undef A_LD_X
}
__device__ __forceinline__ void phase_b(const Par& P, int gtid, int gthreads, bool dry = false) {
    for (int it = gtid; it < BATCH * SSD_H * SSD_P * 16; it += gthreads) {
        const int nq = it & 15, p = (it >> 4) & 63, bh = it >> 10, h = bh % SSD_H, b = bh / SSD_H;
        u32x4 v[NCHUNK];
#pragma unroll
        for (int c = 0; c < NCHUNK; ++c) v[c] = *(const u32x4*)(P.states + ((((size_t)b * NCHUNK + c) * SSD_H + h) * SSD_P + p) * SSD_N + 8 * nq);
        float hr[8];
#pragma unroll
        for (int i = 0; i < 8; ++i) hr[i] = 0.f;
#pragma unroll
        for (int c = 0; c < NCHUNK; ++c) {
            const float dec = P.cdec[((size_t)b * NCHUNK + c) * SSD_H + h];
            u32x4 o; o.x = pk2(hr[0], hr[1]); o.y = pk2(hr[2], hr[3]); o.z = pk2(hr[4], hr[5]); o.w = pk2(hr[6], hr[7]);
            if (!dry) *(u32x4*)(P.states + ((((size_t)b * NCHUNK + c) * SSD_H + h) * SSD_P + p) * SSD_N + 8 * nq) = o;
            hr[0] = dec * hr[0] + bflo(v[c].x); hr[1] = dec * hr[1] + bfhi(v[c].x); hr[2] = dec * hr[2] + bflo(v[c].y); hr[3] = dec * hr[3] + bfhi(v[c].y);
            hr[4] = dec * hr[4] + bflo(v[c].z); hr[5] = dec * hr[5] + bfhi(v[c].z); hr[6] = dec * hr[6] + bflo(v[c].w); hr[7] = dec * hr[7] + bfhi(v[c].w);
        }
    }
}
constexpr int C_WT = 141312;
template <int WS>
__device__ __forceinline__ void conv_math_t(const LAS float* wt, int lc, int s0, const unsigned (&r)[11], float (&y0)[8], float (&y1)[8]) {
    float x0[11], x1[11];
#pragma unroll
    for (int j = 0; j < 11; ++j) { x0[j] = bflo(r[j]); x1[j] = bfhi(r[j]); }
    if (s0 == 0) {
#pragma unroll
        for (int j = 0; j < 3; ++j) { x0[j] = 0.f; x1[j] = 0.f; } }
    f32x2 wj[4];
#pragma unroll
    for (int j = 0; j < 4; ++j) wj[j] = *(const LAS f32x2*)(wt + j * WS + lc);
    const f32x2 bb = *(const LAS f32x2*)(wt + 4 * WS + lc);
#pragma unroll
    for (int i = 0; i < 8; ++i) {
        const float a0 = bb.x + wj[0].x * x0[i] + wj[1].x * x0[i + 1] + wj[2].x * x0[i + 2] + wj[3].x * x0[i + 3];
        const float a1 = bb.y + wj[0].y * x1[i] + wj[1].y * x1[i + 1] + wj[2].y * x1[i + 2] + wj[3].y * x1[i + 3];
        y0[i] = silu_f(a0); y1[i] = silu_f(a1); }
}
__device__ __forceinline__ void phase_c(LAS unsigned char* lds, int wv, const Par& P, bf16* projw, int vcu, int NG) {
    const int tid = opaque_tid(wv), w = wv;
    constexpr int NIT = BATCH * NCHUNK * SSD_G;
    unsigned rBC[4][11], rX[2][11], dr0 = 0, dr1 = 0;
#define C_DEC(it_) const int g = (it_) & 3, c = ((it_) >> 2) & 15, b = (it_) >> 6
#define C_LD_DT(it_) { C_DEC(it_); if (w < 6) { const int l_ = tid & 63; const size_t row0 = (size_t)b * SEQ + c * SSD_CH + 2 * l_; dr0 = P.proj[row0 * P1W + P1_DT + g * 6 + w]; dr1 = P.proj[(row0 + 1) * P1W + P1_DT + g * 6 + w]; } }
#define C_LD_BC(it_) { C_DEC(it_); int t_ = tid; asm volatile("" : "+v"(t_)); _Pragma("unroll") for (int j = 0; j < 4; ++j) { const int i2 = t_ + NTHR * j, cp = i2 & 127, tg = i2 >> 7; \
        conv_load(P, b, c * SSD_CH + 8 * tg, SSD_IN + (cp >> 6) * (SSD_G * SSD_N) + g * SSD_N + 2 * (cp & 63), rBC[j]); } }
#define C_LD_X(it_, ei_) { C_DEC(it_); int t_ = tid; asm volatile("" : "+v"(t_)); _Pragma("unroll") for (int j = 0; j < 2; ++j) { const int i2 = t_ + NTHR * j, cp = i2 & 63, tg = i2 >> 6; \
        conv_load(P, b, c * SSD_CH + 8 * tg, (g * 6 + 3 * (cp >> 5) + (ei_)) * SSD_P + 2 * (cp & 31), rX[j]); } }
    int it = vcu, gtab = -1;
    if (it < NIT) { C_LD_DT(it) C_LD_BC(it) C_LD_X(it, 0) }
    const LAS float* wt = (const LAS float*)(lds + C_WT);
#pragma unroll 1
    for (; it < NIT; it += NG) {
        C_DEC(it); const int itc = (it + NG < NIT) ? it + NG : it;
        if (g != gtab) { gtab = g;
#pragma unroll
            for (int q = 0; q < 2; ++q) { const int idx = tid + NTHR * q;
                if (idx < 640) { const int ch = idx < 128 ? SSD_IN + g * SSD_N + idx : idx < 256 ? SSD_IN + SSD_G * SSD_N + g * SSD_N + (idx - 128) : g * 6 * SSD_P + (idx - 256);
#pragma unroll
                    for (int j = 0; j < 4; ++j) ((LAS float*)(lds + C_WT))[j * 640 + idx] = P.conv_w[j * CONV_DIM + ch];
                    ((LAS float*)(lds + C_WT))[4 * 640 + idx] = P.conv_b[ch]; } }
            __syncthreads(); }
        if (w < 6) {
            const int lane = tid & 63, hd = g * 6 + w; const float bias = P.dt_bias[hd], A = -expf(P.a_log[hd]);
            const float x0 = bf2f((unsigned short)dr0) + bias, x1 = bf2f((unsigned short)dr1) + bias;
            const float d0 = x0 > 20.f ? x0 : log1pf(expf(x0)), d1 = x1 > 20.f ? x1 : log1pf(expf(x1));
            const float la0 = d0 * A, la1 = d1 * A; const float s1 = la0 + la1; float v = s1;
#pragma unroll
            for (int off = 1; off < 64; off <<= 1) { const float t = __shfl_up(v, off); if (lane >= off) v += t; }
            LAS float* dt = (LAS float*)(lds + DT_OFF) + w * 128; LAS float* cs = (LAS float*)(lds + CS_OFF) + w * 128;
            dt[2 * lane] = d0; dt[2 * lane + 1] = d1; cs[2 * lane] = v - s1 + la0; cs[2 * lane + 1] = v;
        }
        { int tb = tid; asm volatile("" : "+v"(tb));
#pragma unroll
          for (int j = 0; j < 4; ++j) { const int i2 = tb + NTHR * j, cp = i2 & 127, tg = i2 >> 7; float y0[8], y1[8];
            conv_math_t<640>(wt, 2 * cp, c * SSD_CH + 8 * tg, rBC[j], y0, y1);
            const int img = (cp >> 6) ? C_CM : C_BM, n2 = cp & 63;
#pragma unroll
            for (int i = 0; i < 8; ++i) *(LAS unsigned*)(lds + img + sw_off(8 * tg + i, n2 >> 2) + (n2 & 3) * 4) = pk2(y0[i], y1[i]); } }
        int lv = tid & 63; asm volatile("" : "+v"(lv));
        const int lane = lv, cl = lane & 31, hi = lane >> 5;
        __syncthreads();
    const LAS float* dtl = (const LAS float*)(lds + DT_OFF); const LAS float* csl = (const LAS float*)(lds + CS_OFF);
    const int lt = (w < 4) ? w : 7 - w, hh = w >> 2, l = 32 * lt + cl;
    const int xo = (cl & 3) | (((cl >> 3) & 3) << 2);
    const int pi = (cl & ~0xC) | ((cl & 4) << 1) | ((cl & 8) >> 1), xpi = (pi & 3) | (((pi >> 3) & 3) << 2);
    const LAS unsigned char* cmb = lds + C_CM + l * 256;
#define CF(ks) (*(const LAS bf16x8*)(cmb + (((2 * (ks) + hi) ^ xo) << 4)))
    f32x16 G[4];
#pragma unroll
    for (int st = 0; st < 4; ++st) {
#pragma unroll
        for (int r = 0; r < 16; ++r) G[st][r] = 0.f;
        if (st <= lt) { const LAS unsigned char* ab = lds + C_BM + (32 * st + pi) * 256;
#pragma unroll
            for (int ks = 0; ks < 8; ++ks) G[st] = MFMA32(*(const LAS bf16x8*)(ab + (((2 * ks + hi) ^ xpi) << 4)), CF(ks), G[st]); }
        __builtin_amdgcn_sched_barrier(0);
    }
        float sq = 0.f;
#pragma unroll 1
        for (int ei = 0; ei < 3; ++ei) {
            const int e = 3 * hh + ei, hd = g * 6 + e;
            const float csl_l = csl[e * 128 + l], dsk = P.d_skip[hd] / dtl[e * 128 + l];
            u32x4 zq[4];
            { const bf16* zr = projw + ((size_t)b * SEQ + c * SSD_CH + 32 * lt) * P1W + hd * SSD_P;
#pragma unroll
              for (int i = 0; i < 4; ++i) zq[i] = *(const u32x4*)(zr + (size_t)(8 * i + (lane >> 3)) * P1W + 8 * (lane & 7)); }
            __syncthreads();
            if (c > 0) {
                int tq = tid; asm volatile("" : "+v"(tq));
                const int ln = tq & 63, cs = ln & 15;
#pragma unroll
                for (int q = 0; q < 4; ++q) { const int hb = q >> 1, pc = w + 8 * (q & 1), r = 4 * pc + (ln >> 4);
                    const bf16* sp = P.states + ((((size_t)b * NCHUNK + c) * SSD_H + g * 6 + 3 * hb + ei) * SSD_P + r) * SSD_N + ((cs ^ ((r & 3) | (((r >> 3) & 3) << 2))) << 3);
                    __builtin_amdgcn_global_load_lds((const unsigned*)sp, (LAS unsigned*)(lds + C_BM + hb * 16384 + pc * 1024), 16, 0, 0); }
            }
            { int tx = tid; asm volatile("" : "+v"(tx));
#pragma unroll
              for (int j = 0; j < 2; ++j) { const int i2 = tx + NTHR * j, cp = i2 & 63, tg = i2 >> 6; const int hb = cp >> 5, e2 = 3 * hb + ei, pp = 2 * (cp & 31); float y0[8], y1[8];
                conv_math_t<640>(wt, 256 + e2 * SSD_P + pp, c * SSD_CH + 8 * tg, rX[j], y0, y1);
                const f32x4 sa = *(const LAS f32x4*)(dtl + e2 * 128 + 8 * tg), sb = *(const LAS f32x4*)(dtl + e2 * 128 + 8 * tg + 4);
#pragma unroll
                for (int i = 0; i < 4; ++i) { y0[i] *= sa[i]; y1[i] *= sa[i]; y0[4 + i] *= sb[i]; y1[4 + i] *= sb[i]; }
                *(LAS u32x4*)(lds + C_XT + hb * 16384 + sw_off(pp, tg)) = pack8f(y0); *(LAS u32x4*)(lds + C_XT + hb * 16384 + sw_off(pp + 1, tg)) = pack8f(y1); } }
            VM_WAIT();
            { const int itx = ei < 2 ? it : itc, eix = ei < 2 ? ei + 1 : 0; C_LD_X(itx, eix) }
            __syncthreads();
            f32x16 Y0, Y1;
#pragma unroll
            for (int r = 0; r < 16; ++r) { Y0[r] = 0.f; Y1[r] = 0.f; }
            if (c > 0) {
                const LAS unsigned char* sb0 = lds + C_BM + hh * 16384 + cl * 256; const LAS unsigned char* sb1 = sb0 + 32 * 256;
#pragma unroll
                for (int ks = 0; ks < 8; ++ks) { const bf16x8 cfk = CF(ks); const int co = ((2 * ks + hi) ^ xo) << 4;
                    Y0 = MFMA32(*(const LAS bf16x8*)(sb0 + co), cfk, Y0); Y1 = MFMA32(*(const LAS bf16x8*)(sb1 + co), cfk, Y1); }
                const float el = fast_exp2(csl_l * LOG2E);
                Y0 *= el; Y1 *= el;
            }
            int clv = cl; asm volatile("" : "+v"(clv));
            const LAS unsigned char* xb0 = lds + C_XT + hh * 16384 + cl * 256; const LAS unsigned char* xb1 = xb0 + 32 * 256;
#pragma unroll
            for (int st = 0; st < 4; ++st) {
                if (st <= lt) {
                    float mv[16];
                    const LAS float* cp8 = csl + e * 128 + 32 * st + 8 * hi;
                    const f32x4 c0 = *(const LAS f32x4*)cp8, c1 = *(const LAS f32x4*)(cp8 + 4), c2 = *(const LAS f32x4*)(cp8 + 16), c3 = *(const LAS f32x4*)(cp8 + 20);
#pragma unroll
                    for (int r = 0; r < 16; ++r) {
                        const float cs_s = (r < 4) ? c0[r & 3] : (r < 8) ? c1[r & 3] : (r < 12) ? c2[r & 3] : c3[r & 3];
                        mv[r] = G[st][r] * fast_exp2((csl_l - cs_s) * LOG2E); }
                    if (st == lt) {
#pragma unroll
                        for (int r = 0; r < 16; ++r) { const int sl = (r & 7) + 8 * hi + 16 * (r >> 3);
                            float v = mv[r]; v = (sl <= clv) ? v : 0.f; v = (sl == clv) ? v + dsk : v; mv[r] = v; }
                    }
                    u32x4 t; bf16x8 m0, m1;
                    t.x = pk2(mv[0], mv[1]); t.y = pk2(mv[2], mv[3]); t.z = pk2(mv[4], mv[5]); t.w = pk2(mv[6], mv[7]); m0 = __builtin_bit_cast(bf16x8, t);
                    t.x = pk2(mv[8], mv[9]); t.y = pk2(mv[10], mv[11]); t.z = pk2(mv[12], mv[13]); t.w = pk2(mv[14], mv[15]); m1 = __builtin_bit_cast(bf16x8, t);
                    const int co0 = ((4 * st + hi) ^ xo) << 4, co1 = ((4 * st + 2 + hi) ^ xo) << 4;
                    Y0 = MFMA32(*(const LAS bf16x8*)(xb0 + co0), m0, Y0); Y0 = MFMA32(*(const LAS bf16x8*)(xb0 + co1), m1, Y0);
                    Y1 = MFMA32(*(const LAS bf16x8*)(xb1 + co0), m0, Y1); Y1 = MFMA32(*(const LAS bf16x8*)(xb1 + co1), m1, Y1);
                }
            }
            { LAS unsigned char* zt = lds + zt_base(w);
              bf16* zrow = projw + ((size_t)b * SEQ + c * SSD_CH + 32 * lt) * P1W + hd * SSD_P;
              const int rr = lane >> 3, pc = lane & 7;
#pragma unroll
              for (int i = 0; i < 4; ++i) *(LAS u32x4*)(zt + zt_off(8 * i + rr, pc)) = zq[i];
              LDS_WAIT(); asm volatile("" ::: "memory");
              u32x2 zz0[4], zz1[4];
#pragma unroll
              for (int a = 0; a < 4; ++a) { zz0[a] = *(const LAS u32x2*)(zt + zt_off(cl, a) + 8 * hi); zz1[a] = *(const LAS u32x2*)(zt + zt_off(cl, 4 + a) + 8 * hi); }
              LDS_WAIT(); asm volatile("" ::: "memory");
#pragma unroll
              for (int a = 0; a < 4; ++a) {
                { const u32x2 zz = zz0[a];
                  const float u0 = Y0[4 * a] * silu_f(bflo(zz.x)), u1 = Y0[4 * a + 1] * silu_f(bfhi(zz.x)), u2 = Y0[4 * a + 2] * silu_f(bflo(zz.y)), u3 = Y0[4 * a + 3] * silu_f(bfhi(zz.y));
                  sq += (u0 * u0 + u1 * u1) + (u2 * u2 + u3 * u3); u32x2 t; t.x = pk2(u0, u1); t.y = pk2(u2, u3); *(LAS u32x2*)(zt + zt_off(cl, a) + 8 * hi) = t; }
                { const u32x2 zz = zz1[a];
                  const float u0 = Y1[4 * a] * silu_f(bflo(zz.x)), u1 = Y1[4 * a + 1] * silu_f(bfhi(zz.x)), u2 = Y1[4 * a + 2] * silu_f(bflo(zz.y)), u3 = Y1[4 * a + 3] * silu_f(bfhi(zz.y));
                  sq += (u0 * u0 + u1 * u1) + (u2 * u2 + u3 * u3); u32x2 t; t.x = pk2(u0, u1); t.y = pk2(u2, u3); *(LAS u32x2*)(zt + zt_off(cl, 4 + a) + 8 * hi) = t; }
              }
              LDS_WAIT(); asm volatile("" ::: "memory");
#pragma unroll
              for (int i = 0; i < 4; ++i) { const u32x4 uq = *(const LAS u32x4*)(zt + zt_off(8 * i + rr, pc)); *(u32x4*)(zrow + (size_t)(8 * i + rr) * P1W + 8 * pc) = uq; }
              LDS_WAIT(); asm volatile("" ::: "memory");
            }
    }
LAS float* ssp = (LAS float*)(lds + SSP_OFF);
    ssp[l * 4 + hh * 2 + hi] = sq;
        { C_LD_DT(itc) C_LD_BC(itc) }
    __syncthreads();
    { const int rr = lane >> 3, pc = lane & 7;
#pragma unroll
      for (int ei = 0; ei < 3; ++ei) { const int hd = g * 6 + 3 * hh + ei;
            bf16* zrow = projw + ((size_t)b * SEQ + c * SSD_CH + 32 * lt) * P1W + hd * SSD_P;
            const f32x4 g0 = *(const f32x4*)(P.g_out + hd * SSD_P + 8 * pc), g1 = *(const f32x4*)(P.g_out + hd * SSD_P + 8 * pc + 4);
#pragma unroll
            for (int i = 0; i < 4; ++i) { const int lr = 32 * lt + 8 * i + rr;
                const f32x4 s4 = *(const LAS f32x4*)(ssp + lr * 4); const float rs = 1.0f / sqrtf(((s4.x + s4.y) + (s4.z + s4.w)) * (1.0f / 384.0f) + EPS);
                u32x4* up = (u32x4*)(zrow + (size_t)(8 * i + rr) * P1W + 8 * pc);
                const u32x4 uv = *up;
                u32x4 t; t.x = pk2(bflo(uv.x) * rs * g0[0], bfhi(uv.x) * rs * g0[1]); t.y = pk2(bflo(uv.y) * rs * g0[2], bfhi(uv.y) * rs * g0[3]);
                t.z = pk2(bflo(uv.z) * rs * g1[0], bfhi(uv.z) * rs * g1[1]); t.w = pk2(bflo(uv.w) * rs * g1[2], bfhi(uv.w) * rs * g1[3]);
                *up = t; } } }
    __syncthreads();
    }
#undef CF
#undef C_DEC
#undef C_LD_DT
#undef C_LD_BC
#undef C_LD_X
}
}

constexpr size_t WS_MEMRS = 4 * MiB + 256 * 1024;
constexpr size_t WS_RS0 = 4 * MiB + 512 * 1024;
constexpr int N_PHASES = 15;

struct MoeOrder {
    pg8::StaticOrder so; const LAS int* pan; int npn;
    __device__ __forceinline__ bool next(int i, Unit& u) const { if (!so.next(i, u)) return false; u.pn = ((pan[u.pm] >> 16) & 7) * npn + u.pn; return true; }
};
struct MoeOrderSplit {
    pg8::StaticOrder so; const LAS int* pan; int npn;
    __device__ __forceinline__ int nfull() const { return (so.nwg / so.G) * so.G; }
    __device__ __forceinline__ int nsl() const { const int t = so.nwg - nfull(); return (t * 7 <= so.G) ? 7 : ((t * 2 <= so.G) ? 2 : 1); }
    __device__ __forceinline__ int ntail() const { const int t = so.nwg - nfull(); return nsl() > 1 ? t : 0; }
    __device__ __forceinline__ bool next(int i, Unit& u) const {
        const int L = i * so.G + so.c, nf = nfull(), nt = ntail(), ns = nsl();
        if (nt == 0 || L < nf) { if (L >= so.nwg) return false; so.decode(L, u); u.kt0 = 0; u.nkt = MOE_NKT; u.ti = -1; }
        else { const int s = L - nf; if (s >= nt * ns) return false; so.decode(nf + s / ns, u); u.kt0 = (s % ns) * (MOE_NKT / ns); u.nkt = MOE_NKT / ns; u.ti = s / ns; }
        u.ui = i; u.pn = ((pan[u.pm] >> 16) & 7) * npn + u.pn; return true;
    }
};

__device__ __forceinline__ void row_to_bf16(const float* xrow, bf16* orow, float* ss16, float* rs1, int lane) {
    const GAS f32x4* xr = (const GAS f32x4*)xrow + lane;
    f32x4 v[4]; float s = 0.f;
#pragma unroll
    for (int j = 0; j < 4; ++j) { v[j] = xr[64 * j]; s += (v[j].x * v[j].x + v[j].y * v[j].y) + (v[j].z * v[j].z + v[j].w * v[j].w); }
    s = wave_sum(s);
    GAS unsigned long long* o8 = (GAS unsigned long long*)orow + lane;
#pragma unroll
    for (int j = 0; j < 4; ++j) o8[64 * j] = (unsigned long long)pk2(v[j].x, v[j].y) | ((unsigned long long)pk2(v[j].z, v[j].w) << 32);
    if (lane < 16) ss16[lane] = (lane == 0) ? s : 0.f;
    if (lane == 0) *rs1 = 1.0f / sqrtf(s * (1.0f / 1024.0f) + EPS);
}

__global__ void __launch_bounds__(NTHR, 2) fwd_kernel(Args args_unused) {
#define args (*kargs())
    extern __shared__ __attribute__((aligned(16))) unsigned char lds_raw[];
    LAS unsigned char* lds = (LAS unsigned char*)lds_raw;
    const int wave = __builtin_amdgcn_readfirstlane((int)threadIdx.x >> 6);
#define tid (opaque_tid(wave))
#define lane (opaque_tid(wave) & 63)
    const int G = gridDim.x, bx = blockIdx.x;
    const int vcu = (G % 8 == 0) ? (bx % 8) * (G / 8) + bx / 8 : bx;
    unsigned char* ws = args.ws;
    gu32* ctl = (gu32*)(ws + WS_CTL);
    for (int u = tid; u < 256; u += NTHR) ((LAS unsigned*)(lds + MISC_OFF))[u] = 0u;
    __syncthreads();
    XcdBarrier bar = xcd_barrier_post((unsigned*)(ctl + CW_BAR), (volatile LAS unsigned*)(lds + MISC_OFF) + 8);
    const int lo = args.ph_lo, hi = args.ph_hi;
#ifndef ONLY_PHASE
#define ONLY_PHASE -1
#endif
#define IN(k) ((ONLY_PHASE < 0 || (k) == ONLY_PHASE) && lo <= (k) && (k) < hi)
#define SEAM(k) do { if (IN(k) && IN((k) + 1)) xcd_barrier(bar); } while (0)

    const float* x_in = args.in[0]; float* out = args.out;
    bf16* XB = (bf16*)(ws + WS_XB); float* SS = (float*)(ws + WS_SS); bf16* PROJ = (bf16*)(ws + WS_PROJ);
    float* KMEAN = (float*)(ws + WS_KMEAN);
    const LAS unsigned short* rowtab = (const LAS unsigned short*)(lds + ROWTAB_OFF);
    LAS int* pan = (LAS int*)(lds + PAN_OFF);

    if (IN(0)) {
        LAS float* scr = (LAS float*)(lds + wave * 16384);
        const int gw = vcu * NWAVES + wave, NGW = G * NWAVES;
        const float *g_mix = args.in[2], *g_mem = args.in[3], *w_moba = args.in[4], *w_ssd = args.in[5], *w_kv = args.in[6], *w_out = args.in[7], *g_ffn = args.in[15];
        constexpr int NIT = (1024 / 64) * ((3584 + 1536 + 4864 + 1024 + 1024 + 7168) / 32) + (2048 / 64) * (2048 / 32) + (3584 / 64) * (1024 / 32);
        const int cvt_c = (NIT + NGW - 1) / NGW, cvt_end = (gw + 1) * cvt_c < NIT ? (gw + 1) * cvt_c : NIT;
        for (int it = gw * cvt_c; it < cvt_end;) {
            int r = it; CVT_DECL()
            CVT_JOB(w_moba, nullptr, g_mix, (bf16*)(ws + WS_WM1), IN_MOBA, 1024, 1536, 0, 0, 1536)
            CVT_JOB(w_moba, nullptr, g_mix, (bf16*)(ws + WS_WM1) + (size_t)1536 * 1024, IN_MOBA, 1024, 512, 4608, 0, 512)
            CVT_JOB(w_moba, nullptr, g_mix, (bf16*)(ws + WS_WM1) + (size_t)2048 * 1024, IN_MOBA, 1024, 1536, 1536, 0, 1536)
            CVT_JOB(w_moba, nullptr, g_mix, (bf16*)(ws + WS_WV), IN_MOBA, 1024, 1536, 3072, 0, 1536)
            CVT_JOB(w_ssd, nullptr, g_mix + D, (bf16*)(ws + WS_WS), IN_SSD, 1024, 1536, 0, 0, 1536)
            CVT_JOB(w_ssd, nullptr, g_mix + D, (bf16*)(ws + WS_WS) + (size_t)1536 * 1024, IN_SSD, 1024, 512, 4120, 0, 512)
            CVT_JOB(w_ssd, nullptr, g_mix + D, (bf16*)(ws + WS_WS) + (size_t)2048 * 1024, IN_SSD, 1024, 2560, 1536, 0, 2560)
            CVT_JOB(w_ssd, nullptr, g_mix + D, (bf16*)(ws + WS_WS) + (size_t)4608 * 1024, IN_SSD, 1024, 256, 4096, 0, 24)
            CVT_JOB(w_kv, nullptr, g_mem, (bf16*)(ws + WS_WMK), 1024, 1024, 512, 0, 0, 512)
            CVT_JOB(w_kv + (size_t)1024 * 1024, nullptr, g_mem + D, (bf16*)(ws + WS_WMK) + (size_t)512 * 1024, 1024, 1024, 512, 0, 0, 512)
            CVT_JOB(w_kv, nullptr, g_mem, (bf16*)(ws + WS_WMV), 1024, 1024, 512, 512, 0, 512)
            CVT_JOB(w_kv + (size_t)1024 * 1024, nullptr, g_mem + D, (bf16*)(ws + WS_WMV) + (size_t)512 * 1024, 1024, 1024, 512, 512, 0, 512)
            CVT_JOB(args.in[16], args.in[17], g_ffn, (bf16*)(ws + WS_WGU), FF, 1024, 7168, 0, 1, 7168)
            CVT_JOB(w_out, nullptr, nullptr, (bf16*)(ws + WS_WO), 1024, 2048, 1024, 0, 0, 1024)
            CVT_JOB(w_out + (size_t)2048 * 1024, nullptr, nullptr, (bf16*)(ws + WS_WO) + (size_t)1024 * 2048, 1024, 2048, 1024, 0, 0, 1024)
            CVT_JOB(args.in[18], nullptr, nullptr, (bf16*)(ws + WS_WD), 1024, FF, 1024, 0, 0, 1024)
            CVT_RUN(it, cvt_end);
        }
        for (int m = gw; m < T; m += NGW) row_to_bf16(x_in + (size_t)m * D, XB + (size_t)m * D, SS + (size_t)m * 16, (float*)(ws + WS_RS0) + m, lane);
        for (int m = gw; m < MROWS; m += NGW) row_to_bf16(args.in[1] + (size_t)m * D, (bf16*)(ws + WS_MEMB) + (size_t)m * D, (float*)(ws + WS_MEMSS) + (size_t)m * 16, (float*)(ws + WS_MEMRS) + m, lane);
        __syncthreads();
    }
    SEAM(0);
    if (IN(1)) {
        { pg8::Gemm g{XB, (const bf16*)(ws + WS_WM1), D, D}; pg8::StaticOrder S; S.init(T / 256, P0W / 256, G, bx);
          EpiScale E{PROJ, P0W, SS, KMEAN, 2048};
          pg8::gemm_phase<EpiScale, pg8::StaticOrder, false>(lds, g, S, E, rowtab, wave); }
        { pg8::Gemm g{(const bf16*)(ws + WS_WV), XB, D, D}; pg8::StaticOrder S; S.init(MOBA_W / 256, T / 256, G, bx);
          EpiVT E{(bf16*)(ws + WS_VT), T, (const float*)(ws + WS_RS0)};
          pg8::gemm_phase<EpiVT, pg8::StaticOrder, false>(lds, g, S, E, rowtab, wave); }
        { pg8::Gemm g{(const bf16*)(ws + WS_MEMB), (const bf16*)(ws + WS_WMK), D, D}; pg8::StaticOrder S; S.init(MROWS / 256, 2, G, bx);
          EpiScale E{(bf16*)(ws + WS_KMEM), 1024, (const float*)(ws + WS_MEMSS), nullptr, 0};
          pg8::gemm_phase<EpiScale, pg8::StaticOrder, false>(lds, g, S, E, rowtab, wave); }
        { pg8::Gemm g{(const bf16*)(ws + WS_WMV), (const bf16*)(ws + WS_MEMB), D, D}; pg8::StaticOrder S; S.init(2, MROWS / 256, G, (bx + G - 32) % G);
          EpiVT E{(bf16*)(ws + WS_VMEMT), MROWS, (const float*)(ws + WS_MEMRS)};
          pg8::gemm_phase<EpiVT, pg8::StaticOrder, false>(lds, g, S, E, rowtab, wave); }
    }
    SEAM(1);
    if (IN(2)) { const bool dry = false;
        for (int it = vcu; it < BATCH * MOBA_H * 4; it += G) {
            const int bh = it >> 2, pr = it & 3, b = bh / MOBA_H, h = bh % MOBA_H;
#pragma unroll 1
            for (int half = 0; half < 2; ++half) { const int n = half ? pr : 7 - pr;
                att::attn_unit<true>(lds, wave, PROJ + ((size_t)b * SEQ + 256 * n) * P0W + h * HD, P0W, PROJ + ((size_t)b * SEQ) * P0W + 2048 + h * HD, P0W,
                                     (const bf16*)(ws + WS_VT) + (size_t)(h * HD) * T + (size_t)b * SEQ, T, 4 * (n + 1), n, KMEAN + (size_t)(b * NBLK) * MOBA_W + h * HD, args.in[8], h, dry); }
        }
        for (int it = vcu; it < BATCH * MEM_H * 8; it += G) {
            const int b = it >> 5, mh = (it >> 3) & 3, qt = it & 7;
            att::attn_unit<false>(lds, wave, PROJ + ((size_t)b * SEQ + 256 * qt) * P0W + 1536 + mh * HD, P0W, (const bf16*)(ws + WS_KMEM) + ((size_t)b * MEM_LEN) * 1024 + mh * HD, 1024,
                                  (const bf16*)(ws + WS_VMEMT) + (size_t)(mh * HD) * MROWS + b * MEM_LEN, MROWS, 4, 0, nullptr, nullptr, 0, dry);
        }
    }
    SEAM(2);
    if (IN(3)) {
        pg8::Gemm g{PROJ, (const bf16*)(ws + WS_WO), P0W, MIXW}; pg8::StaticOrder S; S.init(T / 256, 4, G, bx);
        EpiResid<false, true, false> E{nullptr, nullptr, XB, SS, nullptr};
        pg8::gemm_phase<EpiResid<false, true, false>, pg8::StaticOrder, false>(lds, g, S, E, rowtab, wave);
    }
    SEAM(3);
    if (IN(4)) {
        pg8::Gemm g{XB, (const bf16*)(ws + WS_WGU), D, D}; pg8::StaticOrder S; S.init(T / 256, 28, G, bx);
        EpiGateUp<false> E{(bf16*)(ws + WS_ACT), SS, rowtab};
        pg8::gemm_phase<EpiGateUp<false>, pg8::StaticOrder, false>(lds, g, S, E, rowtab, wave);
    }
    SEAM(4);
    if (IN(5)) {
        pg8::Gemm g{(const bf16*)(ws + WS_ACT), (const bf16*)(ws + WS_WD), FF, FF}; pg8::StaticOrder S; S.init(T / 256, 4, G, bx);
        EpiResid<false, true, false> E{nullptr, nullptr, XB, SS, nullptr};
        pg8::gemm_phase<EpiResid<false, true, false>, pg8::StaticOrder, false>(lds, g, S, E, rowtab, wave);
    }
    SEAM(5);
    if (IN(6)) {
        pg8::Gemm g{XB, (const bf16*)(ws + WS_WS), D, D}; pg8::StaticOrder S; S.init(T / 256, P1W / 256, G, bx);
        EpiScale E{PROJ, P1W, SS, nullptr, 0};
        pg8::gemm_phase<EpiScale, pg8::StaticOrder, false>(lds, g, S, E, rowtab, wave);
        { pg8::Gemm g2{(const bf16*)(ws + WS_MEMB), (const bf16*)(ws + WS_WMK) + (size_t)512 * 1024, D, D}; pg8::StaticOrder S2; S2.init(MROWS / 256, 2, G, (bx + G - 128) % G);
          EpiScale E2{(bf16*)(ws + WS_KMEM) + 512, 1024, (const float*)(ws + WS_MEMSS), nullptr, 0};
          pg8::gemm_phase<EpiScale, pg8::StaticOrder, false>(lds, g2, S2, E2, rowtab, wave); }
        { pg8::Gemm g2{(const bf16*)(ws + WS_WMV) + (size_t)512 * 1024, (const bf16*)(ws + WS_MEMB), D, D}; pg8::StaticOrder S2; S2.init(2, MROWS / 256, G, (bx + G - 160) % G);
          EpiVT E2{(bf16*)(ws + WS_VMEMT) + (size_t)512 * MROWS, MROWS, (const float*)(ws + WS_MEMRS)};
          pg8::gemm_phase<EpiVT, pg8::StaticOrder, false>(lds, g2, S2, E2, rowtab, wave); }
    }
    SEAM(6);
    const ssd::Par SP{PROJ, args.in[9], args.in[10], args.in[11], args.in[12], args.in[13], args.in[14], (bf16*)(ws + WS_STATES), (float*)(ws + WS_CDEC)};
    if (IN(7)) { const bool dry = false;
        ssd::phase_a(lds, wave, SP, vcu, G);
        for (int it = vcu; it < BATCH * MEM_H * 8; it += G) {
            const int b = it >> 5, mh = (it >> 3) & 3, qt = it & 7;
            att::attn_unit<false>(lds, wave, PROJ + ((size_t)b * SEQ + 256 * qt) * P1W + 1536 + mh * HD, P1W, (const bf16*)(ws + WS_KMEM) + ((size_t)b * MEM_LEN) * 1024 + 512 + mh * HD, 1024,
                                  (const bf16*)(ws + WS_VMEMT) + (size_t)(512 + mh * HD) * MROWS + b * MEM_LEN, MROWS, 4, 0, nullptr, nullptr, 0, dry);
        }
    }
    SEAM(7);
    if (IN(8)) { ssd::phase_b(SP, bx * NTHR + tid, G * NTHR); }
    SEAM(8);
    if (IN(9)) {
        ssd::phase_c(lds, wave, SP, PROJ, vcu, G);
    }
    SEAM(9);
    if (IN(10)) {
        pg8::Gemm g{PROJ, (const bf16*)(ws + WS_WO) + (size_t)1024 * 2048, P1W, MIXW}; pg8::StaticOrder S; S.init(T / 256, 4, G, bx);
        EpiResid<true, true, false> E{nullptr, nullptr, XB, SS, ws + WS_XB8};
        pg8::gemm_phase<EpiResid<true, true, false>, pg8::StaticOrder, false>(lds, g, S, E, rowtab, wave);
    }
    SEAM(10);
    float* GW = (float*)(ws + WS_GW); int* LIST = (int*)(ws + WS_LIST);
    if (IN(11)) {
        LAS int* e1s = (LAS int*)lds; LAS int* e2s = e1s + 128; LAS int* lr0 = e1s + 256; LAS int* lr1 = e1s + 384; LAS int* basel = e1s + 512;
        const float* wr = args.in[19]; const float* br = args.in[20]; const float* gf = args.in[15] + D;
        f32x4 wa[16], wb[16];
#pragma unroll
        for (int j = 0; j < 4; ++j)
#pragma unroll
            for (int q = 0; q < 4; ++q) { const int k = 256 * j + 4 * lane + q; const float gk = gf[k];
                wa[4 * j + q] = *(const f32x4*)(wr + (size_t)k * 8) * gk; wb[4 * j + q] = *(const f32x4*)(wr + (size_t)k * 8 + 4) * gk; }
        const f32x4 ba = *(const f32x4*)br, bb = *(const f32x4*)(br + 4);
        for (int blk = bx; blk < T / 128; blk += G) {
#pragma unroll 1
            for (int i = 0; i < 16; ++i) {
                const int tl = wave * 16 + i, row = blk * 128 + tl;
                const GAS u32x2* xr = (const GAS u32x2*)(XB + (size_t)row * D) + lane;
                f32x4 a0 = {0.f, 0.f, 0.f, 0.f}, a1 = {0.f, 0.f, 0.f, 0.f}; float s = 0.f;
#pragma unroll
                for (int j = 0; j < 4; ++j) { const u32x2 xw = xr[64 * j]; const f32x4 v = {bflo(xw.x), bfhi(xw.x), bflo(xw.y), bfhi(xw.y)}; s += (v.x * v.x + v.y * v.y) + (v.z * v.z + v.w * v.w);
                    a0 += wa[4 * j] * v.x + wa[4 * j + 1] * v.y + wa[4 * j + 2] * v.z + wa[4 * j + 3] * v.w;
                    a1 += wb[4 * j] * v.x + wb[4 * j + 1] * v.y + wb[4 * j + 2] * v.z + wb[4 * j + 3] * v.w; }
                s = wave_sum(s); const float rs = 1.0f / sqrtf(s * (1.0f / 1024.0f) + EPS);
                float lg[8];
#pragma unroll
                for (int e = 0; e < 4; ++e) { lg[e] = wave_sum(a0[e]) * rs + ba[e]; lg[4 + e] = wave_sum(a1[e]) * rs + bb[e]; }
                int i1 = 0; float l1 = lg[0];
#pragma unroll
                for (int e = 1; e < 8; ++e) if (lg[e] > l1) { l1 = lg[e]; i1 = e; }
                int i2 = -1; float l2 = -__builtin_inff();
#pragma unroll
                for (int e = 0; e < 8; ++e) if (e != i1 && lg[e] > l2) { l2 = lg[e]; i2 = e; }
                const float w1 = 1.0f / (1.0f + expf(l2 - l1));
                if (lane == 0) { e1s[tl] = i1; e2s[tl] = i2; GW[(size_t)row * 2] = w1; GW[(size_t)row * 2 + 1] = 1.0f - w1; ((float*)(ws + WS_RSG))[row] = rs; }
            }
            __syncthreads();
            if (tid < 16) { const int k = tid >> 3, e = tid & 7; int cnt = 0;
                for (int t = 0; t < 128; ++t) { const int ee = k ? e2s[t] : e1s[t]; if (ee == e) { if (k) lr1[t] = cnt; else lr0[t] = cnt; ++cnt; } }
                basel[tid] = (int)__hip_atomic_fetch_add((unsigned*)(ctl + CW_CNT + 64 * tid), (unsigned)cnt, __ATOMIC_RELAXED, __HIP_MEMORY_SCOPE_AGENT); }
            __syncthreads();
            if (tid < 256) { const int k = tid >> 7, t = tid & 127, e = k ? e2s[t] : e1s[t], pos = basel[k * 8 + e] + (k ? lr1[t] : lr0[t]);
                LIST[(size_t)(k * 8 + e) * MOE_CAP + pos] = blk * 128 + t; }
            __syncthreads();
        }
        LAS float* scr = (LAS float*)(lds + 4096 + wave * 16384);
        const int gw = vcu * NWAVES + wave, NGW = G * NWAVES;
        const float* gf1 = args.in[15] + D;
        constexpr int NGU = (1024 / 64) * (7168 / 32), NDN = (FF / 64) * (1024 / 32);
        constexpr int NITE = NEXP * (NGU + NDN);
        const int cvt_c = (NITE + NGW - 1) / NGW, cvt_end = (gw + 1) * cvt_c < NITE ? (gw + 1) * cvt_c : NITE;
        for (int it = gw * cvt_c; it < cvt_end;) {
            const int e = it / (NGU + NDN); int r = it % (NGU + NDN); CVT_DECL()
            CVT_JOB8(args.in[21] + (size_t)e * 1024 * FF, args.in[22] + (size_t)e * 1024 * FF, gf1, ws + WS_WEGU + (size_t)e * 7168 * 1024, FF, 1024, 7168, 0, 1, 7168, F8_SW1)
            CVT_JOB8(args.in[23] + (size_t)e * FF * 1024, nullptr, nullptr, ws + WS_WED + (size_t)e * 1024 * FF, 1024, FF, 1024, 0, 0, 1024, F8_SW2)
            CVT_RUN(it, cvt_end);
        }
        __syncthreads();
    }
    SEAM(11);
#define MOE_TABLES() \
        if (tid < 16) pan[288 + tid] = (int)__hip_atomic_load((unsigned*)(ctl + CW_CNT + 64 * tid), __ATOMIC_RELAXED, __HIP_MEMORY_SCOPE_AGENT); \
        __syncthreads(); \
        int cum[17]; cum[0] = 0; \
        _Pragma("unroll") for (int q = 0; q < 16; ++q) cum[q + 1] = cum[q] + ((pan[288 + q] + 255) >> 8); \
        const int NP = cum[16]; \
        { const int p_ = tid; if (p_ < NP) { int gi = 0; \
            _Pragma("unroll") for (int q = 1; q < 16; ++q) gi += (p_ >= cum[q]) ? 1 : 0; \
            int cg = 0; \
            _Pragma("unroll") for (int q = 0; q < 16; ++q) cg = (q == gi) ? cum[q] : cg; \
            pan[p_] = (gi << 16) | (p_ - cg); } } \
        __syncthreads();
#define MOE_ROWTAB(S) { Unit u; LAS unsigned short* rt = (LAS unsigned short*)(lds + ROWTAB_OFF); \
        for (int i = 0; i < 32 && S.next(i, u); ++i) { const int t_ = tid; \
            if (t_ < 256) { const int gi = pan[u.pm] >> 16, off = (pan[u.pm] & 0xffff) * 256 + t_; rt[u.ui * 256 + t_] = (unsigned short)((off < pan[288 + gi]) ? LIST[(size_t)gi * MOE_CAP + off] : 0xFFFF); } } } \
        __syncthreads();
    if (IN(12)) {
        MOE_TABLES()
        MoeOrder S; S.so.init(NP, 28, G, bx); S.pan = pan; S.npn = 28;
        MOE_ROWTAB(S)
        int kdim = D; asm volatile("" : "+s"(kdim));
        pg8::Gemm g{(const bf16*)(ws + WS_XB8), (const bf16*)(ws + WS_WEGU), D, kdim};
        EpiGateUp<true> E{(bf16*)(ws + WS_ACTM), nullptr, rowtab};
        pg8::gemm_phase<EpiGateUp<true>, MoeOrder, true, false, 1>(lds, g, S, E, rowtab, wave);
    }
    SEAM(12);
    if (IN(13)) {
        MOE_TABLES()
        MoeOrderSplit S; S.so.init(NP, 4, G, bx); S.pan = pan; S.npn = 4;
        MOE_ROWTAB(S)
        pg8::Gemm g{(const bf16*)(ws + WS_ACTM), (const bf16*)(ws + WS_WED), FF, FF};
        float* mscr = (float*)(ws + WS_WM1);
        bf16* yp0 = (bf16*)(ws + WS_YP0);
        const int nsl = S.nsl();
        EpiMoeDown E{yp0, (unsigned)((WS_YP1 - WS_YP0) / 2), GW, pan, rowtab, mscr, nsl};
        pg8::gemm_phase<EpiMoeDown, MoeOrderSplit, false, true, 1>(lds, g, S, E, rowtab, wave);
        const int ntl = S.ntail();
        if (ntl > 0) { xcd_barrier(bar);
            const int gw = vcu * NWAVES + wave, NGW = G * NWAVES, nf = S.nfull();
            for (int ri = gw; ri < ntl * 256; ri += NGW) { const int ti = ri >> 8, r = ri & 255; Unit u; S.so.decode(nf + ti, u);
                const int gi = pan[u.pm] >> 16, k = gi >> 3, off = (pan[u.pm] & 0xffff) * 256 + r;
                if (off < pan[288 + gi]) { const int tok = LIST[(size_t)gi * MOE_CAP + off]; const float w = GW[(size_t)tok * 2 + k] * (1.0f / (F8_SH * F8_SW2));
                    const float* sp = mscr + (size_t)(ti * nsl) * 65536 + r * 256 + 4 * lane; f32x4 a = *(const f32x4*)sp;
                    for (int q = 1; q < nsl; ++q) a += *(const f32x4*)(sp + (size_t)q * 65536);
                    a = a * w; u32x2 t2; t2.x = pk2(a[0], a[1]); t2.y = pk2(a[2], a[3]); *(u32x2*)(yp0 + (size_t)k * ((WS_YP1 - WS_YP0) / 2) + (size_t)tok * D + u.pn * 256 + 4 * lane) = t2; } } }
    }
    SEAM(13);
    if (IN(14)) {
        const int gw = vcu * NWAVES + wave, NGW = G * NWAVES;
        f32x4 gfin[4];
#pragma unroll
        for (int j = 0; j < 4; ++j) gfin[j] = *((const f32x4*)args.in[24] + lane + 64 * j);
        for (int m = gw; m < T; m += NGW) {
            const int ln = lane;
            GAS f32x4* xr = (GAS f32x4*)(out + (size_t)m * D) + ln; f32x4 v[4]; float s = 0.f;
            const GAS u32x2* xs = (const GAS u32x2*)(XB + (size_t)m * D) + ln;
            const GAS u32x2* y0 = (const GAS u32x2*)(ws + WS_YP0 + (size_t)m * D * 2) + ln; const GAS u32x2* y1 = (const GAS u32x2*)(ws + WS_YP1 + (size_t)m * D * 2) + ln;
#pragma unroll
            for (int j = 0; j < 4; ++j) { const u32x2 xw = xs[64 * j]; v[j] = (f32x4){bflo(xw.x), bfhi(xw.x), bflo(xw.y), bfhi(xw.y)}; const u32x2 a = y0[64 * j], b = y1[64 * j];
                v[j].x += bflo(a.x) + bflo(b.x); v[j].y += bfhi(a.x) + bfhi(b.x); v[j].z += bflo(a.y) + bflo(b.y); v[j].w += bfhi(a.y) + bfhi(b.y);
                s += (v[j].x * v[j].x + v[j].y * v[j].y) + (v[j].z * v[j].z + v[j].w * v[j].w); }
            s = wave_sum(s); const float rs = 1.0f / sqrtf(s * (1.0f / 1024.0f) + EPS);
#pragma unroll
            for (int j = 0; j < 4; ++j) xr[64 * j] = v[j] * rs * gfin[j];
        }
    }
#undef IN
#undef SEAM
#undef tid
#undef lane
#undef args
}

extern "C" void kernel_launch(void* const* d_in, const int* in_sizes, int n_in, void* d_out, int out_size, void* d_ws, size_t ws_size, hipStream_t stream) {
    static int grid = 0;
    if (grid == 0) {
        if (n_in != 25 || in_sizes[0] != T * D || out_size != T * D || ws_size < WS_END) { fprintf(stderr, "kernel_launch: unexpected shapes / workspace (n_in %d, ws %zu); nothing launched\n", n_in, ws_size); grid = -1; return; }
        int dev = 0, cus = 0, per_cu = 0;
        if (hipGetDevice(&dev) != hipSuccess || hipDeviceGetAttribute(&cus, hipDeviceAttributeMultiprocessorCount, dev) != hipSuccess) { grid = -1; return; }
        if (hipFuncSetAttribute((const void*)fwd_kernel, hipFuncAttributeMaxDynamicSharedMemorySize, LDS_BYTES) != hipSuccess) { fprintf(stderr, "kernel_launch: hipFuncSetAttribute failed\n"); grid = -1; return; }
        if (hipOccupancyMaxActiveBlocksPerMultiprocessor(&per_cu, (const void*)fwd_kernel, NTHR, LDS_BYTES) != hipSuccess || per_cu < 1) { fprintf(stderr, "kernel_launch: occupancy query says %d\n", per_cu); }
        (void)hipGetLastError();
        grid = cus;
    }
    if (grid < 0) return;
    if (hipMemsetAsync((char*)d_ws, 0, ZERO_BYTES, stream) != hipSuccess) return;
    Args a{};
    for (int i = 0; i < 25; ++i) a.in[i] = (const float*)d_in[i];
    a.out = (float*)d_out; a.ws = (unsigned char*)d_ws;
    a.ph_lo = 0; a.ph_hi = N_PHASES;
    hipLaunchKernelGGL(fwd_kernel, dim3(grid), dim3(NTHR), LDS_BYTES, stream, a);
}
```

```cpp
#include <hip/hip_runtime.h>
#include <cstdio>
#include <cstdint>

#define GAS __attribute__((address_space(1)))
#define LAS __attribute__((address_space(3)))
typedef unsigned short bf16;
typedef short bf16x8 __attribute__((ext_vector_type(8)));
typedef float f32x2 __attribute__((ext_vector_type(2)));
typedef float f32x4 __attribute__((ext_vector_type(4)));
typedef float f32x16 __attribute__((ext_vector_type(16)));
typedef unsigned u32x2 __attribute__((ext_vector_type(2)));
typedef unsigned u32x4 __attribute__((ext_vector_type(4)));
typedef int i32x4 __attribute__((ext_vector_type(4)));
typedef int i32x8 __attribute__((ext_vector_type(8)));
typedef __bf16 bf16x2_t __attribute__((ext_vector_type(2)));
typedef GAS unsigned gu32;

constexpr int D = 1024, BATCH = 16, SEQ = 2048, T = BATCH * SEQ;
constexpr int MEM_LEN = 256, MROWS = BATCH * MEM_LEN;
constexpr int MOBA_H = 12, HD = 128, MOBA_W = 1536, NBLK = 8;
constexpr int MEM_H = 4, MEM_W = 512;
constexpr int SSD_H = 24, SSD_P = 64, SSD_IN = 1536, SSD_G = 4, SSD_N = 128, SSD_CH = 128, NCHUNK = SEQ / SSD_CH, CONV_DIM = 2560;
constexpr int IN_MOBA = 5120, IN_SSD = 4632, MIXW = 2048, FF = 3584, NEXP = 8;
constexpr int P0W = 3584;
constexpr int P1W = 4864;
constexpr int P1_XBC = 2048, P1_DT = 4608;
constexpr float EPS = 1e-6f;
constexpr float LOG2E = 1.4426950408889634f;
constexpr int MOE_CAP = T;
constexpr int MOE_MAXP = 272;

constexpr size_t MiB = 1u << 20;
constexpr size_t WS_CTL = 0, WS_KMEAN = 1 * MiB, ZERO_BYTES = 2 * MiB;
constexpr size_t WS_SS = 2 * MiB;
constexpr size_t WS_MEMSS = 4 * MiB;
constexpr size_t WS_GW = 5 * MiB;
constexpr size_t WS_LIST = 6 * MiB;
constexpr size_t WS_CDEC = 8 * MiB;
constexpr size_t WS_WM1 = 9 * MiB;
constexpr size_t WS_WV = 16 * MiB;
constexpr size_t WS_WS = 19 * MiB;
constexpr size_t WS_WMK = 29 * MiB;
constexpr size_t WS_WMV = 31 * MiB;
constexpr size_t WS_WO = 33 * MiB;
constexpr size_t WS_WGU = 41 * MiB;
constexpr size_t WS_WD = 55 * MiB;
constexpr size_t WS_MEMB = 62 * MiB;
constexpr size_t WS_KMEM = 70 * MiB;
constexpr size_t WS_VMEMT = 78 * MiB;
constexpr size_t WS_XB = 86 * MiB;
constexpr size_t WS_BIG = 150 * MiB;
constexpr size_t WS_PROJ = WS_BIG;
constexpr size_t WS_VT = 374 * MiB;
constexpr size_t WS_ACT = WS_BIG;
constexpr size_t WS_STATES = 454 * MiB;
constexpr size_t WS_ACTM = WS_BIG;
constexpr size_t WS_WED = 388 * MiB;
constexpr size_t WS_WEGU = 416 * MiB;
constexpr size_t WS_XB8 = 472 * MiB;
constexpr size_t WS_YP0 = 416 * MiB;
constexpr size_t WS_YP1 = 480 * MiB;
constexpr size_t WS_RSG = 544 * MiB;
constexpr size_t WS_END = 555 * MiB;
static_assert(WS_PROJ + (size_t)T * P0W * 2 <= WS_VT && WS_VT + (size_t)MOBA_W * T * 2 <= 470 * MiB, "layer 0 map");
static_assert(WS_PROJ + (size_t)T * P1W * 2 <= WS_STATES && WS_STATES + (size_t)BATCH * NCHUNK * SSD_H * SSD_P * SSD_N * 2 <= 550 * MiB, "layer 1 map");
static_assert(WS_ACTM + (size_t)MOE_MAXP * 256 * FF <= WS_WED && WS_WED + (size_t)NEXP * 1024 * FF <= WS_WEGU && WS_WEGU + (size_t)NEXP * 7168 * 1024 <= WS_XB8 && WS_XB8 + (size_t)T * D <= WS_RSG && WS_YP0 + (size_t)T * D * 2 <= WS_YP1 && WS_YP1 + (size_t)T * D * 2 <= WS_RSG && WS_RSG + (size_t)T * 4 <= WS_END && WS_XB8 >= WS_PROJ + (size_t)T * P1W * 2, "moe map");
constexpr int CW_BAR = 4096;
constexpr int CW_CNT = 16384;

constexpr int RING_BYTES = 131072;
constexpr int MISC_OFF = RING_BYTES;
constexpr int PAN_OFF = RING_BYTES + 1024;
constexpr int ROWTAB_OFF = RING_BYTES + 3072;
constexpr int LDS_BYTES = ROWTAB_OFF + 16 * 1024 + 4096;
constexpr int NWAVES = 8, NTHR = 512;

__device__ __forceinline__ unsigned pk2(float lo, float hi) { f32x2 v = {lo, hi}; bf16x2_t b = __builtin_convertvector(v, bf16x2_t); return __builtin_bit_cast(unsigned, b); }
__device__ __forceinline__ float bf2f(unsigned short b) { return __uint_as_float(((unsigned)b) << 16); }
__device__ __forceinline__ float bflo(unsigned w) { return __uint_as_float(w << 16); }
__device__ __forceinline__ float bfhi(unsigned w) { return __uint_as_float(w & 0xffff0000u); }
__device__ __forceinline__ float fast_exp2(float x) { return __builtin_amdgcn_exp2f(x); }
__device__ __forceinline__ float fast_rcp(float x) { return __builtin_amdgcn_rcpf(x); }
__device__ __forceinline__ float silu_f(float x) { return x * fast_rcp(1.0f + fast_exp2(-x * LOG2E)); }
__device__ __forceinline__ float wave_sum(float v) {
#pragma unroll
    for (int o = 1; o < 64; o <<= 1) v += __shfl_xor(v, o);
    return v;
}
__device__ __forceinline__ int opaque_tid(int wv) { int l = __builtin_amdgcn_mbcnt_hi(~0u, __builtin_amdgcn_mbcnt_lo(~0u, 0u)); asm volatile("" : "+v"(l)); return wv * 64 + l; }
struct Args { const float* in[25]; float* out; unsigned char* ws; int ph_lo, ph_hi; };
static_assert(sizeof(Args) == 25 * 8 + 8 + 8 + 8, "Args has no padding");

typedef const __attribute__((address_space(4))) Args* kargs_t;
__device__ __forceinline__ kargs_t kargs() { kargs_t p = (kargs_t)__builtin_amdgcn_kernarg_segment_ptr(); asm volatile("" : "+s"(p)); return p; }
#define LDS_WAIT() asm volatile("s_waitcnt lgkmcnt(0)" ::: "memory")
#define VM_WAIT() asm volatile("s_waitcnt vmcnt(0)" ::: "memory")
#define MFMA32(a, b, c) __builtin_amdgcn_mfma_f32_32x32x16_bf16((a), (b), (c), 0, 0, 0)

#define XB_TMO      128
#define XB_XCNT(j)  (256  + 64 * (j))
#define XB_XSUB(j)  (1280 + 64 * (j))
#define XB_XGEN(j)  (2304 + 64 * (j))
#define XB_TOP      3328
#define XB_TOPGEN   3392
#define XCD_BAR_WORDS 3456
#define XB_SPIN_CAP (1u << 18)

__device__ __forceinline__ unsigned xb_ld(unsigned* p)              { return __hip_atomic_load(p, __ATOMIC_RELAXED, __HIP_MEMORY_SCOPE_AGENT); }
__device__ __forceinline__ unsigned xb_add(unsigned* p, unsigned v) { return __hip_atomic_fetch_add(p, v, __ATOMIC_RELAXED, __HIP_MEMORY_SCOPE_AGENT); }
__device__ __forceinline__ unsigned xb_xcc_id() { return (unsigned)__builtin_amdgcn_s_getreg((3 << 11) | 20) & 0xFu; }
#define XB_SPIN(cond, bar) do { unsigned _sp = 0; while (cond) { __builtin_amdgcn_s_sleep(1); \
    if ((++_sp & 255u) == 0u) { if (xb_ld(&(bar)[XB_TMO])) break; if (_sp > XB_SPIN_CAP) { atomicAdd(&(bar)[XB_TMO], 1u); break; } } } } while (0)

struct XcdBarrier {
    unsigned* bar; unsigned x;
    volatile LAS unsigned* st;
};

__device__ __forceinline__ XcdBarrier xcd_barrier_post(unsigned* bar, volatile LAS unsigned* st) {
    XcdBarrier b; b.bar = bar; b.x = xb_xcc_id(); b.st = st;
    if (threadIdx.x == 0) (void)xb_add(&bar[XB_XCNT(b.x)], 1u);
    return b;
}
__device__ __forceinline__ void xcd_barrier_complete(unsigned* bar, unsigned x, unsigned& nloc, unsigned& nx) {
    const unsigned G = gridDim.x * gridDim.y * gridDim.z;
    unsigned sum, cnt, mine, sp = 0u;
    for (;;) {
        sum = 0u; cnt = 0u; mine = 0u;
#pragma unroll
        for (unsigned j = 0; j < 16; ++j) { const unsigned c = xb_ld(&bar[XB_XCNT(j)]); sum += c; cnt += (c > 0u) ? 1u : 0u; mine = (j == x) ? c : mine; }
        if (sum == G) break;
        __builtin_amdgcn_s_sleep(1);
        if ((++sp & 255u) == 0u) { if (xb_ld(&bar[XB_TMO])) break; if (sp > XB_SPIN_CAP) { atomicAdd(&bar[XB_TMO], 1u); break; } }
    }
    nloc = mine > 0u ? mine : 1u; nx = cnt > 0u ? cnt : 1u;
}

__device__ __forceinline__ void xcd_barrier(const XcdBarrier& b) {
    asm volatile("s_waitcnt vmcnt(0)" ::: "memory");
    __syncthreads();
    if (threadIdx.x == 0) {
        unsigned* bar = b.bar;
        __builtin_amdgcn_s_waitcnt(0);
        unsigned nloc = b.st[0], nx = b.st[1];
        if (nloc == 0u) { xcd_barrier_complete(bar, b.x, nloc, nx); b.st[0] = nloc; b.st[1] = nx; }
        const unsigned old = xb_add(&bar[XB_XSUB(b.x)], 1u);
        const unsigned gen = old / nloc;
        if (old + 1u == (gen + 1u) * nloc) {
            __builtin_amdgcn_fence(__ATOMIC_RELEASE, "agent");
            asm volatile("s_waitcnt vmcnt(0)" ::: "memory");
            const unsigned og = xb_add(&bar[XB_TOP], 1u);
            const unsigned tg = og / nx;
            if (og + 1u == (tg + 1u) * nx) xb_add(&bar[XB_TOPGEN], 1u);
            else XB_SPIN(xb_ld(&bar[XB_TOPGEN]) == tg, bar);
            __builtin_amdgcn_fence(__ATOMIC_ACQUIRE, "agent");
            xb_add(&bar[XB_XGEN(b.x)], 1u);
            asm volatile("s_waitcnt vmcnt(0)" ::: "memory");
        } else {
            XB_SPIN(xb_ld(&bar[XB_XGEN(b.x)]) == gen, bar);
            __builtin_amdgcn_fence(__ATOMIC_ACQUIRE, "agent");
            asm volatile("s_waitcnt vmcnt(0)" ::: "memory");
        }
    }
    __syncthreads();
}


namespace pg8 {
constexpr int BM = 256, BK = 64, HALF = 128, HTB = HALF * BK * 2, STAGE_BYTES = 8 * HTB, NXCD = 8, WGM = 8;
__host__ __device__ __forceinline__ int lds_byte(int r, int c) { const int st = (r >> 4) * 2 + (c >> 5), rr = r & 15, cc = c & 31, ob = rr * 64 + cc * 2; return st * 1024 + (ob ^ (((ob >> 9) & 1) << 5)); }
__host__ __device__ __forceinline__ void stage_rc(int b, int& R, int& C) { const int st = b / 1024, sb = b % 1024, swz = sb ^ (((sb >> 9) & 1) << 5); R = (st >> 1) * 16 + swz / 64; C = (st & 1) * 32 + (swz % 64) / 2; }
__host__ __device__ __forceinline__ int perm32(int rho) { const int n = rho >> 4, i = rho & 15; return 8 * (i >> 2) + 4 * n + (i & 3); }

struct Unit { int pm, pn, ui, kt0, nkt, ti; };
struct Gemm { const bf16* A; const bf16* Bt; int lda, K; };

struct StaticOrder {
    int nM, nN, nwg, G, c;
    __device__ __forceinline__ void init(int nM_, int nN_, int G_, int c_) { nM = nM_; nN = nN_; nwg = nM * nN; G = G_; c = c_; }
    __device__ __forceinline__ void decode(int wgid, Unit& u) const {
        { const int q = nwg / NXCD, r = nwg % NXCD, xcd = wgid % NXCD, off = wgid / NXCD; wgid = (xcd < r ? xcd * (q + 1) : r * (q + 1) + (xcd - r) * q) + off; }
        const int nig = WGM * nN, gid = wgid / nig, fm = gid * WGM, gsz = (nM - fm) < WGM ? (nM - fm) : WGM;
        u.pm = fm + ((wgid % nig) % gsz); u.pn = (wgid % nig) / gsz;
    }
    __device__ __forceinline__ bool next(int i, Unit& u) const {
        const int L = i * G + c; if (L >= nwg) return false;
        decode(L, u); u.ui = i; u.kt0 = 0; u.nkt = 0; u.ti = -1; return true;
    }
};

template <class Epi, class Sched, bool GATHER, bool KSPLIT = false, int ESZ = 2>
__device__ __forceinline__ void gemm_phase(LAS unsigned char* lds, const Gemm g, const Sched& S, const Epi& E, const LAS unsigned short* rowtab, int wv) {
    const int tid = opaque_tid(wv), wid = wv, lane = tid & 63, wr = wid >> 2, wc = wid & 3, fr = lane & 15, fq = lane >> 4;
    const int K = g.K, nt = K * ESZ / 128, lda = g.lda;
    unsigned voffB[2];
    unsigned vA00, vA01, vA10, vA11;
#pragma unroll
    for (int i = 0; i < 2; ++i) { int R, C; stage_rc(tid * 16 + i * 8192, R, C); const int Rb = Epi::PERM ? ((R & ~31) + perm32(R & 31)) : R;
        voffB[i] = (unsigned)(Rb * K * ESZ + C * 2); }
#define PG8_RC() int RA0, CA0, RA1, CA1; { int t_ = tid; asm volatile("" : "+v"(t_)); stage_rc(t_ * 16, RA0, CA0); stage_rc(t_ * 16 + 8192, RA1, CA1); }
    const size_t kstep = (size_t)(BK * 2);
    const size_t hstepB = (size_t)HALF * K * ESZ, tstepB = 2 * hstepB;
    const size_t tstepA = (size_t)BM * lda * ESZ;
    const size_t hA = GATHER ? 0 : (size_t)HALF * lda * ESZ;
    const unsigned ldsw = (unsigned)wid * 1024u;
    const int aoff = lds_byte(wr * 64 + fr, fq * 8), boff = lds_byte(wc * 32 + fr, fq * 8);
#define PG8_SA(b, h) (((b) * 2 + (h)) * HTB)
#define PG8_SB(b, h) ((4 + (b) * 2 + (h)) * HTB)
#define PG8_GLDS(gptr, ldsoff) __builtin_amdgcn_global_load_lds((const unsigned*)(gptr), (LAS unsigned*)(lds + (ldsoff)), 16, 0, 0)
#define PG8_GLDS_S(gbase, voff, ldsoff) do { unsigned keep_; asm volatile("s_mov_b32 %0, m0\n\ts_mov_b32 m0, %3\n\ts_nop 0\n\tglobal_load_lds_dwordx4 %1, %2\n\ts_mov_b32 m0, %0" \
        : "=&s"(keep_) : "v"(voff), "s"(gbase), "s"((unsigned)(size_t)(lds + (ldsoff))) : "memory"); } while (0)
#define PG8_STAGE_B(bufoff, gbase) do { if constexpr (ESZ == 1) { PG8_GLDS_S((const char*)(gbase), voffB[0], (bufoff) + ldsw); PG8_GLDS_S((const char*)(gbase) + (size_t)64 * K * ESZ, voffB[0], (bufoff) + ldsw + 8192); } \
        else { PG8_GLDS((const char*)(gbase) + voffB[0], (bufoff) + ldsw); PG8_GLDS((const char*)(gbase) + voffB[1], (bufoff) + ldsw + 8192); } } while (0)
#define PG8_STAGE_A(bufoff, gbase, v0, v1) do { if constexpr (ESZ == 1) { PG8_GLDS_S((const char*)(gbase), (v0), (bufoff) + ldsw); \
            if constexpr (GATHER) PG8_GLDS_S((const char*)(gbase), (v1), (bufoff) + ldsw + 8192); else PG8_GLDS_S((const char*)(gbase) + (size_t)64 * lda * ESZ, (v0), (bufoff) + ldsw + 8192); } \
        else { PG8_GLDS((const char*)(gbase) + (v0), (bufoff) + ldsw); PG8_GLDS((const char*)(gbase) + (v1), (bufoff) + ldsw + 8192); } } while (0)
#define PG8_STAGE_AG(bufoff, gbase, half, uix, v0, v1) do { if constexpr (GATHER) { const LAS unsigned short* q_ = rtp0 + (uix) * 256 + (half) * 128; int t0_ = q_[0], t1_ = q_[64]; \
            t0_ = t0_ == 0xFFFF ? 0 : t0_; t1_ = t1_ == 0xFFFF ? 0 : t1_;        \
            PG8_GLDS_S((const char*)(gbase), (unsigned)(t0_ * lda * ESZ) + cb2, (bufoff) + ldsw); PG8_GLDS_S((const char*)(gbase), (unsigned)(t1_ * lda * ESZ) + cb2, (bufoff) + ldsw + 8192); } \
        else PG8_STAGE_A(bufoff, (gbase) + ((half) ? hA : 0), v0, v1); } while (0)
#define PG8_LDA(dst, b, h) do { _Pragma("unroll") for (int m = 0; m < 4; ++m) { \
        if constexpr (ESZ == 2) { _Pragma("unroll") for (int k = 0; k < 2; ++k) dst[m][k] = *(const LAS bf16x8*)(lds + PG8_SA(b, h) + aoff + m * 2048 + k * 1024); } \
        else dst##8[m] = __builtin_shufflevector(*(const LAS i32x4*)(lds + PG8_SA(b, h) + aoff + m * 2048), *(const LAS i32x4*)(lds + PG8_SA(b, h) + aoff + m * 2048 + 1024), 0, 1, 2, 3, 4, 5, 6, 7); } } while (0)
#define PG8_LDB(dst, b, h) do { _Pragma("unroll") for (int n = 0; n < 2; ++n) { \
        if constexpr (ESZ == 2) { _Pragma("unroll") for (int k = 0; k < 2; ++k) dst[n][k] = *(const LAS bf16x8*)(lds + PG8_SB(b, h) + boff + n * 2048 + k * 1024); } \
        else dst##8[n] = __builtin_shufflevector(*(const LAS i32x4*)(lds + PG8_SB(b, h) + boff + n * 2048), *(const LAS i32x4*)(lds + PG8_SB(b, h) + boff + n * 2048 + 1024), 0, 1, 2, 3, 4, 5, 6, 7); } } while (0)
#define PG8_MMA(ai, bj, At, Bt) do { __builtin_amdgcn_s_setprio(1); _Pragma("unroll") for (int m = 0; m < 4; ++m) _Pragma("unroll") for (int n = 0; n < 2; ++n) { \
        if constexpr (ESZ == 2) { _Pragma("unroll") for (int k = 0; k < 2; ++k) acc[ai][bj][m][n] = __builtin_amdgcn_mfma_f32_16x16x32_bf16(Bt[n][k], At[m][k], acc[ai][bj][m][n], 0, 0, 0); } \
        else acc[ai][bj][m][n] = __builtin_amdgcn_mfma_scale_f32_16x16x128_f8f6f4(Bt##8[n], At##8[m], acc[ai][bj][m][n], 0, 0, 0, 0, 0, 0); } \
        __builtin_amdgcn_s_setprio(0); } while (0)
#define PG8_WAIT_V(n) asm volatile("s_waitcnt vmcnt(" #n ")" ::: "memory")
#define PG8_WAIT_L(n) asm volatile("s_waitcnt lgkmcnt(" #n ")" ::: "memory")
#define PG8_BAR __builtin_amdgcn_s_barrier()
#define PG8_SCHED __builtin_amdgcn_sched_barrier(0)
    Unit cur, nxt; int ui = 0;
    if (!S.next(0, cur)) return;
    f32x4 acc[2][2][4][2];
#pragma unroll
    for (int a = 0; a < 2; ++a)
#pragma unroll
        for (int b = 0; b < 2; ++b)
#pragma unroll
            for (int m = 0; m < 4; ++m)
#pragma unroll
                for (int n = 0; n < 2; ++n) acc[a][b][m][n] = (f32x4){0.f, 0.f, 0.f, 0.f};
    bf16x8 At[4][2], B0[2][2], B1[2][2];
    i32x8 At8[4], B08[2], B18[2];
    const char* cA; const char* cB = (const char*)g.Bt + (size_t)cur.pn * tstepB + (KSPLIT ? (size_t)cur.kt0 * kstep : 0);
    const LAS unsigned short* rtp0 = rowtab; unsigned cb2 = 0;
    if constexpr (GATHER) {
        static_assert(!GATHER || ESZ == 1, "gathered A rows: fp8 body only");
        cA = (const char*)g.A; PG8_RC();
        rtp0 = rowtab + RA0; cb2 = (unsigned)(CA0 * 2); vA00 = vA01 = vA10 = vA11 = 0;
    } else {
        cA = (const char*)g.A + (size_t)cur.pm * tstepA + (KSPLIT ? (size_t)cur.kt0 * kstep : 0); PG8_RC();
        vA00 = (unsigned)(RA0 * lda * ESZ + CA0 * 2); vA01 = (unsigned)(RA1 * lda * ESZ + CA1 * 2);
        vA10 = vA00; vA11 = vA01;
    }
    PG8_STAGE_B(PG8_SB(0, 0), cB); PG8_STAGE_B(PG8_SB(0, 1), cB + hstepB); PG8_STAGE_AG(PG8_SA(0, 0), cA, 0, cur.ui, vA00, vA01); PG8_STAGE_AG(PG8_SA(0, 1), cA, 1, cur.ui, vA10, vA11);
    if (wr == 1) PG8_BAR;
    PG8_WAIT_V(2); PG8_BAR;
    PG8_STAGE_B(PG8_SB(1, 0), cB + kstep); PG8_STAGE_AG(PG8_SA(1, 0), cA + kstep, 0, cur.ui, vA00, vA01); PG8_STAGE_B(PG8_SB(1, 1), cB + hstepB + kstep);
    PG8_WAIT_V(6); PG8_BAR;
    for (;;) {
        const bool has_next = S.next(ui + 1, nxt);
        const char* nA; const char* nB = has_next ? (const char*)g.Bt + (size_t)nxt.pn * tstepB + (KSPLIT ? (size_t)nxt.kt0 * kstep : 0) : cB;
        const int cnt = KSPLIT ? cur.nkt : nt;
        if constexpr (GATHER) {
            nA = cA;
        } else {
            nA = has_next ? (const char*)g.A + (size_t)nxt.pm * tstepA + (KSPLIT ? (size_t)nxt.kt0 * kstep : 0) : cA;
        }
        for (int t = 0; t < cnt; t += 2) {
            const bool last = (t == cnt - 2);
            const char* a1 = cA + (size_t)(t + 1) * kstep;
            const char* a2 = last ? nA : cA + (size_t)(t + 2) * kstep; const char* b2 = last ? nB : cB + (size_t)(t + 2) * kstep;
            const char* a3 = a2 + kstep; const char* b3 = b2 + kstep;
            unsigned w00 = vA00, w01 = vA01, w10 = vA10, w11 = vA11;
            const int uiN = (last && has_next) ? nxt.ui : cur.ui;
            PG8_LDB(B0, 0, 0); PG8_LDB(B1, 0, 1); PG8_SCHED; PG8_LDA(At, 0, 0); PG8_STAGE_AG(PG8_SA(1, 1), a1, 1, cur.ui, vA10, vA11);
            PG8_WAIT_V(8); PG8_WAIT_L(0); PG8_BAR; PG8_MMA(0, 0, At, B0); PG8_MMA(0, 1, At, B1); PG8_BAR; PG8_SCHED;
            PG8_LDA(At, 0, 1); PG8_STAGE_B(PG8_SB(0, 0), b2); PG8_STAGE_B(PG8_SB(0, 1), b2 + hstepB); PG8_STAGE_AG(PG8_SA(0, 0), a2, 0, uiN, w00, w01);
            PG8_WAIT_V(8); PG8_WAIT_L(0); PG8_BAR; PG8_MMA(1, 0, At, B0); PG8_MMA(1, 1, At, B1); PG8_BAR; PG8_SCHED;
            PG8_LDB(B0, 1, 0); PG8_LDB(B1, 1, 1); PG8_SCHED; PG8_LDA(At, 1, 0); PG8_STAGE_AG(PG8_SA(0, 1), a2, 1, uiN, w10, w11);
            PG8_WAIT_V(8); PG8_WAIT_L(0); PG8_BAR; PG8_MMA(0, 0, At, B0); PG8_MMA(0, 1, At, B1); PG8_BAR; PG8_SCHED;
            PG8_LDA(At, 1, 1); PG8_STAGE_B(PG8_SB(1, 0), b3); PG8_STAGE_B(PG8_SB(1, 1), b3 + hstepB); PG8_STAGE_AG(PG8_SA(1, 0), a3, 0, uiN, w00, w01);
            PG8_WAIT_V(8); PG8_WAIT_L(0); PG8_BAR; PG8_MMA(1, 0, At, B0); PG8_MMA(1, 1, At, B1); PG8_BAR; PG8_SCHED;
        }
        if (wr == 0) PG8_BAR;
        if constexpr (ESZ == 1) { const int l2_ = opaque_tid(wv) & 63; E(acc, cur, wr, wc, l2_ & 15, l2_ >> 4); }
        else E(acc, cur, wr, wc, fr, fq);
        if (!has_next) break;
#pragma unroll
        for (int a = 0; a < 2; ++a)
#pragma unroll
            for (int b = 0; b < 2; ++b)
#pragma unroll
                for (int m = 0; m < 4; ++m)
#pragma unroll
                    for (int n = 0; n < 2; ++n) acc[a][b][m][n] = (f32x4){0.f, 0.f, 0.f, 0.f};
        cur = nxt; cA = nA; cB = nB; ++ui;
        if (wr == 1) PG8_BAR;
    }
    PG8_WAIT_V(0);
    PG8_BAR;
#undef PG8_SA
#undef PG8_SB
#undef PG8_GLDS
#undef PG8_RC
#undef PG8_GLDS_S
#undef PG8_STAGE_A
#undef PG8_STAGE_AG
#undef PG8_STAGE_B
#undef PG8_LDA
#undef PG8_LDB
#undef PG8_MMA
#undef PG8_WAIT_V
#undef PG8_WAIT_L
#undef PG8_BAR
#undef PG8_SCHED
}
}

constexpr int MOE_NKT = FF / 128;
#ifndef MOE_NSLICE
#define MOE_NSLICE 7
#endif
using pg8::Unit;
__device__ __forceinline__ f32x4 row_ss_load(const float* SS, int row, int fq) { return *(const f32x4*)(SS + (unsigned)(row * 16 + 4 * fq)); }
__device__ __forceinline__ float row_rs_from(const f32x4 p) {
    float s = (p.x + p.y) + (p.z + p.w);
    s += __shfl_xor(s, 16); s += __shfl_xor(s, 32);
    return __builtin_amdgcn_rsqf(s + 1024.0f * EPS) * 32.0f;
}
constexpr float F8_SX = 8.f, F8_SW1 = 64.f, F8_SH = 4.f, F8_SW2 = 128.f;
template <bool CLAMP = false> __device__ __forceinline__ unsigned pk4_fp8(float a, float b, float c, float d) {
    if (CLAMP) { a = __builtin_amdgcn_fmed3f(a, -448.f, 448.f); b = __builtin_amdgcn_fmed3f(b, -448.f, 448.f); c = __builtin_amdgcn_fmed3f(c, -448.f, 448.f); d = __builtin_amdgcn_fmed3f(d, -448.f, 448.f); }
    int r = 0; r = __builtin_amdgcn_cvt_pk_fp8_f32(a, b, r, false); r = __builtin_amdgcn_cvt_pk_fp8_f32(c, d, r, true); return (unsigned)r; }
__device__ __forceinline__ u32x4 pack8(const f32x4 a, const f32x4 b) { u32x4 w; w.x = pk2(a[0], a[1]); w.y = pk2(a[2], a[3]); w.z = pk2(b[0], b[1]); w.w = pk2(b[2], b[3]); return w; }

constexpr float ATT_QSCALE = 0.08838834764831845f * LOG2E;
struct EpiScale {
    static constexpr bool PERM = true;
    bf16* O; int ldc; const float* SS; float* kmean; int kcol0; int qp0, qp1;
    __device__ __forceinline__ void operator()(const f32x4 (&acc)[2][2][4][2], const Unit& u, int wr, int wc, int fr, int fq) const {
        const int row0 = u.pm * 256 + wr * 64 + fr, col0 = u.pn * 256 + wc * 32 + 8 * fq;
        const bool dok = (kmean != nullptr) && (u.pn * 256 >= kcol0);
        const float qsc = (u.pn >= qp0 && u.pn < qp1) ? ATT_QSCALE : 1.0f;
        f32x4 ks[2][2];
#pragma unroll
        for (int bj = 0; bj < 2; ++bj)
#pragma unroll
            for (int n = 0; n < 2; ++n) ks[bj][n] = (f32x4){0.f, 0.f, 0.f, 0.f};
        f32x4 pp[2][4];
#pragma unroll
        for (int ai = 0; ai < 2; ++ai)
#pragma unroll
            for (int m = 0; m < 4; ++m) pp[ai][m] = row_ss_load(SS, row0 + ai * 128 + m * 16, fq);
#pragma unroll
        for (int ai = 0; ai < 2; ++ai)
#pragma unroll
            for (int m = 0; m < 4; ++m) {
                const int row = row0 + ai * 128 + m * 16; const float rs = row_rs_from(pp[ai][m]) * qsc;
                bf16* rowp = O + (size_t)row * ldc + col0;
#pragma unroll
                for (int bj = 0; bj < 2; ++bj) { const f32x4 v0 = acc[ai][bj][m][0] * rs, v1 = acc[ai][bj][m][1] * rs;
                    ks[bj][0] += v0; ks[bj][1] += v1;
                    *(u32x4*)(rowp + bj * 128) = pack8(v0, v1); }
            }
        if (dok) {
#pragma unroll
            for (int bj = 0; bj < 2; ++bj)
#pragma unroll
                for (int n = 0; n < 2; ++n)
#pragma unroll
                    for (int j = 0; j < 4; ++j) { float v = ks[bj][n][j];
                        v += __shfl_xor(v, 1); v += __shfl_xor(v, 2); v += __shfl_xor(v, 4); v += __shfl_xor(v, 8);
                        if (fr == 0) unsafeAtomicAdd(kmean + (size_t)u.pm * MOBA_W + (col0 + bj * 128 + 4 * n + j - kcol0), v); }
        }
    }
};
struct EpiVT {
    static constexpr bool PERM = true;
    bf16* O; int ldc; const float* RS;
    __device__ __forceinline__ void operator()(const f32x4 (&acc)[2][2][4][2], const Unit& u, int wr, int wc, int fr, int fq) const {
        const int row0 = u.pm * 256 + wr * 64 + fr, col0 = u.pn * 256 + wc * 32 + 8 * fq;
        f32x4 rs[2][2];
#pragma unroll
        for (int bj = 0; bj < 2; ++bj) { rs[bj][0] = *(const f32x4*)(RS + col0 + bj * 128); rs[bj][1] = *(const f32x4*)(RS + col0 + bj * 128 + 4); }
#pragma unroll
        for (int ai = 0; ai < 2; ++ai)
#pragma unroll
            for (int m = 0; m < 4; ++m) {
                bf16* rowp = O + (size_t)(row0 + ai * 128 + m * 16) * ldc + col0;
#pragma unroll
                for (int bj = 0; bj < 2; ++bj) *(u32x4*)(rowp + bj * 128) = pack8(acc[ai][bj][m][0] * rs[bj][0], acc[ai][bj][m][1] * rs[bj][1]);
            }
    }
};
template <bool F8, bool BASEBF, bool WF32> struct EpiResid {
    static constexpr bool PERM = true;
    const float* base; float* out; bf16* xb; float* SS; unsigned char* xb8;
    __device__ __forceinline__ void operator()(const f32x4 (&acc)[2][2][4][2], const Unit& u, int wr, int wc, int fr, int fq) const {
        const int row0 = u.pm * 256 + wr * 64 + fr, col0 = u.pn * 256 + wc * 32 + 8 * fq;
        static_assert(BASEBF, "EpiResid: the residual base is the bf16 stream");
        u32x4 bw[2][4][2];
#pragma unroll
        for (int ai = 0; ai < 2; ++ai)
#pragma unroll
            for (int m = 0; m < 4; ++m)
#pragma unroll
                for (int bj = 0; bj < 2; ++bj) bw[ai][m][bj] = *(const u32x4*)(xb + (unsigned)((row0 + ai * 128 + m * 16) * D + col0 + bj * 128));
#pragma unroll
        for (int ai = 0; ai < 2; ++ai)
#pragma unroll
            for (int m = 0; m < 4; ++m) {
                const int row = row0 + ai * 128 + m * 16; const unsigned off = (unsigned)(row * D + col0); float sq = 0.f;
#pragma unroll
                for (int bj = 0; bj < 2; ++bj) {
                    const u32x4 b = bw[ai][m][bj];
                    const f32x4 b0 = (f32x4){bflo(b.x), bfhi(b.x), bflo(b.y), bfhi(b.y)}, b1 = (f32x4){bflo(b.z), bfhi(b.z), bflo(b.w), bfhi(b.w)};
                    const f32x4 v0 = acc[ai][bj][m][0] + b0, v1 = acc[ai][bj][m][1] + b1;
                    if (WF32) { *(f32x4*)(out + off + bj * 128) = v0; *(f32x4*)(out + off + bj * 128 + 4) = v1; }
                    else *(u32x4*)(xb + off + bj * 128) = pack8(v0, v1);
                    if (F8) { u32x2 t8; t8.x = pk4_fp8(v0[0] * F8_SX, v0[1] * F8_SX, v0[2] * F8_SX, v0[3] * F8_SX); t8.y = pk4_fp8(v1[0] * F8_SX, v1[1] * F8_SX, v1[2] * F8_SX, v1[3] * F8_SX); *(u32x2*)(xb8 + off + bj * 128) = t8; }
                    sq += (v0[0] * v0[0] + v0[1] * v0[1]) + (v0[2] * v0[2] + v0[3] * v0[3]) + (v1[0] * v1[0] + v1[1] * v1[1]) + (v1[2] * v1[2] + v1[3] * v1[3]);
                }
                sq += __shfl_xor(sq, 16); sq += __shfl_xor(sq, 32);
                if (fq == 0) SS[(unsigned)(row * 16 + u.pn * 4 + wc)] = sq;
            }
    }
};
template <bool MOE> struct EpiGateUp {
    static constexpr bool PERM = true;
    bf16* O; const float* SS; const LAS unsigned short* rowtab;
    __device__ __forceinline__ void operator()(const f32x4 (&acc)[2][2][4][2], const Unit& u, int wr, int wc, int fr, int fq) const {
        if (MOE) asm volatile("" : "+v"(fr), "+v"(fq));
        const int pnl = MOE ? (u.pn % 28) : u.pn, colo = pnl * 128 + wc * 32 + 8 * fq;
        f32x4 pp[2][4]; float rsm[2][4];
        const float* rsg_ = MOE ? (const float*)((*kargs()).ws + WS_RSG) : nullptr;
#pragma unroll
        for (int ai = 0; ai < 2; ++ai)
#pragma unroll
            for (int m = 0; m < 4; ++m) { const int orow = u.pm * 256 + ai * 128 + wr * 64 + m * 16 + fr;
                if (MOE) { int tk_ = rowtab[u.ui * 256 + ai * 128 + wr * 64 + m * 16 + fr]; tk_ = tk_ == 0xFFFF ? 0 : tk_; rsm[ai][m] = rsg_[(unsigned)tk_]; } else pp[ai][m] = row_ss_load(SS, orow, fq); }
#pragma unroll
        for (int ai = 0; ai < 2; ++ai)
#pragma unroll
            for (int m = 0; m < 4; ++m) {
                const int rl = ai * 128 + wr * 64 + m * 16 + fr, orow = u.pm * 256 + rl;
                const float rs = MOE ? rsm[ai][m] * (1.0f / (F8_SX * F8_SW1)) : row_rs_from(pp[ai][m]);
                const f32x4 g0 = acc[ai][0][m][0] * rs, g1 = acc[ai][0][m][1] * rs, u0 = acc[ai][1][m][0] * rs, u1 = acc[ai][1][m][1] * rs;
                f32x4 h0, h1;
#pragma unroll
                for (int j = 0; j < 4; ++j) { h0[j] = silu_f(g0[j]) * u0[j]; h1[j] = silu_f(g1[j]) * u1[j]; }
                if (MOE) { u32x2 t8; t8.x = pk4_fp8(h0[0] * F8_SH, h0[1] * F8_SH, h0[2] * F8_SH, h0[3] * F8_SH); t8.y = pk4_fp8(h1[0] * F8_SH, h1[1] * F8_SH, h1[2] * F8_SH, h1[3] * F8_SH);
                           *(u32x2*)((unsigned char*)O + (unsigned)(orow * FF + colo)) = t8; }
                else *(u32x4*)(O + (size_t)orow * FF + colo) = pack8(h0, h1);
            }
    }
};
struct EpiMoeDown {
    static constexpr bool PERM = true;
    bf16* yp0; unsigned ypstride; const float* GW; const LAS int* pan; const LAS unsigned short* rowtab; float* scr; int nsl;
    __device__ __forceinline__ void operator()(const f32x4 (&acc)[2][2][4][2], const Unit& u, int wr, int wc, int fr, int fq) const {
        asm volatile("" : "+v"(fr), "+v"(fq));
        const int pnl = u.pn & 3, col0 = pnl * 256 + wc * 32 + 8 * fq;
        if (u.ti >= 0) {
            float* sp = scr + ((size_t)(u.ti * nsl + u.kt0 / u.nkt)) * 65536 + wc * 32 + 8 * fq;
#pragma unroll
            for (int ai = 0; ai < 2; ++ai)
#pragma unroll
                for (int m = 0; m < 4; ++m) { float* rp = sp + (ai * 128 + wr * 64 + m * 16 + fr) * 256;
#pragma unroll
                    for (int bj = 0; bj < 2; ++bj) { *(f32x4*)(rp + bj * 128) = acc[ai][bj][m][0]; *(f32x4*)(rp + bj * 128 + 4) = acc[ai][bj][m][1]; } }
            return;
        }
        const int k = (pan[u.pm] >> 19) & 1;
        bf16* yp = yp0 + (size_t)k * ypstride;
        int tk[2][4]; float wt[2][4];
#pragma unroll
        for (int ai = 0; ai < 2; ++ai)
#pragma unroll
            for (int m = 0; m < 4; ++m) tk[ai][m] = rowtab[u.ui * 256 + ai * 128 + wr * 64 + m * 16 + fr];
#pragma unroll
        for (int ai = 0; ai < 2; ++ai)
#pragma unroll
            for (int m = 0; m < 4; ++m) wt[ai][m] = GW[(unsigned)((tk[ai][m] == 0xFFFF ? 0 : tk[ai][m]) * 2 + k)];
#pragma unroll
        for (int ai = 0; ai < 2; ++ai)
#pragma unroll
            for (int m = 0; m < 4; ++m) {
                const int tok = tk[ai][m];
                if (tok != 0xFFFF) { const float w = wt[ai][m] * (1.0f / (F8_SH * F8_SW2)); bf16* p = yp + (unsigned)(tok * D + col0);
#pragma unroll
                    for (int bj = 0; bj < 2; ++bj) *(u32x4*)(p + bj * 128) = pack8(acc[ai][bj][m][0] * w, acc[ai][bj][m][1] * w); }
                asm volatile("" ::: "memory");
            }
    }
};

struct CvtJ { const float* s0; const float* s1; const float* g; bf16* d; int ld, K, nr, c0, md, nv, n, f8; float sc; };
__device__ __forceinline__ void cvt_load(const CvtJ& J, int item, int lane, f32x4 (&v)[8]) {
    const int nblk = J.nr / 32, kb = item / nblk, nb = item % nblk, k0 = 64 * kb, n0 = 32 * nb;
    const float* src = J.s0; int col = J.c0 + n0;
    if (J.md == 1) { const int blk = n0 >> 8, r = n0 & 255; src = (r < 128) ? J.s0 : J.s1; col = blk * 128 + (r & 127); }
    const int lr = lane >> 3, lc = (lane & 7) * 4;
    const bool ok = (n0 + lc) < J.nv;
#pragma unroll
    for (int i = 0; i < 8; ++i) { v[i] = (f32x4){0.f, 0.f, 0.f, 0.f}; if (ok) v[i] = *(const GAS f32x4*)(src + (size_t)(k0 + 8 * i + lr) * J.ld + col + lc); }
    if (J.g) {
#pragma unroll
        for (int i = 0; i < 8; ++i) v[i] = v[i] * J.g[k0 + 8 * i + lr];
    }
}
__device__ __forceinline__ void cvt_store(const CvtJ& J, int item, int lane, LAS float* scr, const f32x4 (&v)[8]) {
    const int nblk = J.nr / 32, kb = item / nblk, nb = item % nblk, k0 = 64 * kb, n0 = 32 * nb;
    const int lr = lane >> 3, lc = (lane & 7) * 4;
#pragma unroll
    for (int i = 0; i < 8; ++i) { LAS float* sp = scr + (8 * i + lr) * 33 + lc; sp[0] = v[i].x; sp[1] = v[i].y; sp[2] = v[i].z; sp[3] = v[i].w; }
    LDS_WAIT(); asm volatile("" ::: "memory");
    if (J.f8) {
        const int c4 = lane & 3; const float sc = J.sc;
#pragma unroll
        for (int j = 0; j < 2; ++j) { const int n = (lane >> 2) + 16 * j; const LAS float* s = scr + (16 * c4) * 33 + n;
            u32x4 o; o.x = pk4_fp8<true>(s[0 * 33] * sc, s[1 * 33] * sc, s[2 * 33] * sc, s[3 * 33] * sc); o.y = pk4_fp8<true>(s[4 * 33] * sc, s[5 * 33] * sc, s[6 * 33] * sc, s[7 * 33] * sc);
            o.z = pk4_fp8<true>(s[8 * 33] * sc, s[9 * 33] * sc, s[10 * 33] * sc, s[11 * 33] * sc); o.w = pk4_fp8<true>(s[12 * 33] * sc, s[13 * 33] * sc, s[14 * 33] * sc, s[15 * 33] * sc);
            *(GAS u32x4*)((unsigned char*)J.d + (size_t)(n0 + n) * J.K + k0 + 16 * c4) = o; }
    } else {
    const int c = lane & 7;
#pragma unroll
    for (int j = 0; j < 4; ++j) { const int n = (lane >> 3) + 8 * j; const LAS float* s = scr + (8 * c) * 33 + n;
        u32x4 o; o.x = pk2(s[0 * 33], s[1 * 33]); o.y = pk2(s[2 * 33], s[3 * 33]); o.z = pk2(s[4 * 33], s[5 * 33]); o.w = pk2(s[6 * 33], s[7 * 33]);
        *(GAS u32x4*)(J.d + (size_t)(n0 + n) * J.K + k0 + 8 * c) = o; }
    }
    LDS_WAIT(); asm volatile("" ::: "memory");
}
#define CVT_DECL() CvtJ J; J.s0 = nullptr; J.s1 = nullptr; J.g = nullptr; J.d = nullptr; J.ld = 0; J.K = 64; J.nr = 32; J.c0 = 0; J.md = 0; J.nv = 0; J.n = 0; J.f8 = 0; J.sc = 1.f; bool j_found = false;
#define CVT_JOB(src0, src1, gain, dst, ld_, K_, nrows, col0, mode, nvalid) { const int _n = ((K_) / 64) * ((nrows) / 32); \
    if (!j_found) { if (r < _n) { J.s0 = (src0); J.s1 = (src1); J.g = (gain); J.d = (dst); J.ld = (ld_); J.K = (K_); J.nr = (nrows); J.c0 = (col0); J.md = (mode); J.nv = (nvalid); J.n = _n; j_found = true; } else r -= _n; } }
#define CVT_JOB8(src0, src1, gain, dst, ld_, K_, nrows, col0, mode, nvalid, scale) { const int _n = ((K_) / 64) * ((nrows) / 32); \
    if (!j_found) { if (r < _n) { J.s0 = (src0); J.s1 = (src1); J.g = (gain); J.d = (bf16*)(dst); J.ld = (ld_); J.K = (K_); J.nr = (nrows); J.c0 = (col0); J.md = (mode); J.nv = (nvalid); J.n = _n; J.f8 = 1; J.sc = (scale); j_found = true; } else r -= _n; } }
#define CVT_RUN(it, end) do { int m_ = J.n - r; if ((end) - (it) < m_) m_ = (end) - (it); if (!j_found || m_ < 1) m_ = 1; \
    if (j_found) { f32x4 va[8], vb[8], vc[8]; cvt_load(J, r, lane, va); if (m_ > 1) cvt_load(J, r + 1, lane, vb);       \
        for (int j_ = 0; j_ < m_; j_ += 3) { \
            if (j_ + 2 < m_) cvt_load(J, r + j_ + 2, lane, vc); cvt_store(J, r + j_, lane, scr, va); \
            if (j_ + 1 < m_) { if (j_ + 3 < m_) cvt_load(J, r + j_ + 3, lane, va); cvt_store(J, r + j_ + 1, lane, scr, vb); } \
            if (j_ + 2 < m_) { if (j_ + 4 < m_) cvt_load(J, r + j_ + 4, lane, vb); cvt_store(J, r + j_ + 2, lane, scr, vc); } } } \
    (it) += m_; } while (0)

namespace att {
constexpr int KBUF = 0, VBUF = 32768, LUT_OFF = 65536, KM_OFF = 65536 + 1024;
__device__ __forceinline__ int ks_off(int row, int chunk) { return row * 256 + ((chunk ^ ((row & 3) | (((row >> 3) & 3) << 2))) << 4); }
__device__ __forceinline__ int vs_off(int row, int chunk) { return row * 128 + ((chunk ^ (((row >> 1) & 1) | (((row >> 3) & 3) << 1))) << 4); }
__device__ __forceinline__ int qt_base(int w) { return w < 7 ? 73728 + w * 8192 : 133120; }
__device__ __forceinline__ int qt_off(int row, int piece) { return row * 256 + ((piece ^ (row & 15)) << 4); }

template <bool MOBA>
__device__ __forceinline__ void attn_unit(LAS unsigned char* lds, int wv, bf16* Qb, int ldq, const bf16* Kb, int ldk, const bf16* VTb, int ldvt, int ntiles,
                                          int nblk, const float* ksum_bh, const float* rel_bias, int head, bool dry = false) {
    const int tid = opaque_tid(wv), lane = tid & 63, w = wv, c = lane & 31, hi = lane >> 5;
    int kofs0, kofs1, vofs0, vofs1;
    { const int r0 = w * 4 + (lane >> 4), r1 = r0 + 32, cs = lane & 15;
      kofs0 = r0 * ldk + ((cs ^ ((r0 & 3) | (((r0 >> 3) & 3) << 2))) << 3); kofs1 = r1 * ldk + ((cs ^ ((r1 & 3) | (((r1 >> 3) & 3) << 2))) << 3);
      const int v0 = w * 8 + (lane >> 3), v1 = v0 + 64, cv = lane & 7;
      vofs0 = v0 * ldvt + ((cv ^ (((v0 >> 1) & 1) | (((v0 >> 3) & 3) << 1))) << 3); vofs1 = v1 * ldvt + ((cv ^ (((v1 >> 1) & 1) | (((v1 >> 3) & 3) << 1))) << 3); }
#define ATT_GLDS(gptr, ldsoff) __builtin_amdgcn_global_load_lds((const unsigned*)(gptr), (LAS unsigned*)(lds + (ldsoff)), 16, 0, 0)
#define ATT_STAGE(ti, buf) do { const bf16* kt_ = Kb + (size_t)(64 * (ti)) * ldk; const bf16* vt_ = VTb + 64 * (ti); \
        ATT_GLDS(kt_ + kofs0, (buf) * 16384 + KBUF + w * 1024); ATT_GLDS(kt_ + kofs1, (buf) * 16384 + KBUF + 8192 + w * 1024); \
        ATT_GLDS(vt_ + vofs0, (buf) * 16384 + VBUF + w * 1024); ATT_GLDS(vt_ + vofs1, (buf) * 16384 + VBUF + 8192 + w * 1024); } while (0)
    ATT_STAGE(0, 0);
    LAS float* lut = (LAS float*)(lds + LUT_OFF);
    LAS float* km = (LAS float*)(lds + KM_OFF);
    if (MOBA) {
        if (tid < 130) { float v;
            if (tid == 0) v = -__builtin_inff();
            else { const int d = tid - 1; int bk;
                if (d < 16) bk = d; else if (d >= 128) bk = 31;
                else bk = 16 + (d >= 19) + (d >= 21) + (d >= 24) + (d >= 27) + (d >= 31) + (d >= 35) + (d >= 40) + (d >= 46) + (d >= 52) + (d >= 59) + (d >= 67) + (d >= 77) + (d >= 87) + (d >= 99) + (d >= 113);
                v = rel_bias[bk * MOBA_H + head] * LOG2E; }
            lut[tid] = v; }
        for (int idx = tid; idx < nblk * 128; idx += NTHR) km[idx] = ksum_bh[(size_t)(idx >> 7) * MOBA_W + (idx & 127)];
    }
    LAS unsigned char* qt = lds + qt_base(w);
    bf16* qtile = Qb + (size_t)(32 * w) * ldq;
    const int qr = lane >> 4, qp = lane & 15;
    { u32x4 qq[8];
#pragma unroll
      for (int i = 0; i < 8; ++i) qq[i] = *(const u32x4*)(qtile + (size_t)(4 * i + qr) * ldq + 8 * qp);
#pragma unroll
      for (int i = 0; i < 8; ++i) *(LAS u32x4*)(qt + qt_off(4 * i + qr, qp)) = qq[i]; }
    LDS_WAIT(); asm volatile("" ::: "memory");
    bf16x8 qf[8];
#pragma unroll
    for (int ks = 0; ks < 8; ++ks) qf[ks] = *(const LAS bf16x8*)(qt + qt_off(c, 2 * ks + hi));
    LDS_WAIT(); asm volatile("" ::: "memory");
    VM_WAIT();
    __syncthreads();
    unsigned selmask = 0;
    if (MOBA) {
        if (nblk <= 3) selmask = (1u << nblk) - 1u;
        else {
            float g[7];
#pragma unroll
            for (int j = 0; j < 7; ++j) { g[j] = -__builtin_inff();
                if (j < nblk) { float s = 0.f;
#pragma unroll
                    for (int ks = 0; ks < 8; ++ks) { const LAS float* kp = km + j * 128 + 16 * ks + 8 * hi; const f32x4 k0 = *(const LAS f32x4*)kp, k1 = *(const LAS f32x4*)(kp + 4);
                        const u32x4 qw = __builtin_bit_cast(u32x4, qf[ks]);
                        s += bflo(qw.x) * k0[0] + bfhi(qw.x) * k0[1] + bflo(qw.y) * k0[2] + bfhi(qw.y) * k0[3] + bflo(qw.z) * k1[0] + bfhi(qw.z) * k1[1] + bflo(qw.w) * k1[2] + bfhi(qw.w) * k1[3]; }
                    s += __shfl_xor(s, 32); g[j] = s; } }
#pragma unroll
            for (int pick = 0; pick < 3; ++pick) { float best = -__builtin_inff(); int bi = 0;
#pragma unroll
                for (int j = 0; j < 7; ++j) { const bool cand = (j < nblk) && !((selmask >> j) & 1u) && (g[j] > best); best = cand ? g[j] : best; bi = cand ? j : bi; }
                selmask |= 1u << bi; }
        }
    }
    const int pi = (c & ~0xC) | ((c & 4) << 1) | ((c & 8) >> 1);
    const int kra = ks_off(pi, 0) & ~0xF0, kxa = (pi & 3) | (((pi >> 3) & 3) << 2);
    const int vxa = ((c >> 1) & 1) | (((c >> 3) & 3) << 1);
    float m_run = -1e30f, l_run = 0.f;
    f32x16 o0, o1, o2, o3;
#pragma unroll
    for (int r = 0; r < 16; ++r) { o0[r] = 0.f; o1[r] = 0.f; o2[r] = 0.f; o3[r] = 0.f; }
    const int qpos = 256 * nblk + 32 * w + c;
    const float bfar = MOBA ? lut[129] : 0.f;
    for (int ti = 0; ti < ntiles; ++ti) {
        const int cur = ti & 1;
        int kx = kxa, vx = vxa; asm volatile("" : "+v"(kx), "+v"(vx));
        if (ti + 1 < ntiles) ATT_STAGE(ti + 1, cur ^ 1);
        const int kb = 64 * ti;
        bool skip = false, nearb = false, own = false;
        if (MOBA) { own = ((ti >> 2) == nblk); const int qlo = 256 * nblk + 32 * w;
            skip = own && (kb > qlo + 31);
            nearb = (qlo - (kb + 63)) < 128; }
        if (!skip) {
            float offs = 0.f;
            if (MOBA) { const bool sel = own || ((selmask >> (ti >> 2)) & 1u); offs = sel ? 0.f : -__builtin_inff(); }
            const bool first = m_run < -1e29f;
            const float mref = first ? 0.f : m_run;
            const float cinit = ((MOBA && nearb) ? offs : bfar + offs) - mref;
            f32x16 p0, p1;
#pragma unroll
            for (int r = 0; r < 16; ++r) { p0[r] = cinit; p1[r] = cinit; }
            const LAS unsigned char* kbase = lds + cur * 16384 + KBUF + kra;
#pragma unroll
            for (int ks = 0; ks < 8; ++ks) { const int co = ((2 * ks + hi) ^ kx) << 4;
                const bf16x8 a0 = *(const LAS bf16x8*)(kbase + co), a1 = *(const LAS bf16x8*)(kbase + 8192 + co);
                p0 = MFMA32(a0, qf[ks], p0); p1 = MFMA32(a1, qf[ks], p1);
                if (ks == 3) __builtin_amdgcn_sched_barrier(0); }
            if (MOBA && nearb) {
#pragma unroll
                for (int r = 0; r < 16; ++r) { const int kl = (r & 7) + 8 * hi + 16 * (r >> 3);
                    int i0 = qpos - (kb + kl) + 1, i1 = i0 - 32;
                    i0 = i0 < 0 ? 0 : (i0 > 129 ? 129 : i0); i1 = i1 < 0 ? 0 : (i1 > 129 ? 129 : i1);
                    p0[r] += lut[i0]; p1[r] += lut[i1];
                    if ((r & 3) == 3) __builtin_amdgcn_sched_barrier(0); }
            }
            float mx = p0[0];
#pragma unroll
            for (int r = 1; r < 16; ++r) mx = fmaxf(mx, p0[r]);
#pragma unroll
            for (int r = 0; r < 16; ++r) mx = fmaxf(mx, p1[r]);
            mx = fmaxf(mx, __shfl_xor(mx, 32));
            if (!__all(mx <= 8.0f && !first)) {
                const float mn = fmaxf(m_run, mx + mref); const float alpha = fast_exp2(m_run - mn); m_run = mn;
                l_run *= alpha; o0 *= alpha; o1 *= alpha; o2 *= alpha; o3 *= alpha;
                const float sub = mn - mref;
#pragma unroll
                for (int r = 0; r < 16; ++r) { p0[r] -= sub; p1[r] -= sub; } }
            float ls = 0.f;
#pragma unroll
            for (int r = 0; r < 16; ++r) { p0[r] = fast_exp2(p0[r]); p1[r] = fast_exp2(p1[r]); ls += p0[r] + p1[r]; }
            l_run += ls;
            bf16x8 pf[4];
            { u32x4 t;
              t.x = pk2(p0[0], p0[1]); t.y = pk2(p0[2], p0[3]); t.z = pk2(p0[4], p0[5]); t.w = pk2(p0[6], p0[7]); pf[0] = __builtin_bit_cast(bf16x8, t);
              t.x = pk2(p0[8], p0[9]); t.y = pk2(p0[10], p0[11]); t.z = pk2(p0[12], p0[13]); t.w = pk2(p0[14], p0[15]); pf[1] = __builtin_bit_cast(bf16x8, t);
              t.x = pk2(p1[0], p1[1]); t.y = pk2(p1[2], p1[3]); t.z = pk2(p1[4], p1[5]); t.w = pk2(p1[6], p1[7]); pf[2] = __builtin_bit_cast(bf16x8, t);
              t.x = pk2(p1[8], p1[9]); t.y = pk2(p1[10], p1[11]); t.z = pk2(p1[12], p1[13]); t.w = pk2(p1[14], p1[15]); pf[3] = __builtin_bit_cast(bf16x8, t); }
            const LAS unsigned char* vbase = lds + cur * 16384 + VBUF + c * 128;
#pragma unroll
            for (int q = 0; q < 4; ++q) { const int co = ((2 * q + hi) ^ vx) << 4;
                o0 = MFMA32(*(const LAS bf16x8*)(vbase + co), pf[q], o0);
                o1 = MFMA32(*(const LAS bf16x8*)(vbase + 4096 + co), pf[q], o1);
                o2 = MFMA32(*(const LAS bf16x8*)(vbase + 8192 + co), pf[q], o2);
                o3 = MFMA32(*(const LAS bf16x8*)(vbase + 12288 + co), pf[q], o3);
                if (q == 1) __builtin_amdgcn_sched_barrier(0); }
        }
        VM_WAIT();
        __syncthreads();
    }
    const float inv = 1.0f / (l_run + __shfl_xor(l_run, 32));
    int l2 = lane; asm volatile("" : "+v"(l2));
    const int c2 = l2 & 31, h2 = l2 >> 5, qr2 = l2 >> 4, qp2 = l2 & 15;
#pragma unroll
    for (int a = 0; a < 4; ++a) {
        u32x2 t;
        t.x = pk2(o0[4 * a] * inv, o0[4 * a + 1] * inv); t.y = pk2(o0[4 * a + 2] * inv, o0[4 * a + 3] * inv); *(LAS u32x2*)(qt + qt_off(c2, a) + 8 * h2) = t;
        t.x = pk2(o1[4 * a] * inv, o1[4 * a + 1] * inv); t.y = pk2(o1[4 * a + 2] * inv, o1[4 * a + 3] * inv); *(LAS u32x2*)(qt + qt_off(c2, 4 + a) + 8 * h2) = t;
        t.x = pk2(o2[4 * a] * inv, o2[4 * a + 1] * inv); t.y = pk2(o2[4 * a + 2] * inv, o2[4 * a + 3] * inv); *(LAS u32x2*)(qt + qt_off(c2, 8 + a) + 8 * h2) = t;
        t.x = pk2(o3[4 * a] * inv, o3[4 * a + 1] * inv); t.y = pk2(o3[4 * a + 2] * inv, o3[4 * a + 3] * inv); *(LAS u32x2*)(qt + qt_off(c2, 12 + a) + 8 * h2) = t;
    }
    LDS_WAIT(); asm volatile("" ::: "memory");
#pragma unroll
    for (int i = 0; i < 8; ++i) { const u32x4 oq = *(const LAS u32x4*)(qt + qt_off(4 * i + qr2, qp2)); if (!dry) *(u32x4*)(qtile + (size_t)(4 * i + qr2) * ldq + 8 * qp2) = oq; }
    LDS_WAIT(); asm volatile("" ::: "memory");
#undef ATT_GLDS
#undef ATT_STAGE
}
}

namespace ssd {
constexpr int DT_OFF = 0, CS_OFF = 3072, SSP_OFF = 6144;
constexpr int A_BMT = 8192, A_XT = 8192 + 32768;
constexpr int C_BM = 8192, C_CM = 8192 + 32768, C_XT = 8192 + 65536;
__device__ __forceinline__ int sw_off(int row, int chunk) { return row * 256 + ((chunk ^ ((row & 3) | (((row >> 3) & 3) << 2))) << 4); }

__device__ __forceinline__ int zt_base(int w) { return w < 6 ? 106496 + w * 4096 : 133120 + (w - 6) * 4096; }
__device__ __forceinline__ int zt_off(int row, int piece) { return row * 128 + ((piece ^ (row & 7)) << 4); }
struct Par { const bf16* proj; const float* conv_w; const float* conv_b; const float* dt_bias; const float* a_log; const float* d_skip; const float* g_out; bf16* states; float* cdec; };

__device__ __forceinline__ void dtcs(LAS unsigned char* lds, int wv, const Par& P, int b, int c, int g, bool write_cdec) {
    const int tid = opaque_tid(wv), lane = tid & 63, w = wv;
    if (w < 6) {
        const int hd = g * 6 + w; const size_t row0 = (size_t)b * SEQ + c * SSD_CH + 2 * lane;
        const float r0 = bf2f(P.proj[row0 * P1W + P1_DT + hd]), r1 = bf2f(P.proj[(row0 + 1) * P1W + P1_DT + hd]);
        const float bias = P.dt_bias[hd], A = -expf(P.a_log[hd]);
        const float x0 = r0 + bias, x1 = r1 + bias;
        const float d0 = x0 > 20.f ? x0 : log1pf(expf(x0)), d1 = x1 > 20.f ? x1 : log1pf(expf(x1));
        const float la0 = d0 * A, la1 = d1 * A; const float s1 = la0 + la1; float v = s1;
#pragma unroll
        for (int off = 1; off < 64; off <<= 1) { const float t = __shfl_up(v, off); if (lane >= off) v += t; }
        LAS float* dt = (LAS float*)(lds + DT_OFF) + w * 128; LAS float* cs = (LAS float*)(lds + CS_OFF) + w * 128;
        dt[2 * lane] = d0; dt[2 * lane + 1] = d1; cs[2 * lane] = v - s1 + la0; cs[2 * lane + 1] = v;
        if (write_cdec && lane == 63) P.cdec[((size_t)b * NCHUNK + c) * SSD_H + hd] = expf(v);
    }
}
__device__ __forceinline__ void conv8(const Par& P, int b, int s0, int chx, float (&y0)[8], float (&y1)[8]) {
    float x0[11], x1[11];
    const bf16* base = P.proj + ((size_t)b * SEQ) * P1W + P1_XBC + chx;
#pragma unroll
    for (int j = 0; j < 11; ++j) { const int s = s0 - 3 + j; unsigned wv = 0u; if (s >= 0) wv = *(const unsigned*)(base + (size_t)s * P1W); x0[j] = bflo(wv); x1[j] = bfhi(wv); }
    f32x2 wj[4];
#pragma unroll
    for (int j = 0; j < 4; ++j) wj[j] = *(const f32x2*)(P.conv_w + j * CONV_DIM + chx);
    const f32x2 bb = *(const f32x2*)(P.conv_b + chx);
#pragma unroll
    for (int i = 0; i < 8; ++i) {
        const float a0 = bb.x + wj[0].x * x0[i] + wj[1].x * x0[i + 1] + wj[2].x * x0[i + 2] + wj[3].x * x0[i + 3];
        const float a1 = bb.y + wj[0].y * x1[i] + wj[1].y * x1[i + 1] + wj[2].y * x1[i + 2] + wj[3].y * x1[i + 3];
        y0[i] = silu_f(a0); y1[i] = silu_f(a1); }
}
__device__ __forceinline__ u32x4 pack8f(const float (&y)[8]) { u32x4 t; t.x = pk2(y[0], y[1]); t.y = pk2(y[2], y[3]); t.z = pk2(y[4], y[5]); t.w = pk2(y[6], y[7]); return t; }

constexpr int A_WT = 90112, A_SC = 100352;
__device__ __forceinline__ void conv_load(const Par& P, int b, int s0, int chx, unsigned (&r)[11]) {
    const bf16* base = P.proj + ((size_t)b * SEQ) * P1W + P1_XBC + chx;
#pragma unroll
    for (int j = 0; j < 11; ++j) { const int s = s0 - 3 + j; r[j] = *(const unsigned*)(base + (size_t)(s < 0 ? 0 : s) * P1W); }
}
__device__ __forceinline__ void conv_math(const LAS float* wt, int lc, int s0, const unsigned (&r)[11], float (&y0)[8], float (&y1)[8]) {
    float x0[11], x1[11];
#pragma unroll
    for (int j = 0; j < 11; ++j) { x0[j] = bflo(r[j]); x1[j] = bfhi(r[j]); }
    if (s0 == 0) {
#pragma unroll
        for (int j = 0; j < 3; ++j) { x0[j] = 0.f; x1[j] = 0.f; } }
    f32x2 wj[4];
#pragma unroll
    for (int j = 0; j < 4; ++j) wj[j] = *(const LAS f32x2*)(wt + j * 512 + lc);
    const f32x2 bb = *(const LAS f32x2*)(wt + 4 * 512 + lc);
#pragma unroll
    for (int i = 0; i < 8; ++i) {
        const float a0 = bb.x + wj[0].x * x0[i] + wj[1].x * x0[i + 1] + wj[2].x * x0[i + 2] + wj[3].x * x0[i + 3];
        const float a1 = bb.y + wj[0].y * x1[i] + wj[1].y * x1[i + 1] + wj[2].y * x1[i + 2] + wj[3].y * x1[i + 3];
        y0[i] = silu_f(a0); y1[i] = silu_f(a1); }
}
__device__ __forceinline__ void phase_a(LAS unsigned char* lds, int wv, const Par& P, int vcu, int G) {
    const int tid = opaque_tid(wv), lane = tid & 63, w = wv;
    constexpr int NIT = BATCH * NCHUNK * SSD_G;
    unsigned rB[2][11], rX[6][11], dr0 = 0, dr1 = 0;
#define A_DEC(it_) const int g = (it_) & 3, c = ((it_) >> 2) & 15, b = (it_) >> 6
#define A_LD_DT(it_) { A_DEC(it_); if (w < 6) { const size_t row0 = (size_t)b * SEQ + c * SSD_CH + 2 * lane; dr0 = P.proj[row0 * P1W + P1_DT + g * 6 + w]; dr1 = P.proj[(row0 + 1) * P1W + P1_DT + g * 6 + w]; } }
#define A_LD_B(it_) { A_DEC(it_); int t_ = tid; asm volatile("" : "+v"(t_)); _Pragma("unroll") for (int j = 0; j < 2; ++j) { const int i2 = t_ + NTHR * j, cp = i2 & 63, tg = i2 >> 6; conv_load(P, b, c * SSD_CH + 8 * tg, SSD_IN + g * SSD_N + 2 * cp, rB[j]); } }
#define A_LD_X(it_, hg) { A_DEC(it_); int t_ = tid; asm volatile("" : "+v"(t_)); _Pragma("unroll") for (int j = 0; j < 3; ++j) { const int i2 = t_ + NTHR * j, cp = i2 % 96, tg = i2 / 96; conv_load(P, b, c * SSD_CH + 8 * tg, (g * 6 + 3 * (hg) + (cp >> 5)) * SSD_P + 2 * (cp & 31), rX[3 * (hg) + j]); } }
    int it = vcu, gtab = -1;
    if (it < NIT) { A_LD_DT(it) A_LD_B(it) A_LD_X(it, 0) A_LD_X(it, 1) }
    const LAS float* wt = (const LAS float*)(lds + A_WT); const LAS float* sct = (const LAS float*)(lds + A_SC);
#pragma unroll 1
    for (; it < NIT; it += G) {
        A_DEC(it); const int itc = (it + G < NIT) ? it + G : it;
        if (g != gtab) { gtab = g;
            const int ch = tid < 128 ? SSD_IN + g * SSD_N + tid : g * 6 * SSD_P + (tid - 128);
#pragma unroll
            for (int j = 0; j < 4; ++j) ((LAS float*)(lds + A_WT))[j * 512 + tid] = P.conv_w[j * CONV_DIM + ch];
            ((LAS float*)(lds + A_WT))[4 * 512 + tid] = P.conv_b[ch];
            __syncthreads(); }
        if (w < 6) {
            const int hd = g * 6 + w; const float bias = P.dt_bias[hd], A = -expf(P.a_log[hd]);
            const float x0 = bf2f((unsigned short)dr0) + bias, x1 = bf2f((unsigned short)dr1) + bias;
            const float d0 = x0 > 20.f ? x0 : log1pf(expf(x0)), d1 = x1 > 20.f ? x1 : log1pf(expf(x1));
            const float la0 = d0 * A, la1 = d1 * A; const float s1 = la0 + la1; float v = s1;
#pragma unroll
            for (int off = 1; off < 64; off <<= 1) { const float t = __shfl_up(v, off); if (lane >= off) v += t; }
            const float cend = __shfl(v, 63);
            LAS float* sc = (LAS float*)(lds + A_SC) + w * 128;
            sc[2 * lane] = d0 * expf(cend - (v - s1 + la0)); sc[2 * lane + 1] = d1 * expf(cend - v);
            if (lane == 63) P.cdec[((size_t)b * NCHUNK + c) * SSD_H + hd] = expf(v);
        }
        int tb = tid; asm volatile("" : "+v"(tb));
#pragma unroll
        for (int j = 0; j < 2; ++j) { const int i2 = tb + NTHR * j, cp = i2 & 63, tg = i2 >> 6; float y0[8], y1[8];
            conv_math(wt, 2 * cp, c * SSD_CH + 8 * tg, rB[j], y0, y1);
            *(LAS u32x4*)(lds + A_BMT + sw_off(2 * cp, tg)) = pack8f(y0); *(LAS u32x4*)(lds + A_BMT + sw_off(2 * cp + 1, tg)) = pack8f(y1); }
        { A_LD_DT(itc) A_LD_B(itc) }
        __syncthreads();
#pragma unroll
        for (int hg = 0; hg < 2; ++hg) {
            int tx = tid; asm volatile("" : "+v"(tx));
#pragma unroll
            for (int j = 0; j < 3; ++j) { const int i2 = tx + NTHR * j, cp = i2 % 96, tg = i2 / 96; const int e3 = cp >> 5, e = 3 * hg + e3, pp = 2 * (cp & 31); float y0[8], y1[8];
                conv_math(wt, 128 + e * SSD_P + pp, c * SSD_CH + 8 * tg, rX[3 * hg + j], y0, y1);
                const f32x4 sa = *(const LAS f32x4*)(sct + e * 128 + 8 * tg), sb = *(const LAS f32x4*)(sct + e * 128 + 8 * tg + 4);
#pragma unroll
                for (int i = 0; i < 4; ++i) { y0[i] *= sa[i]; y1[i] *= sa[i]; y0[4 + i] *= sb[i]; y1[4 + i] *= sb[i]; }
                *(LAS u32x4*)(lds + A_XT + e3 * 16384 + sw_off(pp, tg)) = pack8f(y0); *(LAS u32x4*)(lds + A_XT + e3 * 16384 + sw_off(pp + 1, tg)) = pack8f(y1); }
            { if (hg == 0) A_LD_X(itc, 0) else A_LD_X(itc, 1) }
            __syncthreads();
            const int nt = w & 3, pt = w >> 2;
            int clm = tid & 31; asm volatile("" : "+v"(clm));
            const int cl = clm, hi = (tid >> 5) & 1;
            const int xo = (cl & 3) | (((cl >> 3) & 3) << 2);
#pragma unroll
            for (int e3 = 0; e3 < 3; ++e3) {
                f32x16 acc;
#pragma unroll
                for (int r = 0; r < 16; ++r) acc[r] = 0.f;
                const LAS unsigned char* ab = lds + A_BMT + (32 * nt + cl) * 256; const LAS unsigned char* bb = lds + A_XT + e3 * 16384 + (32 * pt + cl) * 256;
#pragma unroll
                for (int ks = 0; ks < 8; ++ks) { const int co = ((2 * ks + hi) ^ xo) << 4;
                    acc = MFMA32(*(const LAS bf16x8*)(ab + co), *(const LAS bf16x8*)(bb + co), acc); }
                const int hd = g * 6 + 3 * hg + e3;
                bf16* dst = P.states + ((((size_t)b * NCHUNK + c) * SSD_H + hd) * SSD_P + 32 * pt + cl) * SSD_N + 32 * nt + 4 * hi;
#pragma unroll
                for (int a = 0; a < 4; ++a) { u32x2 t; t.x = pk2(acc[4 * a], acc[4 * a + 1]); t.y = pk2(acc[4 * a + 2], acc[4 * a + 3]); *(u32x2*)(dst + 8 * a) = t; }
            }
            __syncthreads();
        }
    }
#undef A_DEC
#undef A_LD_DT
#undef A_LD_B
#undef A_LD_X
}
__device__ __forceinline__ void phase_b(const Par& P, int gtid, int gthreads, bool dry = false) {
    for (int it = gtid; it < BATCH * SSD_H * SSD_P * 16; it += gthreads) {
        const int nq = it & 15, p = (it >> 4) & 63, bh = it >> 10, h = bh % SSD_H, b = bh / SSD_H;
        u32x4 v[NCHUNK];
#pragma unroll
        for (int c = 0; c < NCHUNK; ++c) v[c] = *(const u32x4*)(P.states + ((((size_t)b * NCHUNK + c) * SSD_H + h) * SSD_P + p) * SSD_N + 8 * nq);
        float hr[8];
#pragma unroll
        for (int i = 0; i < 8; ++i) hr[i] = 0.f;
#pragma unroll
        for (int c = 0; c < NCHUNK; ++c) {
            const float dec = P.cdec[((size_t)b * NCHUNK + c) * SSD_H + h];
            u32x4 o; o.x = pk2(hr[0], hr[1]); o.y = pk2(hr[2], hr[3]); o.z = pk2(hr[4], hr[5]); o.w = pk2(hr[6], hr[7]);
            if (!dry) *(u32x4*)(P.states + ((((size_t)b * NCHUNK + c) * SSD_H + h) * SSD_P + p) * SSD_N + 8 * nq) = o;
            hr[0] = dec * hr[0] + bflo(v[c].x); hr[1] = dec * hr[1] + bfhi(v[c].x); hr[2] = dec * hr[2] + bflo(v[c].y); hr[3] = dec * hr[3] + bfhi(v[c].y);
            hr[4] = dec * hr[4] + bflo(v[c].z); hr[5] = dec * hr[5] + bfhi(v[c].z); hr[6] = dec * hr[6] + bflo(v[c].w); hr[7] = dec * hr[7] + bfhi(v[c].w);
        }
    }
}
constexpr int C_WT = 141312;
template <int WS>
__device__ __forceinline__ void conv_math_t(const LAS float* wt, int lc, int s0, const unsigned (&r)[11], float (&y0)[8], float (&y1)[8]) {
    float x0[11], x1[11];
#pragma unroll
    for (int j = 0; j < 11; ++j) { x0[j] = bflo(r[j]); x1[j] = bfhi(r[j]); }
    if (s0 == 0) {
#pragma unroll
        for (int j = 0; j < 3; ++j) { x0[j] = 0.f; x1[j] = 0.f; } }
    f32x2 wj[4];
#pragma unroll
    for (int j = 0; j < 4; ++j) wj[j] = *(const LAS f32x2*)(wt + j * WS + lc);
    const f32x2 bb = *(const LAS f32x2*)(wt + 4 * WS + lc);
#pragma unroll
    for (int i = 0; i < 8; ++i) {
        const float a0 = bb.x + wj[0].x * x0[i] + wj[1].x * x0[i + 1] + wj[2].x * x0[i + 2] + wj[3].x * x0[i + 3];
        const float a1 = bb.y + wj[0].y * x1[i] + wj[1].y * x1[i + 1] + wj[2].y * x1[i + 2] + wj[3].y * x1[i + 3];
        y0[i] = silu_f(a0); y1[i] = silu_f(a1); }
}
__device__ __forceinline__ void phase_c(LAS unsigned char* lds, int wv, const Par& P, bf16* projw, int vcu, int NG) {
    const int tid = opaque_tid(wv), w = wv;
    constexpr int NIT = BATCH * NCHUNK * SSD_G;
    unsigned rBC[4][11], rX[2][11], dr0 = 0, dr1 = 0;
#define C_DEC(it_) const int g = (it_) & 3, c = ((it_) >> 2) & 15, b = (it_) >> 6
#define C_LD_DT(it_) { C_DEC(it_); if (w < 6) { const int l_ = tid & 63; const size_t row0 = (size_t)b * SEQ + c * SSD_CH + 2 * l_; dr0 = P.proj[row0 * P1W + P1_DT + g * 6 + w]; dr1 = P.proj[(row0 + 1) * P1W + P1_DT + g * 6 + w]; } }
#define C_LD_BC(it_) { C_DEC(it_); int t_ = tid; asm volatile("" : "+v"(t_)); _Pragma("unroll") for (int j = 0; j < 4; ++j) { const int i2 = t_ + NTHR * j, cp = i2 & 127, tg = i2 >> 7; \
        conv_load(P, b, c * SSD_CH + 8 * tg, SSD_IN + (cp >> 6) * (SSD_G * SSD_N) + g * SSD_N + 2 * (cp & 63), rBC[j]); } }
#define C_LD_X(it_, ei_) { C_DEC(it_); int t_ = tid; asm volatile("" : "+v"(t_)); _Pragma("unroll") for (int j = 0; j < 2; ++j) { const int i2 = t_ + NTHR * j, cp = i2 & 63, tg = i2 >> 6; \
        conv_load(P, b, c * SSD_CH + 8 * tg, (g * 6 + 3 * (cp >> 5) + (ei_)) * SSD_P + 2 * (cp & 31), rX[j]); } }
    int it = vcu, gtab = -1;
    if (it < NIT) { C_LD_DT(it) C_LD_BC(it) C_LD_X(it, 0) }
    const LAS float* wt = (const LAS float*)(lds + C_WT);
#pragma unroll 1
    for (; it < NIT; it += NG) {
        C_DEC(it); const int itc = (it + NG < NIT) ? it + NG : it;
        if (g != gtab) { gtab = g;
#pragma unroll
            for (int q = 0; q < 2; ++q) { const int idx = tid + NTHR * q;
                if (idx < 640) { const int ch = idx < 128 ? SSD_IN + g * SSD_N + idx : idx < 256 ? SSD_IN + SSD_G * SSD_N + g * SSD_N + (idx - 128) : g * 6 * SSD_P + (idx - 256);
#pragma unroll
                    for (int j = 0; j < 4; ++j) ((LAS float*)(lds + C_WT))[j * 640 + idx] = P.conv_w[j * CONV_DIM + ch];
                    ((LAS float*)(lds + C_WT))[4 * 640 + idx] = P.conv_b[ch]; } }
            __syncthreads(); }
        if (w < 6) {
            const int lane = tid & 63, hd = g * 6 + w; const float bias = P.dt_bias[hd], A = -expf(P.a_log[hd]);
            const float x0 = bf2f((unsigned short)dr0) + bias, x1 = bf2f((unsigned short)dr1) + bias;
            const float d0 = x0 > 20.f ? x0 : log1pf(expf(x0)), d1 = x1 > 20.f ? x1 : log1pf(expf(x1));
            const float la0 = d0 * A, la1 = d1 * A; const float s1 = la0 + la1; float v = s1;
#pragma unroll
            for (int off = 1; off < 64; off <<= 1) { const float t = __shfl_up(v, off); if (lane >= off) v += t; }
            LAS float* dt = (LAS float*)(lds + DT_OFF) + w * 128; LAS float* cs = (LAS float*)(lds + CS_OFF) + w * 128;
            dt[2 * lane] = d0; dt[2 * lane + 1] = d1; cs[2 * lane] = v - s1 + la0; cs[2 * lane + 1] = v;
        }
        { int tb = tid; asm volatile("" : "+v"(tb));
#pragma unroll
          for (int j = 0; j < 4; ++j) { const int i2 = tb + NTHR * j, cp = i2 & 127, tg = i2 >> 7; float y0[8], y1[8];
            conv_math_t<640>(wt, 2 * cp, c * SSD_CH + 8 * tg, rBC[j], y0, y1);
            const int img = (cp >> 6) ? C_CM : C_BM, n2 = cp & 63;
#pragma unroll
            for (int i = 0; i < 8; ++i) *(LAS unsigned*)(lds + img + sw_off(8 * tg + i, n2 >> 2) + (n2 & 3) * 4) = pk2(y0[i], y1[i]); } }
        int lv = tid & 63; asm volatile("" : "+v"(lv));
        const int lane = lv, cl = lane & 31, hi = lane >> 5;
        __syncthreads();
    const LAS float* dtl = (const LAS float*)(lds + DT_OFF); const LAS float* csl = (const LAS float*)(lds + CS_OFF);
    const int lt = (w < 4) ? w : 7 - w, hh = w >> 2, l = 32 * lt + cl;
    const int xo = (cl & 3) | (((cl >> 3) & 3) << 2);
    const int pi = (cl & ~0xC) | ((cl & 4) << 1) | ((cl & 8) >> 1), xpi = (pi & 3) | (((pi >> 3) & 3) << 2);
    const LAS unsigned char* cmb = lds + C_CM + l * 256;
#define CF(ks) (*(const LAS bf16x8*)(cmb + (((2 * (ks) + hi) ^ xo) << 4)))
    f32x16 G[4];
#pragma unroll
    for (int st = 0; st < 4; ++st) {
#pragma unroll
        for (int r = 0; r < 16; ++r) G[st][r] = 0.f;
        if (st <= lt) { const LAS unsigned char* ab = lds + C_BM + (32 * st + pi) * 256;
#pragma unroll
            for (int ks = 0; ks < 8; ++ks) G[st] = MFMA32(*(const LAS bf16x8*)(ab + (((2 * ks + hi) ^ xpi) << 4)), CF(ks), G[st]); }
        __builtin_amdgcn_sched_barrier(0);
    }
        float sq = 0.f;
#pragma unroll 1
        for (int ei = 0; ei < 3; ++ei) {
            const int e = 3 * hh + ei, hd = g * 6 + e;
            const float csl_l = csl[e * 128 + l], dsk = P.d_skip[hd] / dtl[e * 128 + l];
            u32x4 zq[4];
            { const bf16* zr = projw + ((size_t)b * SEQ + c * SSD_CH + 32 * lt) * P1W + hd * SSD_P;
#pragma unroll
              for (int i = 0; i < 4; ++i) zq[i] = *(const u32x4*)(zr + (size_t)(8 * i + (lane >> 3)) * P1W + 8 * (lane & 7)); }
            __syncthreads();
            if (c > 0) {
                int tq = tid; asm volatile("" : "+v"(tq));
                const int ln = tq & 63, cs = ln & 15;
#pragma unroll
                for (int q = 0; q < 4; ++q) { const int hb = q >> 1, pc = w + 8 * (q & 1), r = 4 * pc + (ln >> 4);
                    const bf16* sp = P.states + ((((size_t)b * NCHUNK + c) * SSD_H + g * 6 + 3 * hb + ei) * SSD_P + r) * SSD_N + ((cs ^ ((r & 3) | (((r >> 3) & 3) << 2))) << 3);
                    __builtin_amdgcn_global_load_lds((const unsigned*)sp, (LAS unsigned*)(lds + C_BM + hb * 16384 + pc * 1024), 16, 0, 0); }
            }
            { int tx = tid; asm volatile("" : "+v"(tx));
#pragma unroll
              for (int j = 0; j < 2; ++j) { const int i2 = tx + NTHR * j, cp = i2 & 63, tg = i2 >> 6; const int hb = cp >> 5, e2 = 3 * hb + ei, pp = 2 * (cp & 31); float y0[8], y1[8];
                conv_math_t<640>(wt, 256 + e2 * SSD_P + pp, c * SSD_CH + 8 * tg, rX[j], y0, y1);
                const f32x4 sa = *(const LAS f32x4*)(dtl + e2 * 128 + 8 * tg), sb = *(const LAS f32x4*)(dtl + e2 * 128 + 8 * tg + 4);
#pragma unroll
                for (int i = 0; i < 4; ++i) { y0[i] *= sa[i]; y1[i] *= sa[i]; y0[4 + i] *= sb[i]; y1[4 + i] *= sb[i]; }
                *(LAS u32x4*)(lds + C_XT + hb * 16384 + sw_off(pp, tg)) = pack8f(y0); *(LAS u32x4*)(lds + C_XT + hb * 16384 + sw_off(pp + 1, tg)) = pack8f(y1); } }
            VM_WAIT();
            { const int itx = ei < 2 ? it : itc, eix = ei < 2 ? ei + 1 : 0; C_LD_X(itx, eix) }
            __syncthreads();
            f32x16 Y0, Y1;
#pragma unroll
            for (int r = 0; r < 16; ++r) { Y0[r] = 0.f; Y1[r] = 0.f; }
            if (c > 0) {
                const LAS unsigned char* sb0 = lds + C_BM + hh * 16384 + cl * 256; const LAS unsigned char* sb1 = sb0 + 32 * 256;
#pragma unroll
                for (int ks = 0; ks < 8; ++ks) { const bf16x8 cfk = CF(ks); const int co = ((2 * ks + hi) ^ xo) << 4;
                    Y0 = MFMA32(*(const LAS bf16x8*)(sb0 + co), cfk, Y0); Y1 = MFMA32(*(const LAS bf16x8*)(sb1 + co), cfk, Y1); }
                const float el = fast_exp2(csl_l * LOG2E);
                Y0 *= el; Y1 *= el;
            }
            int clv = cl; asm volatile("" : "+v"(clv));
            const LAS unsigned char* xb0 = lds + C_XT + hh * 16384 + cl * 256; const LAS unsigned char* xb1 = xb0 + 32 * 256;
#pragma unroll
            for (int st = 0; st < 4; ++st) {
                if (st <= lt) {
                    float mv[16];
                    const LAS float* cp8 = csl + e * 128 + 32 * st + 8 * hi;
                    const f32x4 c0 = *(const LAS f32x4*)cp8, c1 = *(const LAS f32x4*)(cp8 + 4), c2 = *(const LAS f32x4*)(cp8 + 16), c3 = *(const LAS f32x4*)(cp8 + 20);
#pragma unroll
                    for (int r = 0; r < 16; ++r) {
                        const float cs_s = (r < 4) ? c0[r & 3] : (r < 8) ? c1[r & 3] : (r < 12) ? c2[r & 3] : c3[r & 3];
                        mv[r] = G[st][r] * fast_exp2((csl_l - cs_s) * LOG2E); }
                    if (st == lt) {
#pragma unroll
                        for (int r = 0; r < 16; ++r) { const int sl = (r & 7) + 8 * hi + 16 * (r >> 3);
                            float v = mv[r]; v = (sl <= clv) ? v : 0.f; v = (sl == clv) ? v + dsk : v; mv[r] = v; }
                    }
                    u32x4 t; bf16x8 m0, m1;
                    t.x = pk2(mv[0], mv[1]); t.y = pk2(mv[2], mv[3]); t.z = pk2(mv[4], mv[5]); t.w = pk2(mv[6], mv[7]); m0 = __builtin_bit_cast(bf16x8, t);
                    t.x = pk2(mv[8], mv[9]); t.y = pk2(mv[10], mv[11]); t.z = pk2(mv[12], mv[13]); t.w = pk2(mv[14], mv[15]); m1 = __builtin_bit_cast(bf16x8, t);
                    const int co0 = ((4 * st + hi) ^ xo) << 4, co1 = ((4 * st + 2 + hi) ^ xo) << 4;
                    Y0 = MFMA32(*(const LAS bf16x8*)(xb0 + co0), m0, Y0); Y0 = MFMA32(*(const LAS bf16x8*)(xb0 + co1), m1, Y0);
                    Y1 = MFMA32(*(const LAS bf16x8*)(xb1 + co0), m0, Y1); Y1 = MFMA32(*(const LAS bf16x8*)(xb1 + co1), m1, Y1);
                }
            }
            { LAS unsigned char* zt = lds + zt_base(w);
              bf16* zrow = projw + ((size_t)b * SEQ + c * SSD_CH + 32 * lt) * P1W + hd * SSD_P;
              const int rr = lane >> 3, pc = lane & 7;
#pragma unroll
              for (int i = 0; i < 4; ++i) *(LAS u32x4*)(zt + zt_off(8 * i + rr, pc)) = zq[i];
              LDS_WAIT(); asm volatile("" ::: "memory");
              u32x2 zz0[4], zz1[4];
#pragma unroll
              for (int a = 0; a < 4; ++a) { zz0[a] = *(const LAS u32x2*)(zt + zt_off(cl, a) + 8 * hi); zz1[a] = *(const LAS u32x2*)(zt + zt_off(cl, 4 + a) + 8 * hi); }
              LDS_WAIT(); asm volatile("" ::: "memory");
#pragma unroll
              for (int a = 0; a < 4; ++a) {
                { const u32x2 zz = zz0[a];
                  const float u0 = Y0[4 * a] * silu_f(bflo(zz.x)), u1 = Y0[4 * a + 1] * silu_f(bfhi(zz.x)), u2 = Y0[4 * a + 2] * silu_f(bflo(zz.y)), u3 = Y0[4 * a + 3] * silu_f(bfhi(zz.y));
                  sq += (u0 * u0 + u1 * u1) + (u2 * u2 + u3 * u3); u32x2 t; t.x = pk2(u0, u1); t.y = pk2(u2, u3); *(LAS u32x2*)(zt + zt_off(cl, a) + 8 * hi) = t; }
                { const u32x2 zz = zz1[a];
                  const float u0 = Y1[4 * a] * silu_f(bflo(zz.x)), u1 = Y1[4 * a + 1] * silu_f(bfhi(zz.x)), u2 = Y1[4 * a + 2] * silu_f(bflo(zz.y)), u3 = Y1[4 * a + 3] * silu_f(bfhi(zz.y));
                  sq += (u0 * u0 + u1 * u1) + (u2 * u2 + u3 * u3); u32x2 t; t.x = pk2(u0, u1); t.y = pk2(u2, u3); *(LAS u32x2*)(zt + zt_off(cl, 4 + a) + 8 * hi) = t; }
              }
              LDS_WAIT(); asm volatile("" ::: "memory");
#pragma unroll
              for (int i = 0; i < 4; ++i) { const u32x4 uq = *(const LAS u32x4*)(zt + zt_off(8 * i + rr, pc)); *(u32x4*)(zrow + (size_t)(8 * i + rr) * P1W + 8 * pc) = uq; }
              LDS_WAIT(); asm volatile("" ::: "memory");
            }
    }
LAS float* ssp = (LAS float*)(lds + SSP_OFF);
    ssp[l * 4 + hh * 2 + hi] = sq;
        { C_LD_DT(itc) C_LD_BC(itc) }
    __syncthreads();
    { const int rr = lane >> 3, pc = lane & 7;
#pragma unroll
      for (int ei = 0; ei < 3; ++ei) { const int hd = g * 6 + 3 * hh + ei;
            bf16* zrow = projw + ((size_t)b * SEQ + c * SSD_CH + 32 * lt) * P1W + hd * SSD_P;
            const f32x4 g0 = *(const f32x4*)(P.g_out + hd * SSD_P + 8 * pc), g1 = *(const f32x4*)(P.g_out + hd * SSD_P + 8 * pc + 4);
#pragma unroll
            for (int i = 0; i < 4; ++i) { const int lr = 32 * lt + 8 * i + rr;
                const f32x4 s4 = *(const LAS f32x4*)(ssp + lr * 4); const float rs = 1.0f / sqrtf(((s4.x + s4.y) + (s4.z + s4.w)) * (1.0f / 384.0f) + EPS);
                u32x4* up = (u32x4*)(zrow + (size_t)(8 * i + rr) * P1W + 8 * pc);
                const u32x4 uv = *up;
                u32x4 t; t.x = pk2(bflo(uv.x) * rs * g0[0], bfhi(uv.x) * rs * g0[1]); t.y = pk2(bflo(uv.y) * rs * g0[2], bfhi(uv.y) * rs * g0[3]);
                t.z = pk2(bflo(uv.z) * rs * g1[0], bfhi(uv.z) * rs * g1[1]); t.w = pk2(bflo(uv.w) * rs * g1[2], bfhi(uv.w) * rs * g1[3]);
                *up = t; } } }
    __syncthreads();
    }
#undef CF
#undef C_DEC
#undef C_LD_DT
#undef C_LD_BC
#undef C_LD_X
}
}

constexpr size_t WS_MEMRS = 4 * MiB + 256 * 1024;
constexpr size_t WS_RS0 = 4 * MiB + 512 * 1024;
constexpr int N_PHASES = 15;

struct MoeOrder {
    pg8::StaticOrder so; const LAS int* pan; int npn;
    __device__ __forceinline__ bool next(int i, Unit& u) const { if (!so.next(i, u)) return false; u.pn = ((pan[u.pm] >> 16) & 7) * npn + u.pn; return true; }
};
struct MoeOrderSplit {
    pg8::StaticOrder so; const LAS int* pan; int npn;
    __device__ __forceinline__ int nfull() const { return (so.nwg / so.G) * so.G; }
    __device__ __forceinline__ int nsl() const { const int t = so.nwg - nfull(); return (t * 7 <= so.G) ? 7 : ((t * 2 <= so.G) ? 2 : 1); }
    __device__ __forceinline__ int ntail() const { const int t = so.nwg - nfull(); return nsl() > 1 ? t : 0; }
    __device__ __forceinline__ bool next(int i, Unit& u) const {
        const int L = i * so.G + so.c, nf = nfull(), nt = ntail(), ns = nsl();
        if (nt == 0 || L < nf) { if (L >= so.nwg) return false; so.decode(L, u); u.kt0 = 0; u.nkt = MOE_NKT; u.ti = -1; }
        else { const int s = L - nf; if (s >= nt * ns) return false; so.decode(nf + s / ns, u); u.kt0 = (s % ns) * (MOE_NKT / ns); u.nkt = MOE_NKT / ns; u.ti = s / ns; }
        u.ui = i; u.pn = ((pan[u.pm] >> 16) & 7) * npn + u.pn; return true;
    }
};

__device__ __forceinline__ void row_to_bf16(const float* xrow, bf16* orow, float* ss16, float* rs1, int lane) {
    const GAS f32x4* xr = (const GAS f32x4*)xrow + lane;
    f32x4 v[4]; float s = 0.f;
#pragma unroll
    for (int j = 0; j < 4; ++j) { v[j] = xr[64 * j]; s += (v[j].x * v[j].x + v[j].y * v[j].y) + (v[j].z * v[j].z + v[j].w * v[j].w); }
    s = wave_sum(s);
    GAS unsigned long long* o8 = (GAS unsigned long long*)orow + lane;
#pragma unroll
    for (int j = 0; j < 4; ++j) o8[64 * j] = (unsigned long long)pk2(v[j].x, v[j].y) | ((unsigned long long)pk2(v[j].z, v[j].w) << 32);
    if (lane < 16) ss16[lane] = (lane == 0) ? s : 0.f;
    if (lane == 0) *rs1 = 1.0f / sqrtf(s * (1.0f / 1024.0f) + EPS);
}

__global__ void __launch_bounds__(NTHR, 2) fwd_kernel(Args args_unused) {
#define args (*kargs())
    extern __shared__ __attribute__((aligned(16))) unsigned char lds_raw[];
    LAS unsigned char* lds = (LAS unsigned char*)lds_raw;
    const int wave = __builtin_amdgcn_readfirstlane((int)threadIdx.x >> 6);
#define tid (opaque_tid(wave))
#define lane (opaque_tid(wave) & 63)
    const int G = gridDim.x, bx = blockIdx.x;
    const int vcu = (G % 8 == 0) ? (bx % 8) * (G / 8) + bx / 8 : bx;
    unsigned char* ws = args.ws;
    gu32* ctl = (gu32*)(ws + WS_CTL);
    for (int u = tid; u < 256; u += NTHR) ((LAS unsigned*)(lds + MISC_OFF))[u] = 0u;
    __syncthreads();
    XcdBarrier bar = xcd_barrier_post((unsigned*)(ctl + CW_BAR), (volatile LAS unsigned*)(lds + MISC_OFF) + 8);
    const int lo = args.ph_lo, hi = args.ph_hi;
#ifndef ONLY_PHASE
#define ONLY_PHASE -1
#endif
#define IN(k) ((ONLY_PHASE < 0 || (k) == ONLY_PHASE) && lo <= (k) && (k) < hi)
#define SEAM(k) do { if (IN(k) && IN((k) + 1)) xcd_barrier(bar); } while (0)

    const float* x_in = args.in[0]; float* out = args.out;
    bf16* XB = (bf16*)(ws + WS_XB); float* SS = (float*)(ws + WS_SS); bf16* PROJ = (bf16*)(ws + WS_PROJ);
    float* KMEAN = (float*)(ws + WS_KMEAN);
    const LAS unsigned short* rowtab = (const LAS unsigned short*)(lds + ROWTAB_OFF);
    LAS int* pan = (LAS int*)(lds + PAN_OFF);

    if (IN(0)) {
        LAS float* scr = (LAS float*)(lds + wave * 16384);
        const int gw = vcu * NWAVES + wave, NGW = G * NWAVES;
        const float *g_mix = args.in[2], *g_mem = args.in[3], *w_moba = args.in[4], *w_ssd = args.in[5], *w_kv = args.in[6], *w_out = args.in[7], *g_ffn = args.in[15];
        constexpr int NIT = (1024 / 64) * ((3584 + 1536 + 4864 + 1024 + 1024 + 7168) / 32) + (2048 / 64) * (2048 / 32) + (3584 / 64) * (1024 / 32);
        const int cvt_c = (NIT + NGW - 1) / NGW, cvt_end = (gw + 1) * cvt_c < NIT ? (gw + 1) * cvt_c : NIT;
        for (int it = gw * cvt_c; it < cvt_end;) {
            int r = it; CVT_DECL()
            CVT_JOB(w_moba, nullptr, g_mix, (bf16*)(ws + WS_WM1), IN_MOBA, 1024, 1536, 0, 0, 1536)
            CVT_JOB(w_moba, nullptr, g_mix, (bf16*)(ws + WS_WM1) + (size_t)1536 * 1024, IN_MOBA, 1024, 512, 4608, 0, 512)
            CVT_JOB(w_moba, nullptr, g_mix, (bf16*)(ws + WS_WM1) + (size_t)2048 * 1024, IN_MOBA, 1024, 1536, 1536, 0, 1536)
            CVT_JOB(w_moba, nullptr, g_mix, (bf16*)(ws + WS_WV), IN_MOBA, 1024, 1536, 3072, 0, 1536)
            CVT_JOB(w_ssd, nullptr, g_mix + D, (bf16*)(ws + WS_WS), IN_SSD, 1024, 1536, 0, 0, 1536)
            CVT_JOB(w_ssd, nullptr, g_mix + D, (bf16*)(ws + WS_WS) + (size_t)1536 * 1024, IN_SSD, 1024, 512, 4120, 0, 512)
            CVT_JOB(w_ssd, nullptr, g_mix + D, (bf16*)(ws + WS_WS) + (size_t)2048 * 1024, IN_SSD, 1024, 2560, 1536, 0, 2560)
            CVT_JOB(w_ssd, nullptr, g_mix + D, (bf16*)(ws + WS_WS) + (size_t)4608 * 1024, IN_SSD, 1024, 256, 4096, 0, 24)
            CVT_JOB(w_kv, nullptr, g_mem, (bf16*)(ws + WS_WMK), 1024, 1024, 512, 0, 0, 512)
            CVT_JOB(w_kv + (size_t)1024 * 1024, nullptr, g_mem + D, (bf16*)(ws + WS_WMK) + (size_t)512 * 1024, 1024, 1024, 512, 0, 0, 512)
            CVT_JOB(w_kv, nullptr, g_mem, (bf16*)(ws + WS_WMV), 1024, 1024, 512, 512, 0, 512)
            CVT_JOB(w_kv + (size_t)1024 * 1024, nullptr, g_mem + D, (bf16*)(ws + WS_WMV) + (size_t)512 * 1024, 1024, 1024, 512, 512, 0, 512)
            CVT_JOB(args.in[16], args.in[17], g_ffn, (bf16*)(ws + WS_WGU), FF, 1024, 7168, 0, 1, 7168)
            CVT_JOB(w_out, nullptr, nullptr, (bf16*)(ws + WS_WO), 1024, 2048, 1024, 0, 0, 1024)
            CVT_JOB(w_out + (size_t)2048 * 1024, nullptr, nullptr, (bf16*)(ws + WS_WO) + (size_t)1024 * 2048, 1024, 2048, 1024, 0, 0, 1024)
            CVT_JOB(args.in[18], nullptr, nullptr, (bf16*)(ws + WS_WD), 1024, FF, 1024, 0, 0, 1024)
            CVT_RUN(it, cvt_end);
        }
        for (int m = gw; m < T; m += NGW) row_to_bf16(x_in + (size_t)m * D, XB + (size_t)m * D, SS + (size_t)m * 16, (float*)(ws + WS_RS0) + m, lane);
        for (int m = gw; m < MROWS; m += NGW) row_to_bf16(args.in[1] + (size_t)m * D, (bf16*)(ws + WS_MEMB) + (size_t)m * D, (float*)(ws + WS_MEMSS) + (size_t)m * 16, (float*)(ws + WS_MEMRS) + m, lane);
        __syncthreads();
    }
    SEAM(0);
    if (IN(1)) {
        { pg8::Gemm g{XB, (const bf16*)(ws + WS_WM1), D, D}; pg8::StaticOrder S; S.init(T / 256, P0W / 256, G, bx);
          EpiScale E{PROJ, P0W, SS, KMEAN, 2048, 0, 8};
          pg8::gemm_phase<EpiScale, pg8::StaticOrder, false>(lds, g, S, E, rowtab, wave); }
        { pg8::Gemm g{(const bf16*)(ws + WS_WV), XB, D, D}; pg8::StaticOrder S; S.init(MOBA_W / 256, T / 256, G, bx);
          EpiVT E{(bf16*)(ws + WS_VT), T, (const float*)(ws + WS_RS0)};
          pg8::gemm_phase<EpiVT, pg8::StaticOrder, false>(lds, g, S, E, rowtab, wave); }
        { pg8::Gemm g{(const bf16*)(ws + WS_MEMB), (const bf16*)(ws + WS_WMK), D, D}; pg8::StaticOrder S; S.init(MROWS / 256, 2, G, bx);
          EpiScale E{(bf16*)(ws + WS_KMEM), 1024, (const float*)(ws + WS_MEMSS), nullptr, 0, 0, 0};
          pg8::gemm_phase<EpiScale, pg8::StaticOrder, false>(lds, g, S, E, rowtab, wave); }
        { pg8::Gemm g{(const bf16*)(ws + WS_WMV), (const bf16*)(ws + WS_MEMB), D, D}; pg8::StaticOrder S; S.init(2, MROWS / 256, G, (bx + G - 32) % G);
          EpiVT E{(bf16*)(ws + WS_VMEMT), MROWS, (const float*)(ws + WS_MEMRS)};
          pg8::gemm_phase<EpiVT, pg8::StaticOrder, false>(lds, g, S, E, rowtab, wave); }
    }
    SEAM(1);
    if (IN(2)) { const bool dry = false;
        for (int it = vcu; it < BATCH * MOBA_H * 4; it += G) {
            const int bh = it >> 2, pr = it & 3, b = bh / MOBA_H, h = bh % MOBA_H;
#pragma unroll 1
            for (int half = 0; half < 2; ++half) { const int n = half ? pr : 7 - pr;
                att::attn_unit<true>(lds, wave, PROJ + ((size_t)b * SEQ + 256 * n) * P0W + h * HD, P0W, PROJ + ((size_t)b * SEQ) * P0W + 2048 + h * HD, P0W,
                                     (const bf16*)(ws + WS_VT) + (size_t)(h * HD) * T + (size_t)b * SEQ, T, 4 * (n + 1), n, KMEAN + (size_t)(b * NBLK) * MOBA_W + h * HD, args.in[8], h, dry); }
        }
        for (int it = vcu; it < BATCH * MEM_H * 8; it += G) {
            const int b = it >> 5, mh = (it >> 3) & 3, qt = it & 7;
            att::attn_unit<false>(lds, wave, PROJ + ((size_t)b * SEQ + 256 * qt) * P0W + 1536 + mh * HD, P0W, (const bf16*)(ws + WS_KMEM) + ((size_t)b * MEM_LEN) * 1024 + mh * HD, 1024,
                                  (const bf16*)(ws + WS_VMEMT) + (size_t)(mh * HD) * MROWS + b * MEM_LEN, MROWS, 4, 0, nullptr, nullptr, 0, dry);
        }
    }
    SEAM(2);
    if (IN(3)) {
        pg8::Gemm g{PROJ, (const bf16*)(ws + WS_WO), P0W, MIXW}; pg8::StaticOrder S; S.init(T / 256, 4, G, bx);
        EpiResid<false, true, false> E{nullptr, nullptr, XB, SS, nullptr};
        pg8::gemm_phase<EpiResid<false, true, false>, pg8::StaticOrder, false>(lds, g, S, E, rowtab, wave);
    }
    SEAM(3);
    if (IN(4)) {
        pg8::Gemm g{XB, (const bf16*)(ws + WS_WGU), D, D}; pg8::StaticOrder S; S.init(T / 256, 28, G, bx);
        EpiGateUp<false> E{(bf16*)(ws + WS_ACT), SS, rowtab};
        pg8::gemm_phase<EpiGateUp<false>, pg8::StaticOrder, false>(lds, g, S, E, rowtab, wave);
    }
    SEAM(4);
    if (IN(5)) {
        pg8::Gemm g{(const bf16*)(ws + WS_ACT), (const bf16*)(ws + WS_WD), FF, FF}; pg8::StaticOrder S; S.init(T / 256, 4, G, bx);
        EpiResid<false, true, false> E{nullptr, nullptr, XB, SS, nullptr};
        pg8::gemm_phase<EpiResid<false, true, false>, pg8::StaticOrder, false>(lds, g, S, E, rowtab, wave);
    }
    SEAM(5);
    if (IN(6)) {
        pg8::Gemm g{XB, (const bf16*)(ws + WS_WS), D, D}; pg8::StaticOrder S; S.init(T / 256, P1W / 256, G, bx);
        EpiScale E{PROJ, P1W, SS, nullptr, 0, 6, 8};
        pg8::gemm_phase<EpiScale, pg8::StaticOrder, false>(lds, g, S, E, rowtab, wave);
        { pg8::Gemm g2{(const bf16*)(ws + WS_MEMB), (const bf16*)(ws + WS_WMK) + (size_t)512 * 1024, D, D}; pg8::StaticOrder S2; S2.init(MROWS / 256, 2, G, (bx + G - 128) % G);
          EpiScale E2{(bf16*)(ws + WS_KMEM) + 512, 1024, (const float*)(ws + WS_MEMSS), nullptr, 0, 0, 0};
          pg8::gemm_phase<EpiScale, pg8::StaticOrder, false>(lds, g2, S2, E2, rowtab, wave); }
        { pg8::Gemm g2{(const bf16*)(ws + WS_WMV) + (size_t)512 * 1024, (const bf16*)(ws + WS_MEMB), D, D}; pg8::StaticOrder S2; S2.init(2, MROWS / 256, G, (bx + G - 160) % G);
          EpiVT E2{(bf16*)(ws + WS_VMEMT) + (size_t)512 * MROWS, MROWS, (const float*)(ws + WS_MEMRS)};
          pg8::gemm_phase<EpiVT, pg8::StaticOrder, false>(lds, g2, S2, E2, rowtab, wave); }
    }
    SEAM(6);
    const ssd::Par SP{PROJ, args.in[9], args.in[10], args.in[11], args.in[12], args.in[13], args.in[14], (bf16*)(ws + WS_STATES), (float*)(ws + WS_CDEC)};
    if (IN(7)) { const bool dry = false;
        ssd::phase_a(lds, wave, SP, vcu, G);
        for (int it = vcu; it < BATCH * MEM_H * 8; it += G) {
            const int b = it >> 5, mh = (it >> 3) & 3, qt = it & 7;
            att::attn_unit<false>(lds, wave, PROJ + ((size_t)b * SEQ + 256 * qt) * P1W + 1536 + mh * HD, P1W, (const bf16*)(ws + WS_KMEM) + ((size_t)b * MEM_LEN) * 1024 + 512 + mh * HD, 1024,
                                  (const bf16*)(ws + WS_VMEMT) + (size_t)(512 + mh * HD) * MROWS + b * MEM_LEN, MROWS, 4, 0, nullptr, nullptr, 0, dry);
        }
    }
    SEAM(7);
    if (IN(8)) { ssd::phase_b(SP, bx * NTHR + tid, G * NTHR); }
    SEAM(8);
    if (IN(9)) {
        ssd::phase_c(lds, wave, SP, PROJ, vcu, G);
    }
    SEAM(9);
    if (IN(10)) {
        pg8::Gemm g{PROJ, (const bf16*)(ws + WS_WO) + (size_t)1024 * 2048, P1W, MIXW}; pg8::StaticOrder S; S.init(T / 256, 4, G, bx);
        EpiResid<true, true, false> E{nullptr, nullptr, XB, SS, ws + WS_XB8};
        pg8::gemm_phase<EpiResid<true, true, false>, pg8::StaticOrder, false>(lds, g, S, E, rowtab, wave);
    }
    SEAM(10);
    float* GW = (float*)(ws + WS_GW); int* LIST = (int*)(ws + WS_LIST);
    if (IN(11)) {
        LAS int* e1s = (LAS int*)lds; LAS int* e2s = e1s + 128; LAS int* lr0 = e1s + 256; LAS int* lr1 = e1s + 384; LAS int* basel = e1s + 512;
        const float* wr = args.in[19]; const float* br = args.in[20]; const float* gf = args.in[15] + D;
        f32x4 wa[16], wb[16];
#pragma unroll
        for (int j = 0; j < 4; ++j)
#pragma unroll
            for (int q = 0; q < 4; ++q) { const int k = 256 * j + 4 * lane + q; const float gk = gf[k];
                wa[4 * j + q] = *(const f32x4*)(wr + (size_t)k * 8) * gk; wb[4 * j + q] = *(const f32x4*)(wr + (size_t)k * 8 + 4) * gk; }
        const f32x4 ba = *(const f32x4*)br, bb = *(const f32x4*)(br + 4);
        for (int blk = bx; blk < T / 128; blk += G) {
#pragma unroll 1
            for (int i = 0; i < 16; ++i) {
                const int tl = wave * 16 + i, row = blk * 128 + tl;
                const GAS u32x2* xr = (const GAS u32x2*)(XB + (size_t)row * D) + lane;
                f32x4 a0 = {0.f, 0.f, 0.f, 0.f}, a1 = {0.f, 0.f, 0.f, 0.f}; float s = 0.f;
#pragma unroll
                for (int j = 0; j < 4; ++j) { const u32x2 xw = xr[64 * j]; const f32x4 v = {bflo(xw.x), bfhi(xw.x), bflo(xw.y), bfhi(xw.y)}; s += (v.x * v.x + v.y * v.y) + (v.z * v.z + v.w * v.w);
                    a0 += wa[4 * j] * v.x + wa[4 * j + 1] * v.y + wa[4 * j + 2] * v.z + wa[4 * j + 3] * v.w;
                    a1 += wb[4 * j] * v.x + wb[4 * j + 1] * v.y + wb[4 * j + 2] * v.z + wb[4 * j + 3] * v.w; }
                s = wave_sum(s); const float rs = 1.0f / sqrtf(s * (1.0f / 1024.0f) + EPS);
                float lg[8];
#pragma unroll
                for (int e = 0; e < 4; ++e) { lg[e] = wave_sum(a0[e]) * rs + ba[e]; lg[4 + e] = wave_sum(a1[e]) * rs + bb[e]; }
                int i1 = 0; float l1 = lg[0];
#pragma unroll
                for (int e = 1; e < 8; ++e) if (lg[e] > l1) { l1 = lg[e]; i1 = e; }
                int i2 = -1; float l2 = -__builtin_inff();
#pragma unroll
                for (int e = 0; e < 8; ++e) if (e != i1 && lg[e] > l2) { l2 = lg[e]; i2 = e; }
                const float w1 = 1.0f / (1.0f + expf(l2 - l1));
                if (lane == 0) { e1s[tl] = i1; e2s[tl] = i2; GW[(size_t)row * 2] = w1; GW[(size_t)row * 2 + 1] = 1.0f - w1; ((float*)(ws + WS_RSG))[row] = rs; }
            }
            __syncthreads();
            if (tid < 16) { const int k = tid >> 3, e = tid & 7; int cnt = 0;
                for (int t = 0; t < 128; ++t) { const int ee = k ? e2s[t] : e1s[t]; if (ee == e) { if (k) lr1[t] = cnt; else lr0[t] = cnt; ++cnt; } }
                basel[tid] = (int)__hip_atomic_fetch_add((unsigned*)(ctl + CW_CNT + 64 * tid), (unsigned)cnt, __ATOMIC_RELAXED, __HIP_MEMORY_SCOPE_AGENT); }
            __syncthreads();
            if (tid < 256) { const int k = tid >> 7, t = tid & 127, e = k ? e2s[t] : e1s[t], pos = basel[k * 8 + e] + (k ? lr1[t] : lr0[t]);
                LIST[(size_t)(k * 8 + e) * MOE_CAP + pos] = blk * 128 + t; }
            __syncthreads();
        }
        LAS float* scr = (LAS float*)(lds + 4096 + wave * 16384);
        const int gw = vcu * NWAVES + wave, NGW = G * NWAVES;
        const float* gf1 = args.in[15] + D;
        constexpr int NGU = (1024 / 64) * (7168 / 32), NDN = (FF / 64) * (1024 / 32);
        constexpr int NITE = NEXP * (NGU + NDN);
        const int cvt_c = (NITE + NGW - 1) / NGW, cvt_end = (gw + 1) * cvt_c < NITE ? (gw + 1) * cvt_c : NITE;
        for (int it = gw * cvt_c; it < cvt_end;) {
            const int e = it / (NGU + NDN); int r = it % (NGU + NDN); CVT_DECL()
            CVT_JOB8(args.in[21] + (size_t)e * 1024 * FF, args.in[22] + (size_t)e * 1024 * FF, gf1, ws + WS_WEGU + (size_t)e * 7168 * 1024, FF, 1024, 7168, 0, 1, 7168, F8_SW1)
            CVT_JOB8(args.in[23] + (size_t)e * FF * 1024, nullptr, nullptr, ws + WS_WED + (size_t)e * 1024 * FF, 1024, FF, 1024, 0, 0, 1024, F8_SW2)
            CVT_RUN(it, cvt_end);
        }
        __syncthreads();
    }
    SEAM(11);
#define MOE_TABLES() \
        if (tid < 16) pan[288 + tid] = (int)__hip_atomic_load((unsigned*)(ctl + CW_CNT + 64 * tid), __ATOMIC_RELAXED, __HIP_MEMORY_SCOPE_AGENT); \
        __syncthreads(); \
        int cum[17]; cum[0] = 0; \
        _Pragma("unroll") for (int q = 0; q < 16; ++q) cum[q + 1] = cum[q] + ((pan[288 + q] + 255) >> 8); \
        const int NP = cum[16]; \
        { const int p_ = tid; if (p_ < NP) { int gi = 0; \
            _Pragma("unroll") for (int q = 1; q < 16; ++q) gi += (p_ >= cum[q]) ? 1 : 0; \
            int cg = 0; \
            _Pragma("unroll") for (int q = 0; q < 16; ++q) cg = (q == gi) ? cum[q] : cg; \
            pan[p_] = (gi << 16) | (p_ - cg); } } \
        __syncthreads();
#define MOE_ROWTAB(S) { Unit u; LAS unsigned short* rt = (LAS unsigned short*)(lds + ROWTAB_OFF); \
        for (int i = 0; i < 32 && S.next(i, u); ++i) { const int t_ = tid; \
            if (t_ < 256) { const int gi = pan[u.pm] >> 16, off = (pan[u.pm] & 0xffff) * 256 + t_; rt[u.ui * 256 + t_] = (unsigned short)((off < pan[288 + gi]) ? LIST[(size_t)gi * MOE_CAP + off] : 0xFFFF); } } } \
        __syncthreads();
    if (IN(12)) {
        MOE_TABLES()
        MoeOrder S; S.so.init(NP, 28, G, bx); S.pan = pan; S.npn = 28;
        MOE_ROWTAB(S)
        int kdim = D; asm volatile("" : "+s"(kdim));
        pg8::Gemm g{(const bf16*)(ws + WS_XB8), (const bf16*)(ws + WS_WEGU), D, kdim};
        EpiGateUp<true> E{(bf16*)(ws + WS_ACTM), nullptr, rowtab};
        pg8::gemm_phase<EpiGateUp<true>, MoeOrder, true, false, 1>(lds, g, S, E, rowtab, wave);
    }
    SEAM(12);
    if (IN(13)) {
        MOE_TABLES()
        MoeOrderSplit S; S.so.init(NP, 4, G, bx); S.pan = pan; S.npn = 4;
        MOE_ROWTAB(S)
        pg8::Gemm g{(const bf16*)(ws + WS_ACTM), (const bf16*)(ws + WS_WED), FF, FF};
        float* mscr = (float*)(ws + WS_WM1);
        bf16* yp0 = (bf16*)(ws + WS_YP0);
        const int nsl = S.nsl();
        EpiMoeDown E{yp0, (unsigned)((WS_YP1 - WS_YP0) / 2), GW, pan, rowtab, mscr, nsl};
        pg8::gemm_phase<EpiMoeDown, MoeOrderSplit, false, true, 1>(lds, g, S, E, rowtab, wave);
        const int ntl = S.ntail();
        if (ntl > 0) { xcd_barrier(bar);
            const int gw = vcu * NWAVES + wave, NGW = G * NWAVES, nf = S.nfull();
            for (int ri = gw; ri < ntl * 256; ri += NGW) { const int ti = ri >> 8, r = ri & 255; Unit u; S.so.decode(nf + ti, u);
                const int gi = pan[u.pm] >> 16, k = gi >> 3, off = (pan[u.pm] & 0xffff) * 256 + r;
                if (off < pan[288 + gi]) { const int tok = LIST[(size_t)gi * MOE_CAP + off]; const float w = GW[(size_t)tok * 2 + k] * (1.0f / (F8_SH * F8_SW2));
                    const float* sp = mscr + (size_t)(ti * nsl) * 65536 + r * 256 + 4 * lane; f32x4 a = *(const f32x4*)sp;
                    for (int q = 1; q < nsl; ++q) a += *(const f32x4*)(sp + (size_t)q * 65536);
                    a = a * w; u32x2 t2; t2.x = pk2(a[0], a[1]); t2.y = pk2(a[2], a[3]); *(u32x2*)(yp0 + (size_t)k * ((WS_YP1 - WS_YP0) / 2) + (size_t)tok * D + u.pn * 256 + 4 * lane) = t2; } } }
    }
    SEAM(13);
    if (IN(14)) {
        const int gw = vcu * NWAVES + wave, NGW = G * NWAVES;
        f32x4 gfin[4];
#pragma unroll
        for (int j = 0; j < 4; ++j) gfin[j] = *((const f32x4*)args.in[24] + lane + 64 * j);
        for (int m = gw; m < T; m += NGW) {
            const int ln = lane;
            GAS f32x4* xr = (GAS f32x4*)(out + (size_t)m * D) + ln; f32x4 v[4]; float s = 0.f;
            const GAS u32x2* xs = (const GAS u32x2*)(XB + (size_t)m * D) + ln;
            const GAS u32x2* y0 = (const GAS u32x2*)(ws + WS_YP0 + (size_t)m * D * 2) + ln; const GAS u32x2* y1 = (const GAS u32x2*)(ws + WS_YP1 + (size_t)m * D * 2) + ln;
#pragma unroll
            for (int j = 0; j < 4; ++j) { const u32x2 xw = xs[64 * j]; v[j] = (f32x4){bflo(xw.x), bfhi(xw.x), bflo(xw.y), bfhi(xw.y)}; const u32x2 a = y0[64 * j], b = y1[64 * j];
                v[j].x += bflo(a.x) + bflo(b.x); v[j].y += bfhi(a.x) + bfhi(b.x); v[j].z += bflo(a.y) + bflo(b.y); v[j].w += bfhi(a.y) + bfhi(b.y);
                s += (v[j].x * v[j].x + v[j].y * v[j].y) + (v[j].z * v[j].z + v[j].w * v[j].w); }
            s = wave_sum(s); const float rs = 1.0f / sqrtf(s * (1.0f / 1024.0f) + EPS);
#pragma unroll
            for (int j = 0; j < 4; ++j) xr[64 * j] = v[j] * rs * gfin[j];
        }
    }
#undef IN
#undef SEAM
#undef tid
#undef lane
#undef args
}

extern "C" void kernel_launch(void* const* d_in, const int* in_sizes, int n_in, void* d_out, int out_size, void* d_ws, size_t ws_size, hipStream_t stream) {
    static int grid = 0;
    if (grid == 0) {
        if (n_in != 25 || in_sizes[0] != T * D || out_size != T * D || ws_size < WS_END) { fprintf(stderr, "kernel_launch: unexpected shapes / workspace (n_in %d, ws %zu); nothing launched\n", n_in, ws_size); grid = -1; return; }
        int dev = 0, cus = 0, per_cu = 0;
        if (hipGetDevice(&dev) != hipSuccess || hipDeviceGetAttribute(&cus, hipDeviceAttributeMultiprocessorCount, dev) != hipSuccess) { grid = -1; return; }
        if (hipFuncSetAttribute((const void*)fwd_kernel, hipFuncAttributeMaxDynamicSharedMemorySize, LDS_BYTES) != hipSuccess) { fprintf(stderr, "kernel_launch: hipFuncSetAttribute failed\n"); grid = -1; return; }
        if (hipOccupancyMaxActiveBlocksPerMultiprocessor(&per_cu, (const void*)fwd_kernel, NTHR, LDS_BYTES) != hipSuccess || per_cu < 1) { fprintf(stderr, "kernel_launch: occupancy query says %d\n", per_cu); }
        (void)hipGetLastError();
        grid = cus;
    }
    if (grid < 0) return;
    if (hipMemsetAsync((char*)d_ws, 0, ZERO_BYTES, stream) != hipSuccess) return;
    Args a{};
    for (int i = 0; i < 25; ++i) a.in[i] = (const float*)d_in[i];
    a.out = (float*)d_out; a.ws = (unsigned char*)d_ws;
    a.ph_lo = 0; a.ph_hi = N_PHASES;
    hipLaunchKernelGGL(fwd_kernel, dim3(grid), dim3(NTHR), LDS_BYTES, stream, a);
}
```

```cpp
#include <hip/hip_runtime.h>
#include <cstdio>
#include <cstdint>

#define GAS __attribute__((address_space(1)))
#define LAS __attribute__((address_space(3)))
typedef unsigned short bf16;
typedef short bf16x8 __attribute__((ext_vector_type(8)));
typedef float f32x2 __attribute__((ext_vector_type(2)));
typedef float f32x4 __attribute__((ext_vector_type(4)));
typedef float f32x16 __attribute__((ext_vector_type(16)));
typedef unsigned u32x2 __attribute__((ext_vector_type(2)));
typedef unsigned u32x4 __attribute__((ext_vector_type(4)));
typedef int i32x4 __attribute__((ext_vector_type(4)));
typedef int i32x8 __attribute__((ext_vector_type(8)));
typedef __bf16 bf16x2_t __attribute__((ext_vector_type(2)));
typedef GAS unsigned gu32;

constexpr int D = 1024, BATCH = 16, SEQ = 2048, T = BATCH * SEQ;
constexpr int MEM_LEN = 256, MROWS = BATCH * MEM_LEN;
constexpr int MOBA_H = 12, HD = 128, MOBA_W = 1536, NBLK = 8;
constexpr int MEM_H = 4, MEM_W = 512;
constexpr int SSD_H = 24, SSD_P = 64, SSD_IN = 1536, SSD_G = 4, SSD_N = 128, SSD_CH = 128, NCHUNK = SEQ / SSD_CH, CONV_DIM = 2560;
constexpr int IN_MOBA = 5120, IN_SSD = 4632, MIXW = 2048, FF = 3584, NEXP = 8;
constexpr int P0W = 3584;
constexpr int P1W = 4864;
constexpr int P1_XBC = 2048, P1_DT = 4608;
constexpr float EPS = 1e-6f;
constexpr float LOG2E = 1.4426950408889634f;
constexpr int MOE_CAP = T;
constexpr int MOE_MAXP = 272;

constexpr size_t MiB = 1u << 20;
constexpr size_t WS_CTL = 0, WS_KMEAN = 1 * MiB, ZERO_BYTES = 2 * MiB;
constexpr size_t WS_SS = 2 * MiB;
constexpr size_t WS_MEMSS = 4 * MiB;
constexpr size_t WS_GW = 5 * MiB;
constexpr size_t WS_LIST = 6 * MiB;
constexpr size_t WS_CDEC = 8 * MiB;
constexpr size_t WS_WM1 = 9 * MiB;
constexpr size_t WS_WV = 16 * MiB;
constexpr size_t WS_WS = 19 * MiB;
constexpr size_t WS_WMK = 29 * MiB;
constexpr size_t WS_WMV = 31 * MiB;
constexpr size_t WS_WO = 33 * MiB;
constexpr size_t WS_WGU = 41 * MiB;
constexpr size_t WS_WD = 55 * MiB;
constexpr size_t WS_MEMB = 62 * MiB;
constexpr size_t WS_KMEM = 70 * MiB;
constexpr size_t WS_VMEMT = 78 * MiB;
constexpr size_t WS_XB = 86 * MiB;
constexpr size_t WS_BIG = 150 * MiB;
constexpr size_t WS_PROJ = WS_BIG;
constexpr size_t WS_VT = 374 * MiB;
constexpr size_t WS_ACT = WS_BIG;
constexpr size_t WS_STATES = 454 * MiB;
constexpr size_t WS_ACTM = WS_BIG;
constexpr size_t WS_WED = 550 * MiB;
constexpr size_t WS_WEGU = 416 * MiB;
constexpr size_t WS_XB8 = 472 * MiB;
constexpr size_t WS_YP0 = 416 * MiB;
constexpr size_t WS_YP1 = 480 * MiB;
constexpr size_t WS_RSG = 544 * MiB;
constexpr size_t WS_END = 555 * MiB;
static_assert(WS_PROJ + (size_t)T * P0W * 2 <= WS_VT && WS_VT + (size_t)MOBA_W * T * 2 <= 470 * MiB, "layer 0 map");
static_assert(WS_PROJ + (size_t)T * P1W * 2 <= WS_STATES && WS_STATES + (size_t)BATCH * NCHUNK * SSD_H * SSD_P * SSD_N * 2 <= 550 * MiB, "layer 1 map");
static_assert(WS_ACTM + (size_t)MOE_MAXP * 256 * FF <= 388 * MiB && WS_WED + (size_t)NEXP * 1024 * FF <= 578 * MiB && WS_WED >= 550 * MiB && 388 * MiB <= WS_WEGU && WS_WEGU + (size_t)NEXP * 7168 * 1024 <= WS_XB8 && WS_XB8 + (size_t)T * D <= WS_RSG && WS_YP0 + (size_t)T * D * 2 <= WS_YP1 && WS_YP1 + (size_t)T * D * 2 <= WS_RSG && WS_RSG + (size_t)T * 4 <= WS_END && WS_XB8 >= WS_PROJ + (size_t)T * P1W * 2, "moe map");
constexpr int CW_BAR = 4096;
constexpr int CW_CNT = 16384;

constexpr int RING_BYTES = 131072;
constexpr int MISC_OFF = RING_BYTES;
constexpr int PAN_OFF = RING_BYTES + 1024;
constexpr int ROWTAB_OFF = RING_BYTES + 3072;
constexpr int LDS_BYTES = ROWTAB_OFF + 16 * 1024 + 4096;
constexpr int NWAVES = 8, NTHR = 512;

__device__ __forceinline__ unsigned pk2(float lo, float hi) { f32x2 v = {lo, hi}; bf16x2_t b = __builtin_convertvector(v, bf16x2_t); return __builtin_bit_cast(unsigned, b); }
__device__ __forceinline__ float bf2f(unsigned short b) { return __uint_as_float(((unsigned)b) << 16); }
__device__ __forceinline__ float bflo(unsigned w) { return __uint_as_float(w << 16); }
__device__ __forceinline__ float bfhi(unsigned w) { return __uint_as_float(w & 0xffff0000u); }
__device__ __forceinline__ float fast_exp2(float x) { return __builtin_amdgcn_exp2f(x); }
__device__ __forceinline__ float fast_rcp(float x) { return __builtin_amdgcn_rcpf(x); }
__device__ __forceinline__ float silu_f(float x) { return x * fast_rcp(1.0f + fast_exp2(-x * LOG2E)); }
__device__ __forceinline__ float wave_sum(float v) {
#pragma unroll
    for (int o = 1; o < 64; o <<= 1) v += __shfl_xor(v, o);
    return v;
}
__device__ __forceinline__ int opaque_tid(int wv) { int l = __builtin_amdgcn_mbcnt_hi(~0u, __builtin_amdgcn_mbcnt_lo(~0u, 0u)); asm volatile("" : "+v"(l)); return wv * 64 + l; }
struct Args { const float* in[25]; float* out; unsigned char* ws; int ph_lo, ph_hi; };
static_assert(sizeof(Args) == 25 * 8 + 8 + 8 + 8, "Args has no padding");

typedef const __attribute__((address_space(4))) Args* kargs_t;
__device__ __forceinline__ kargs_t kargs() { kargs_t p = (kargs_t)__builtin_amdgcn_kernarg_segment_ptr(); asm volatile("" : "+s"(p)); return p; }
#define LDS_WAIT() asm volatile("s_waitcnt lgkmcnt(0)" ::: "memory")
#define VM_WAIT() asm volatile("s_waitcnt vmcnt(0)" ::: "memory")
#define MFMA32(a, b, c) __builtin_amdgcn_mfma_f32_32x32x16_bf16((a), (b), (c), 0, 0, 0)

#define XB_TMO      128
#define XB_XCNT(j)  (256  + 64 * (j))
#define XB_XSUB(j)  (1280 + 64 * (j))
#define XB_XGEN(j)  (2304 + 64 * (j))
#define XB_TOP      3328
#define XB_TOPGEN   3392
#define XCD_BAR_WORDS 3456
#define XB_SPIN_CAP (1u << 18)

__device__ __forceinline__ unsigned xb_ld(unsigned* p)              { return __hip_atomic_load(p, __ATOMIC_RELAXED, __HIP_MEMORY_SCOPE_AGENT); }
__device__ __forceinline__ unsigned xb_add(unsigned* p, unsigned v) { return __hip_atomic_fetch_add(p, v, __ATOMIC_RELAXED, __HIP_MEMORY_SCOPE_AGENT); }
__device__ __forceinline__ unsigned xb_xcc_id() { return (unsigned)__builtin_amdgcn_s_getreg((3 << 11) | 20) & 0xFu; }
#define XB_SPIN(cond, bar) do { unsigned _sp = 0; while (cond) { __builtin_amdgcn_s_sleep(1); \
    if ((++_sp & 255u) == 0u) { if (xb_ld(&(bar)[XB_TMO])) break; if (_sp > XB_SPIN_CAP) { atomicAdd(&(bar)[XB_TMO], 1u); break; } } } } while (0)

struct XcdBarrier {
    unsigned* bar; unsigned x;
    volatile LAS unsigned* st;
};

__device__ __forceinline__ XcdBarrier xcd_barrier_post(unsigned* bar, volatile LAS unsigned* st) {
    XcdBarrier b; b.bar = bar; b.x = xb_xcc_id(); b.st = st;
    if (threadIdx.x == 0) (void)xb_add(&bar[XB_XCNT(b.x)], 1u);
    return b;
}
__device__ __forceinline__ void xcd_barrier_complete(unsigned* bar, unsigned x, unsigned& nloc, unsigned& nx) {
    const unsigned G = gridDim.x * gridDim.y * gridDim.z;
    unsigned sum, cnt, mine, sp = 0u;
    for (;;) {
        sum = 0u; cnt = 0u; mine = 0u;
#pragma unroll
        for (unsigned j = 0; j < 16; ++j) { const unsigned c = xb_ld(&bar[XB_XCNT(j)]); sum += c; cnt += (c > 0u) ? 1u : 0u; mine = (j == x) ? c : mine; }
        if (sum == G) break;
        __builtin_amdgcn_s_sleep(1);
        if ((++sp & 255u) == 0u) { if (xb_ld(&bar[XB_TMO])) break; if (sp > XB_SPIN_CAP) { atomicAdd(&bar[XB_TMO], 1u); break; } }
    }
    nloc = mine > 0u ? mine : 1u; nx = cnt > 0u ? cnt : 1u;
}

__device__ __forceinline__ void xcd_barrier(const XcdBarrier& b) {
    asm volatile("s_waitcnt vmcnt(0)" ::: "memory");
    __syncthreads();
    if (threadIdx.x == 0) {
        unsigned* bar = b.bar;
        __builtin_amdgcn_s_waitcnt(0);
        unsigned nloc = b.st[0], nx = b.st[1];
        if (nloc == 0u) { xcd_barrier_complete(bar, b.x, nloc, nx); b.st[0] = nloc; b.st[1] = nx; }
        const unsigned old = xb_add(&bar[XB_XSUB(b.x)], 1u);
        const unsigned gen = old / nloc;
        if (old + 1u == (gen + 1u) * nloc) {
            __builtin_amdgcn_fence(__ATOMIC_RELEASE, "agent");
            asm volatile("s_waitcnt vmcnt(0)" ::: "memory");
            const unsigned og = xb_add(&bar[XB_TOP], 1u);
            const unsigned tg = og / nx;
            if (og + 1u == (tg + 1u) * nx) xb_add(&bar[XB_TOPGEN], 1u);
            else XB_SPIN(xb_ld(&bar[XB_TOPGEN]) == tg, bar);
            __builtin_amdgcn_fence(__ATOMIC_ACQUIRE, "agent");
            xb_add(&bar[XB_XGEN(b.x)], 1u);
            asm volatile("s_waitcnt vmcnt(0)" ::: "memory");
        } else {
            XB_SPIN(xb_ld(&bar[XB_XGEN(b.x)]) == gen, bar);
            __builtin_amdgcn_fence(__ATOMIC_ACQUIRE, "agent");
            asm volatile("s_waitcnt vmcnt(0)" ::: "memory");
        }
    }
    __syncthreads();
}


namespace pg8 {
constexpr int BM = 256, BK = 64, HALF = 128, HTB = HALF * BK * 2, STAGE_BYTES = 8 * HTB, NXCD = 8, WGM = 8;
__host__ __device__ __forceinline__ int lds_byte(int r, int c) { const int st = (r >> 4) * 2 + (c >> 5), rr = r & 15, cc = c & 31, ob = rr * 64 + cc * 2; return st * 1024 + (ob ^ (((ob >> 9) & 1) << 5)); }
__host__ __device__ __forceinline__ void stage_rc(int b, int& R, int& C) { const int st = b / 1024, sb = b % 1024, swz = sb ^ (((sb >> 9) & 1) << 5); R = (st >> 1) * 16 + swz / 64; C = (st & 1) * 32 + (swz % 64) / 2; }
__host__ __device__ __forceinline__ int perm32(int rho) { const int n = rho >> 4, i = rho & 15; return 8 * (i >> 2) + 4 * n + (i & 3); }

struct Unit { int pm, pn, ui, kt0, nkt, ti; };
struct Gemm { const bf16* A; const bf16* Bt; int lda, K; };

struct StaticOrder {
    int nM, nN, nwg, G, c;
    __device__ __forceinline__ void init(int nM_, int nN_, int G_, int c_) { nM = nM_; nN = nN_; nwg = nM * nN; G = G_; c = c_; }
    __device__ __forceinline__ void decode(int wgid, Unit& u) const {
        { const int q = nwg / NXCD, r = nwg % NXCD, xcd = wgid % NXCD, off = wgid / NXCD; wgid = (xcd < r ? xcd * (q + 1) : r * (q + 1) + (xcd - r) * q) + off; }
        const int nig = WGM * nN, gid = wgid / nig, fm = gid * WGM, gsz = (nM - fm) < WGM ? (nM - fm) : WGM;
        u.pm = fm + ((wgid % nig) % gsz); u.pn = (wgid % nig) / gsz;
    }
    __device__ __forceinline__ bool next(int i, Unit& u) const {
        const int L = i * G + c; if (L >= nwg) return false;
        decode(L, u); u.ui = i; u.kt0 = 0; u.nkt = 0; u.ti = -1; return true;
    }
};

template <class Epi, class Sched, bool GATHER, bool KSPLIT = false, int ESZ = 2>
__device__ __forceinline__ void gemm_phase(LAS unsigned char* lds, const Gemm g, const Sched& S, const Epi& E, const LAS unsigned short* rowtab, int wv) {
    const int tid = opaque_tid(wv), wid = wv, lane = tid & 63, wr = wid >> 2, wc = wid & 3, fr = lane & 15, fq = lane >> 4;
    const int K = g.K, nt = K * ESZ / 128, lda = g.lda;
    unsigned voffB[2];
    unsigned vA00, vA01, vA10, vA11;
#pragma unroll
    for (int i = 0; i < 2; ++i) { int R, C; stage_rc(tid * 16 + i * 8192, R, C); const int Rb = Epi::PERM ? ((R & ~31) + perm32(R & 31)) : R;
        voffB[i] = (unsigned)(Rb * K * ESZ + C * 2); }
#define PG8_RC() int RA0, CA0, RA1, CA1; { int t_ = tid; asm volatile("" : "+v"(t_)); stage_rc(t_ * 16, RA0, CA0); stage_rc(t_ * 16 + 8192, RA1, CA1); }
    const size_t kstep = (size_t)(BK * 2);
    const size_t hstepB = (size_t)HALF * K * ESZ, tstepB = 2 * hstepB;
    const size_t tstepA = (size_t)BM * lda * ESZ;
    const size_t hA = GATHER ? 0 : (size_t)HALF * lda * ESZ;
    const unsigned ldsw = (unsigned)wid * 1024u;
    const int aoff = lds_byte(wr * 64 + fr, fq * 8), boff = lds_byte(wc * 32 + fr, fq * 8);
#define PG8_SA(b, h) (((b) * 2 + (h)) * HTB)
#define PG8_SB(b, h) ((4 + (b) * 2 + (h)) * HTB)
#define PG8_GLDS(gptr, ldsoff) __builtin_amdgcn_global_load_lds((const unsigned*)(gptr), (LAS unsigned*)(lds + (ldsoff)), 16, 0, 0)
#define PG8_GLDS_S(gbase, voff, ldsoff) do { unsigned keep_; asm volatile("s_mov_b32 %0, m0\n\ts_mov_b32 m0, %3\n\ts_nop 0\n\tglobal_load_lds_dwordx4 %1, %2\n\ts_mov_b32 m0, %0" \
        : "=&s"(keep_) : "v"(voff), "s"(gbase), "s"((unsigned)(size_t)(lds + (ldsoff))) : "memory"); } while (0)
#define PG8_STAGE_B(bufoff, gbase) do { if constexpr (ESZ == 1) { PG8_GLDS_S((const char*)(gbase), voffB[0], (bufoff) + ldsw); PG8_GLDS_S((const char*)(gbase) + (size_t)64 * K * ESZ, voffB[0], (bufoff) + ldsw + 8192); } \
        else { PG8_GLDS((const char*)(gbase) + voffB[0], (bufoff) + ldsw); PG8_GLDS((const char*)(gbase) + voffB[1], (bufoff) + ldsw + 8192); } } while (0)
#define PG8_STAGE_A(bufoff, gbase, v0, v1) do { if constexpr (ESZ == 1) { PG8_GLDS_S((const char*)(gbase), (v0), (bufoff) + ldsw); \
            if constexpr (GATHER) PG8_GLDS_S((const char*)(gbase), (v1), (bufoff) + ldsw + 8192); else PG8_GLDS_S((const char*)(gbase) + (size_t)64 * lda * ESZ, (v0), (bufoff) + ldsw + 8192); } \
        else { PG8_GLDS((const char*)(gbase) + (v0), (bufoff) + ldsw); PG8_GLDS((const char*)(gbase) + (v1), (bufoff) + ldsw + 8192); } } while (0)
#define PG8_STAGE_AG(bufoff, gbase, half, uix, v0, v1) do { if constexpr (GATHER) { const LAS unsigned short* q_ = rtp0 + (uix) * 256 + (half) * 128; int t0_ = q_[0], t1_ = q_[64]; \
            t0_ = t0_ == 0xFFFF ? 0 : t0_; t1_ = t1_ == 0xFFFF ? 0 : t1_;        \
            PG8_GLDS_S((const char*)(gbase), (unsigned)(t0_ * lda * ESZ) + cb2, (bufoff) + ldsw); PG8_GLDS_S((const char*)(gbase), (unsigned)(t1_ * lda * ESZ) + cb2, (bufoff) + ldsw + 8192); } \
        else PG8_STAGE_A(bufoff, (gbase) + ((half) ? hA : 0), v0, v1); } while (0)
#define PG8_LDA(dst, b, h) do { _Pragma("unroll") for (int m = 0; m < 4; ++m) { \
        if constexpr (ESZ == 2) { _Pragma("unroll") for (int k = 0; k < 2; ++k) dst[m][k] = *(const LAS bf16x8*)(lds + PG8_SA(b, h) + aoff + m * 2048 + k * 1024); } \
        else dst##8[m] = __builtin_shufflevector(*(const LAS i32x4*)(lds + PG8_SA(b, h) + aoff + m * 2048), *(const LAS i32x4*)(lds + PG8_SA(b, h) + aoff + m * 2048 + 1024), 0, 1, 2, 3, 4, 5, 6, 7); } } while (0)
#define PG8_LDB(dst, b, h) do { _Pragma("unroll") for (int n = 0; n < 2; ++n) { \
        if constexpr (ESZ == 2) { _Pragma("unroll") for (int k = 0; k < 2; ++k) dst[n][k] = *(const LAS bf16x8*)(lds + PG8_SB(b, h) + boff + n * 2048 + k * 1024); } \
        else dst##8[n] = __builtin_shufflevector(*(const LAS i32x4*)(lds + PG8_SB(b, h) + boff + n * 2048), *(const LAS i32x4*)(lds + PG8_SB(b, h) + boff + n * 2048 + 1024), 0, 1, 2, 3, 4, 5, 6, 7); } } while (0)
#define PG8_MMA(ai, bj, At, Bt) do { __builtin_amdgcn_s_setprio(1); _Pragma("unroll") for (int m = 0; m < 4; ++m) _Pragma("unroll") for (int n = 0; n < 2; ++n) { \
        if constexpr (ESZ == 2) { _Pragma("unroll") for (int k = 0; k < 2; ++k) acc[ai][bj][m][n] = __builtin_amdgcn_mfma_f32_16x16x32_bf16(Bt[n][k], At[m][k], acc[ai][bj][m][n], 0, 0, 0); } \
        else acc[ai][bj][m][n] = __builtin_amdgcn_mfma_scale_f32_16x16x128_f8f6f4(Bt##8[n], At##8[m], acc[ai][bj][m][n], 0, 0, 0, 0, 0, 0); } \
        __builtin_amdgcn_s_setprio(0); } while (0)
#define PG8_WAIT_V(n) asm volatile("s_waitcnt vmcnt(" #n ")" ::: "memory")
#define PG8_WAIT_L(n) asm volatile("s_waitcnt lgkmcnt(" #n ")" ::: "memory")
#define PG8_BAR __builtin_amdgcn_s_barrier()
#define PG8_SCHED __builtin_amdgcn_sched_barrier(0)
    Unit cur, nxt; int ui = 0;
    if (!S.next(0, cur)) return;
    f32x4 acc[2][2][4][2];
#pragma unroll
    for (int a = 0; a < 2; ++a)
#pragma unroll
        for (int b = 0; b < 2; ++b)
#pragma unroll
            for (int m = 0; m < 4; ++m)
#pragma unroll
                for (int n = 0; n < 2; ++n) acc[a][b][m][n] = (f32x4){0.f, 0.f, 0.f, 0.f};
    bf16x8 At[4][2], B0[2][2], B1[2][2];
    i32x8 At8[4], B08[2], B18[2];
    const char* cA; const char* cB = (const char*)g.Bt + (size_t)cur.pn * tstepB + (KSPLIT ? (size_t)cur.kt0 * kstep : 0);
    const LAS unsigned short* rtp0 = rowtab; unsigned cb2 = 0;
    if constexpr (GATHER) {
        static_assert(!GATHER || ESZ == 1, "gathered A rows: fp8 body only");
        cA = (const char*)g.A; PG8_RC();
        rtp0 = rowtab + RA0; cb2 = (unsigned)(CA0 * 2); vA00 = vA01 = vA10 = vA11 = 0;
    } else {
        cA = (const char*)g.A + (size_t)cur.pm * tstepA + (KSPLIT ? (size_t)cur.kt0 * kstep : 0); PG8_RC();
        vA00 = (unsigned)(RA0 * lda * ESZ + CA0 * 2); vA01 = (unsigned)(RA1 * lda * ESZ + CA1 * 2);
        vA10 = vA00; vA11 = vA01;
    }
    PG8_STAGE_B(PG8_SB(0, 0), cB); PG8_STAGE_B(PG8_SB(0, 1), cB + hstepB); PG8_STAGE_AG(PG8_SA(0, 0), cA, 0, cur.ui, vA00, vA01); PG8_STAGE_AG(PG8_SA(0, 1), cA, 1, cur.ui, vA10, vA11);
    if (wr == 1) PG8_BAR;
    PG8_WAIT_V(2); PG8_BAR;
    PG8_STAGE_B(PG8_SB(1, 0), cB + kstep); PG8_STAGE_AG(PG8_SA(1, 0), cA + kstep, 0, cur.ui, vA00, vA01); PG8_STAGE_B(PG8_SB(1, 1), cB + hstepB + kstep);
    PG8_WAIT_V(6); PG8_BAR;
    for (;;) {
        const bool has_next = S.next(ui + 1, nxt);
        const char* nA; const char* nB = has_next ? (const char*)g.Bt + (size_t)nxt.pn * tstepB + (KSPLIT ? (size_t)nxt.kt0 * kstep : 0) : cB;
        const int cnt = KSPLIT ? cur.nkt : nt;
        if constexpr (GATHER) {
            nA = cA;
        } else {
            nA = has_next ? (const char*)g.A + (size_t)nxt.pm * tstepA + (KSPLIT ? (size_t)nxt.kt0 * kstep : 0) : cA;
        }
        for (int t = 0; t < cnt; t += 2) {
            const bool last = (t == cnt - 2);
            const char* a1 = cA + (size_t)(t + 1) * kstep;
            const char* a2 = last ? nA : cA + (size_t)(t + 2) * kstep; const char* b2 = last ? nB : cB + (size_t)(t + 2) * kstep;
            const char* a3 = a2 + kstep; const char* b3 = b2 + kstep;
            unsigned w00 = vA00, w01 = vA01, w10 = vA10, w11 = vA11;
            const int uiN = (last && has_next) ? nxt.ui : cur.ui;
            PG8_LDB(B0, 0, 0); PG8_LDB(B1, 0, 1); PG8_SCHED; PG8_LDA(At, 0, 0); PG8_STAGE_AG(PG8_SA(1, 1), a1, 1, cur.ui, vA10, vA11);
            PG8_WAIT_V(8); PG8_WAIT_L(0); PG8_BAR; PG8_MMA(0, 0, At, B0); PG8_MMA(0, 1, At, B1); PG8_BAR; PG8_SCHED;
            PG8_LDA(At, 0, 1); PG8_STAGE_B(PG8_SB(0, 0), b2); PG8_STAGE_B(PG8_SB(0, 1), b2 + hstepB); PG8_STAGE_AG(PG8_SA(0, 0), a2, 0, uiN, w00, w01);
            PG8_WAIT_V(8); PG8_WAIT_L(0); PG8_BAR; PG8_MMA(1, 0, At, B0); PG8_MMA(1, 1, At, B1); PG8_BAR; PG8_SCHED;
            PG8_LDB(B0, 1, 0); PG8_LDB(B1, 1, 1); PG8_SCHED; PG8_LDA(At, 1, 0); PG8_STAGE_AG(PG8_SA(0, 1), a2, 1, uiN, w10, w11);
            PG8_WAIT_V(8); PG8_WAIT_L(0); PG8_BAR; PG8_MMA(0, 0, At, B0); PG8_MMA(0, 1, At, B1); PG8_BAR; PG8_SCHED;
            PG8_LDA(At, 1, 1); PG8_STAGE_B(PG8_SB(1, 0), b3); PG8_STAGE_B(PG8_SB(1, 1), b3 + hstepB); PG8_STAGE_AG(PG8_SA(1, 0), a3, 0, uiN, w00, w01);
            PG8_WAIT_V(8); PG8_WAIT_L(0); PG8_BAR; PG8_MMA(1, 0, At, B0); PG8_MMA(1, 1, At, B1); PG8_BAR; PG8_SCHED;
        }
        if (wr == 0) PG8_BAR;
        if constexpr (ESZ == 1) { const int l2_ = opaque_tid(wv) & 63; E(acc, cur, wr, wc, l2_ & 15, l2_ >> 4); }
        else E(acc, cur, wr, wc, fr, fq);
        if (!has_next) break;
#pragma unroll
        for (int a = 0; a < 2; ++a)
#pragma unroll
            for (int b = 0; b < 2; ++b)
#pragma unroll
                for (int m = 0; m < 4; ++m)
#pragma unroll
                    for (int n = 0; n < 2; ++n) acc[a][b][m][n] = (f32x4){0.f, 0.f, 0.f, 0.f};
        cur = nxt; cA = nA; cB = nB; ++ui;
        if (wr == 1) PG8_BAR;
    }
    PG8_WAIT_V(0);
    PG8_BAR;
#undef PG8_SA
#undef PG8_SB
#undef PG8_GLDS
#undef PG8_RC
#undef PG8_GLDS_S
#undef PG8_STAGE_A
#undef PG8_STAGE_AG
#undef PG8_STAGE_B
#undef PG8_LDA
#undef PG8_LDB
#undef PG8_MMA
#undef PG8_WAIT_V
#undef PG8_WAIT_L
#undef PG8_BAR
#undef PG8_SCHED
}
}

constexpr int MOE_NKT = FF / 128;
#ifndef MOE_NSLICE
#define MOE_NSLICE 7
#endif
using pg8::Unit;
__device__ __forceinline__ f32x4 row_ss_load(const float* SS, int row, int fq) { return *(const f32x4*)(SS + (unsigned)(row * 16 + 4 * fq)); }
__device__ __forceinline__ float row_rs_from(const f32x4 p) {
    float s = (p.x + p.y) + (p.z + p.w);
    s += __shfl_xor(s, 16); s += __shfl_xor(s, 32);
    return __builtin_amdgcn_rsqf(s + 1024.0f * EPS) * 32.0f;
}
constexpr float F8_SX = 8.f, F8_SW1 = 64.f, F8_SH = 4.f, F8_SW2 = 128.f;
template <bool CLAMP = false> __device__ __forceinline__ unsigned pk4_fp8(float a, float b, float c, float d) {
    if (CLAMP) { a = __builtin_amdgcn_fmed3f(a, -448.f, 448.f); b = __builtin_amdgcn_fmed3f(b, -448.f, 448.f); c = __builtin_amdgcn_fmed3f(c, -448.f, 448.f); d = __builtin_amdgcn_fmed3f(d, -448.f, 448.f); }
    int r = 0; r = __builtin_amdgcn_cvt_pk_fp8_f32(a, b, r, false); r = __builtin_amdgcn_cvt_pk_fp8_f32(c, d, r, true); return (unsigned)r; }
__device__ __forceinline__ u32x4 pack8(const f32x4 a, const f32x4 b) { u32x4 w; w.x = pk2(a[0], a[1]); w.y = pk2(a[2], a[3]); w.z = pk2(b[0], b[1]); w.w = pk2(b[2], b[3]); return w; }

struct EpiScale {
    static constexpr bool PERM = true;
    bf16* O; int ldc; const float* SS; float* kmean; int kcol0;
    __device__ __forceinline__ void operator()(const f32x4 (&acc)[2][2][4][2], const Unit& u, int wr, int wc, int fr, int fq) const {
        const int row0 = u.pm * 256 + wr * 64 + fr, col0 = u.pn * 256 + wc * 32 + 8 * fq;
        const bool dok = (kmean != nullptr) && (u.pn * 256 >= kcol0);
        f32x4 ks[2][2];
#pragma unroll
        for (int bj = 0; bj < 2; ++bj)
#pragma unroll
            for (int n = 0; n < 2; ++n) ks[bj][n] = (f32x4){0.f, 0.f, 0.f, 0.f};
        f32x4 pp[2][4];
#pragma unroll
        for (int ai = 0; ai < 2; ++ai)
#pragma unroll
            for (int m = 0; m < 4; ++m) pp[ai][m] = row_ss_load(SS, row0 + ai * 128 + m * 16, fq);
#pragma unroll
        for (int ai = 0; ai < 2; ++ai)
#pragma unroll
            for (int m = 0; m < 4; ++m) {
                const int row = row0 + ai * 128 + m * 16; const float rs = row_rs_from(pp[ai][m]);
                bf16* rowp = O + (size_t)row * ldc + col0;
#pragma unroll
                for (int bj = 0; bj < 2; ++bj) { const f32x4 v0 = acc[ai][bj][m][0] * rs, v1 = acc[ai][bj][m][1] * rs;
                    ks[bj][0] += v0; ks[bj][1] += v1;
                    *(u32x4*)(rowp + bj * 128) = pack8(v0, v1); }
            }
        if (dok) {
#pragma unroll
            for (int bj = 0; bj < 2; ++bj)
#pragma unroll
                for (int n = 0; n < 2; ++n)
#pragma unroll
                    for (int j = 0; j < 4; ++j) { float v = ks[bj][n][j];
                        v += __shfl_xor(v, 1); v += __shfl_xor(v, 2); v += __shfl_xor(v, 4); v += __shfl_xor(v, 8);
                        if (fr == 0) unsafeAtomicAdd(kmean + (size_t)u.pm * MOBA_W + (col0 + bj * 128 + 4 * n + j - kcol0), v); }
        }
    }
};
struct EpiVT {
    static constexpr bool PERM = true;
    bf16* O; int ldc; const float* RS;
    __device__ __forceinline__ void operator()(const f32x4 (&acc)[2][2][4][2], const Unit& u, int wr, int wc, int fr, int fq) const {
        const int row0 = u.pm * 256 + wr * 64 + fr, col0 = u.pn * 256 + wc * 32 + 8 * fq;
        f32x4 rs[2][2];
#pragma unroll
        for (int bj = 0; bj < 2; ++bj) { rs[bj][0] = *(const f32x4*)(RS + col0 + bj * 128); rs[bj][1] = *(const f32x4*)(RS + col0 + bj * 128 + 4); }
#pragma unroll
        for (int ai = 0; ai < 2; ++ai)
#pragma unroll
            for (int m = 0; m < 4; ++m) {
                bf16* rowp = O + (size_t)(row0 + ai * 128 + m * 16) * ldc + col0;
#pragma unroll
                for (int bj = 0; bj < 2; ++bj) *(u32x4*)(rowp + bj * 128) = pack8(acc[ai][bj][m][0] * rs[bj][0], acc[ai][bj][m][1] * rs[bj][1]);
            }
    }
};
template <bool F8, bool BASEBF, bool WF32> struct EpiResid {
    static constexpr bool PERM = true;
    const float* base; float* out; bf16* xb; float* SS; unsigned char* xb8;
    __device__ __forceinline__ void operator()(const f32x4 (&acc)[2][2][4][2], const Unit& u, int wr, int wc, int fr, int fq) const {
        const int row0 = u.pm * 256 + wr * 64 + fr, col0 = u.pn * 256 + wc * 32 + 8 * fq;
        static_assert(BASEBF, "EpiResid: the residual base is the bf16 stream");
        u32x4 bw[2][4][2];
#pragma unroll
        for (int ai = 0; ai < 2; ++ai)
#pragma unroll
            for (int m = 0; m < 4; ++m)
#pragma unroll
                for (int bj = 0; bj < 2; ++bj) bw[ai][m][bj] = *(const u32x4*)(xb + (unsigned)((row0 + ai * 128 + m * 16) * D + col0 + bj * 128));
#pragma unroll
        for (int ai = 0; ai < 2; ++ai)
#pragma unroll
            for (int m = 0; m < 4; ++m) {
                const int row = row0 + ai * 128 + m * 16; const unsigned off = (unsigned)(row * D + col0); float sq = 0.f;
#pragma unroll
                for (int bj = 0; bj < 2; ++bj) {
                    const u32x4 b = bw[ai][m][bj];
                    const f32x4 b0 = (f32x4){bflo(b.x), bfhi(b.x), bflo(b.y), bfhi(b.y)}, b1 = (f32x4){bflo(b.z), bfhi(b.z), bflo(b.w), bfhi(b.w)};
                    const f32x4 v0 = acc[ai][bj][m][0] + b0, v1 = acc[ai][bj][m][1] + b1;
                    if (WF32) { *(f32x4*)(out + off + bj * 128) = v0; *(f32x4*)(out + off + bj * 128 + 4) = v1; }
                    else *(u32x4*)(xb + off + bj * 128) = pack8(v0, v1);
                    if (F8) { u32x2 t8; t8.x = pk4_fp8(v0[0] * F8_SX, v0[1] * F8_SX, v0[2] * F8_SX, v0[3] * F8_SX); t8.y = pk4_fp8(v1[0] * F8_SX, v1[1] * F8_SX, v1[2] * F8_SX, v1[3] * F8_SX); *(u32x2*)(xb8 + off + bj * 128) = t8; }
                    sq += (v0[0] * v0[0] + v0[1] * v0[1]) + (v0[2] * v0[2] + v0[3] * v0[3]) + (v1[0] * v1[0] + v1[1] * v1[1]) + (v1[2] * v1[2] + v1[3] * v1[3]);
                }
                sq += __shfl_xor(sq, 16); sq += __shfl_xor(sq, 32);
                if (fq == 0) SS[(unsigned)(row * 16 + u.pn * 4 + wc)] = sq;
            }
    }
};
template <bool MOE> struct EpiGateUp {
    static constexpr bool PERM = true;
    bf16* O; const float* SS; const LAS unsigned short* rowtab;
    __device__ __forceinline__ void operator()(const f32x4 (&acc)[2][2][4][2], const Unit& u, int wr, int wc, int fr, int fq) const {
        if (MOE) asm volatile("" : "+v"(fr), "+v"(fq));
        const int pnl = MOE ? (u.pn % 28) : u.pn, colo = pnl * 128 + wc * 32 + 8 * fq;
        f32x4 pp[2][4]; float rsm[2][4];
        const float* rsg_ = MOE ? (const float*)((*kargs()).ws + WS_RSG) : nullptr;
#pragma unroll
        for (int ai = 0; ai < 2; ++ai)
#pragma unroll
            for (int m = 0; m < 4; ++m) { const int orow = u.pm * 256 + ai * 128 + wr * 64 + m * 16 + fr;
                if (MOE) { int tk_ = rowtab[u.ui * 256 + ai * 128 + wr * 64 + m * 16 + fr]; tk_ = tk_ == 0xFFFF ? 0 : tk_; rsm[ai][m] = rsg_[(unsigned)tk_]; } else pp[ai][m] = row_ss_load(SS, orow, fq); }
#pragma unroll
        for (int ai = 0; ai < 2; ++ai)
#pragma unroll
            for (int m = 0; m < 4; ++m) {
                const int rl = ai * 128 + wr * 64 + m * 16 + fr, orow = u.pm * 256 + rl;
                const float rs = MOE ? rsm[ai][m] * (1.0f / (F8_SX * F8_SW1)) : row_rs_from(pp[ai][m]);
                const f32x4 g0 = acc[ai][0][m][0] * rs, g1 = acc[ai][0][m][1] * rs, u0 = acc[ai][1][m][0] * rs, u1 = acc[ai][1][m][1] * rs;
                f32x4 h0, h1;
#pragma unroll
                for (int j = 0; j < 4; ++j) { h0[j] = silu_f(g0[j]) * u0[j]; h1[j] = silu_f(g1[j]) * u1[j]; }
                if (MOE) { u32x2 t8; t8.x = pk4_fp8(h0[0] * F8_SH, h0[1] * F8_SH, h0[2] * F8_SH, h0[3] * F8_SH); t8.y = pk4_fp8(h1[0] * F8_SH, h1[1] * F8_SH, h1[2] * F8_SH, h1[3] * F8_SH);
                           *(u32x2*)((unsigned char*)O + (unsigned)(orow * FF + colo)) = t8; }
                else *(u32x4*)(O + (size_t)orow * FF + colo) = pack8(h0, h1);
            }
    }
};
struct EpiMoeDown {
    static constexpr bool PERM = true;
    bf16* yp0; unsigned ypstride; const float* GW; const LAS int* pan; const LAS unsigned short* rowtab; float* scr; int nsl;
    __device__ __forceinline__ void operator()(const f32x4 (&acc)[2][2][4][2], const Unit& u, int wr, int wc, int fr, int fq) const {
        asm volatile("" : "+v"(fr), "+v"(fq));
        const int pnl = u.pn & 3, col0 = pnl * 256 + wc * 32 + 8 * fq;
        if (u.ti >= 0) {
            float* sp = scr + ((size_t)(u.ti * nsl + u.kt0 / u.nkt)) * 65536 + wc * 32 + 8 * fq;
#pragma unroll
            for (int ai = 0; ai < 2; ++ai)
#pragma unroll
                for (int m = 0; m < 4; ++m) { float* rp = sp + (ai * 128 + wr * 64 + m * 16 + fr) * 256;
#pragma unroll
                    for (int bj = 0; bj < 2; ++bj) { *(f32x4*)(rp + bj * 128) = acc[ai][bj][m][0]; *(f32x4*)(rp + bj * 128 + 4) = acc[ai][bj][m][1]; } }
            return;
        }
        const int k = (pan[u.pm] >> 19) & 1;
        bf16* yp = yp0 + (size_t)k * ypstride;
        int tk[2][4]; float wt[2][4];
#pragma unroll
        for (int ai = 0; ai < 2; ++ai)
#pragma unroll
            for (int m = 0; m < 4; ++m) tk[ai][m] = rowtab[u.ui * 256 + ai * 128 + wr * 64 + m * 16 + fr];
#pragma unroll
        for (int ai = 0; ai < 2; ++ai)
#pragma unroll
            for (int m = 0; m < 4; ++m) wt[ai][m] = GW[(unsigned)((tk[ai][m] == 0xFFFF ? 0 : tk[ai][m]) * 2 + k)];
#pragma unroll
        for (int ai = 0; ai < 2; ++ai)
#pragma unroll
            for (int m = 0; m < 4; ++m) {
                const int tok = tk[ai][m];
                if (tok != 0xFFFF) { const float w = wt[ai][m] * (1.0f / (F8_SH * F8_SW2)); bf16* p = yp + (unsigned)(tok * D + col0);
#pragma unroll
                    for (int bj = 0; bj < 2; ++bj) *(u32x4*)(p + bj * 128) = pack8(acc[ai][bj][m][0] * w, acc[ai][bj][m][1] * w); }
                asm volatile("" ::: "memory");
            }
    }
};

struct CvtJ { const float* s0; const float* s1; const float* g; bf16* d; int ld, K, nr, c0, md, nv, n, f8; float sc; };
__device__ __forceinline__ void cvt_load(const CvtJ& J, int item, int lane, f32x4 (&v)[8]) {
    const int nblk = J.nr / 32, kb = item / nblk, nb = item % nblk, k0 = 64 * kb, n0 = 32 * nb;
    const float* src = J.s0; int col = J.c0 + n0;
    if (J.md == 1) { const int blk = n0 >> 8, r = n0 & 255; src = (r < 128) ? J.s0 : J.s1; col = blk * 128 + (r & 127); }
    const int lr = lane >> 3, lc = (lane & 7) * 4;
    const bool ok = (n0 + lc) < J.nv;
#pragma unroll
    for (int i = 0; i < 8; ++i) { v[i] = (f32x4){0.f, 0.f, 0.f, 0.f}; if (ok) v[i] = *(const GAS f32x4*)(src + (size_t)(k0 + 8 * i + lr) * J.ld + col + lc); }
    if (J.g) {
#pragma unroll
        for (int i = 0; i < 8; ++i) v[i] = v[i] * J.g[k0 + 8 * i + lr];
    }
}
__device__ __forceinline__ void cvt_store(const CvtJ& J, int item, int lane, LAS float* scr, const f32x4 (&v)[8]) {
    const int nblk = J.nr / 32, kb = item / nblk, nb = item % nblk, k0 = 64 * kb, n0 = 32 * nb;
    const int lr = lane >> 3, lc = (lane & 7) * 4;
#pragma unroll
    for (int i = 0; i < 8; ++i) { LAS float* sp = scr + (8 * i + lr) * 33 + lc; sp[0] = v[i].x; sp[1] = v[i].y; sp[2] = v[i].z; sp[3] = v[i].w; }
    LDS_WAIT(); asm volatile("" ::: "memory");
    if (J.f8) {
        const int c4 = lane & 3; const float sc = J.sc;
#pragma unroll
        for (int j = 0; j < 2; ++j) { const int n = (lane >> 2) + 16 * j; const LAS float* s = scr + (16 * c4) * 33 + n;
            u32x4 o; o.x = pk4_fp8<true>(s[0 * 33] * sc, s[1 * 33] * sc, s[2 * 33] * sc, s[3 * 33] * sc); o.y = pk4_fp8<true>(s[4 * 33] * sc, s[5 * 33] * sc, s[6 * 33] * sc, s[7 * 33] * sc);
            o.z = pk4_fp8<true>(s[8 * 33] * sc, s[9 * 33] * sc, s[10 * 33] * sc, s[11 * 33] * sc); o.w = pk4_fp8<true>(s[12 * 33] * sc, s[13 * 33] * sc, s[14 * 33] * sc, s[15 * 33] * sc);
            *(GAS u32x4*)((unsigned char*)J.d + (size_t)(n0 + n) * J.K + k0 + 16 * c4) = o; }
    } else {
    const int c = lane & 7;
#pragma unroll
    for (int j = 0; j < 4; ++j) { const int n = (lane >> 3) + 8 * j; const LAS float* s = scr + (8 * c) * 33 + n;
        u32x4 o; o.x = pk2(s[0 * 33], s[1 * 33]); o.y = pk2(s[2 * 33], s[3 * 33]); o.z = pk2(s[4 * 33], s[5 * 33]); o.w = pk2(s[6 * 33], s[7 * 33]);
        *(GAS u32x4*)(J.d + (size_t)(n0 + n) * J.K + k0 + 8 * c) = o; }
    }
    LDS_WAIT(); asm volatile("" ::: "memory");
}
#define CVT_DECL() CvtJ J; J.s0 = nullptr; J.s1 = nullptr; J.g = nullptr; J.d = nullptr; J.ld = 0; J.K = 64; J.nr = 32; J.c0 = 0; J.md = 0; J.nv = 0; J.n = 0; J.f8 = 0; J.sc = 1.f; bool j_found = false;
#define CVT_JOB(src0, src1, gain, dst, ld_, K_, nrows, col0, mode, nvalid) { const int _n = ((K_) / 64) * ((nrows) / 32); \
    if (!j_found) { if (r < _n) { J.s0 = (src0); J.s1 = (src1); J.g = (gain); J.d = (dst); J.ld = (ld_); J.K = (K_); J.nr = (nrows); J.c0 = (col0); J.md = (mode); J.nv = (nvalid); J.n = _n; j_found = true; } else r -= _n; } }
#define CVT_JOB8(src0, src1, gain, dst, ld_, K_, nrows, col0, mode, nvalid, scale) { const int _n = ((K_) / 64) * ((nrows) / 32); \
    if (!j_found) { if (r < _n) { J.s0 = (src0); J.s1 = (src1); J.g = (gain); J.d = (bf16*)(dst); J.ld = (ld_); J.K = (K_); J.nr = (nrows); J.c0 = (col0); J.md = (mode); J.nv = (nvalid); J.n = _n; J.f8 = 1; J.sc = (scale); j_found = true; } else r -= _n; } }
#define CVT_RUN(it, end) do { int m_ = J.n - r; if ((end) - (it) < m_) m_ = (end) - (it); if (!j_found || m_ < 1) m_ = 1; \
    if (j_found) { f32x4 va[8], vb[8], vc[8]; cvt_load(J, r, lane, va); if (m_ > 1) cvt_load(J, r + 1, lane, vb);       \
        for (int j_ = 0; j_ < m_; j_ += 3) { \
            if (j_ + 2 < m_) cvt_load(J, r + j_ + 2, lane, vc); cvt_store(J, r + j_, lane, scr, va); \
            if (j_ + 1 < m_) { if (j_ + 3 < m_) cvt_load(J, r + j_ + 3, lane, va); cvt_store(J, r + j_ + 1, lane, scr, vb); } \
            if (j_ + 2 < m_) { if (j_ + 4 < m_) cvt_load(J, r + j_ + 4, lane, vb); cvt_store(J, r + j_ + 2, lane, scr, vc); } } } \
    (it) += m_; } while (0)

namespace att {
constexpr int KBUF = 0, VBUF = 32768, LUT_OFF = 65536, KM_OFF = 65536 + 1024;
__device__ __forceinline__ int ks_off(int row, int chunk) { return row * 256 + ((chunk ^ ((row & 3) | (((row >> 3) & 3) << 2))) << 4); }
__device__ __forceinline__ int vs_off(int row, int chunk) { return row * 128 + ((chunk ^ (((row >> 1) & 1) | (((row >> 3) & 3) << 1))) << 4); }
constexpr float C1 = 0.08838834764831845f * LOG2E;
__device__ __forceinline__ int qt_base(int w) { return w < 7 ? 73728 + w * 8192 : 133120; }
__device__ __forceinline__ int qt_off(int row, int piece) { return row * 256 + ((piece ^ (row & 15)) << 4); }

template <bool MOBA>
__device__ __forceinline__ void attn_unit(LAS unsigned char* lds, int wv, bf16* Qb, int ldq, const bf16* Kb, int ldk, const bf16* VTb, int ldvt, int ntiles,
                                          int nblk, const float* ksum_bh, const float* rel_bias, int head, bool dry = false) {
    const int tid = opaque_tid(wv), lane = tid & 63, w = wv, c = lane & 31, hi = lane >> 5;
    int kofs0, kofs1, vofs0, vofs1;
    { const int r0 = w * 4 + (lane >> 4), r1 = r0 + 32, cs = lane & 15;
      kofs0 = r0 * ldk + ((cs ^ ((r0 & 3) | (((r0 >> 3) & 3) << 2))) << 3); kofs1 = r1 * ldk + ((cs ^ ((r1 & 3) | (((r1 >> 3) & 3) << 2))) << 3);
      const int v0 = w * 8 + (lane >> 3), v1 = v0 + 64, cv = lane & 7;
      vofs0 = v0 * ldvt + ((cv ^ (((v0 >> 1) & 1) | (((v0 >> 3) & 3) << 1))) << 3); vofs1 = v1 * ldvt + ((cv ^ (((v1 >> 1) & 1) | (((v1 >> 3) & 3) << 1))) << 3); }
#define ATT_GLDS(gptr, ldsoff) __builtin_amdgcn_global_load_lds((const unsigned*)(gptr), (LAS unsigned*)(lds + (ldsoff)), 16, 0, 0)
#define ATT_STAGE(ti, buf) do { const bf16* kt_ = Kb + (size_t)(64 * (ti)) * ldk; const bf16* vt_ = VTb + 64 * (ti); \
        ATT_GLDS(kt_ + kofs0, (buf) * 16384 + KBUF + w * 1024); ATT_GLDS(kt_ + kofs1, (buf) * 16384 + KBUF + 8192 + w * 1024); \
        ATT_GLDS(vt_ + vofs0, (buf) * 16384 + VBUF + w * 1024); ATT_GLDS(vt_ + vofs1, (buf) * 16384 + VBUF + 8192 + w * 1024); } while (0)
    ATT_STAGE(0, 0);
    LAS float* lut = (LAS float*)(lds + LUT_OFF);
    LAS float* km = (LAS float*)(lds + KM_OFF);
    if (MOBA) {
        if (tid < 130) { float v;
            if (tid == 0) v = -__builtin_inff();
            else { const int d = tid - 1; int bk;
                if (d < 16) bk = d; else if (d >= 128) bk = 31;
                else bk = 16 + (d >= 19) + (d >= 21) + (d >= 24) + (d >= 27) + (d >= 31) + (d >= 35) + (d >= 40) + (d >= 46) + (d >= 52) + (d >= 59) + (d >= 67) + (d >= 77) + (d >= 87) + (d >= 99) + (d >= 113);
                v = rel_bias[bk * MOBA_H + head] * LOG2E; }
            lut[tid] = v; }
        for (int idx = tid; idx < nblk * 128; idx += NTHR) km[idx] = ksum_bh[(size_t)(idx >> 7) * MOBA_W + (idx & 127)];
    }
    LAS unsigned char* qt = lds + qt_base(w);
    bf16* qtile = Qb + (size_t)(32 * w) * ldq;
    const int qr = lane >> 4, qp = lane & 15;
    { u32x4 qq[8];
#pragma unroll
      for (int i = 0; i < 8; ++i) qq[i] = *(const u32x4*)(qtile + (size_t)(4 * i + qr) * ldq + 8 * qp);
#pragma unroll
      for (int i = 0; i < 8; ++i) *(LAS u32x4*)(qt + qt_off(4 * i + qr, qp)) = qq[i]; }
    LDS_WAIT(); asm volatile("" ::: "memory");
    bf16x8 qf[8];
#pragma unroll
    for (int ks = 0; ks < 8; ++ks) qf[ks] = *(const LAS bf16x8*)(qt + qt_off(c, 2 * ks + hi));
    LDS_WAIT(); asm volatile("" ::: "memory");
    VM_WAIT();
    __syncthreads();
    unsigned selmask = 0;
    if (MOBA) {
        if (nblk <= 3) selmask = (1u << nblk) - 1u;
        else {
            float g[7];
#pragma unroll
            for (int j = 0; j < 7; ++j) { g[j] = -__builtin_inff();
                if (j < nblk) { float s = 0.f;
#pragma unroll
                    for (int ks = 0; ks < 8; ++ks) { const LAS float* kp = km + j * 128 + 16 * ks + 8 * hi; const f32x4 k0 = *(const LAS f32x4*)kp, k1 = *(const LAS f32x4*)(kp + 4);
                        const u32x4 qw = __builtin_bit_cast(u32x4, qf[ks]);
                        s += bflo(qw.x) * k0[0] + bfhi(qw.x) * k0[1] + bflo(qw.y) * k0[2] + bfhi(qw.y) * k0[3] + bflo(qw.z) * k1[0] + bfhi(qw.z) * k1[1] + bflo(qw.w) * k1[2] + bfhi(qw.w) * k1[3]; }
                    s += __shfl_xor(s, 32); g[j] = s; } }
#pragma unroll
            for (int pick = 0; pick < 3; ++pick) { float best = -__builtin_inff(); int bi = 0;
#pragma unroll
                for (int j = 0; j < 7; ++j) { const bool cand = (j < nblk) && !((selmask >> j) & 1u) && (g[j] > best); best = cand ? g[j] : best; bi = cand ? j : bi; }
                selmask |= 1u << bi; }
        }
    }
    const int pi = (c & ~0xC) | ((c & 4) << 1) | ((c & 8) >> 1);
    const int kra = ks_off(pi, 0) & ~0xF0, kxa = (pi & 3) | (((pi >> 3) & 3) << 2);
    const int vxa = ((c >> 1) & 1) | (((c >> 3) & 3) << 1);
    float m_run = -1e30f, l_run = 0.f;
    f32x16 o0, o1, o2, o3;
#pragma unroll
    for (int r = 0; r < 16; ++r) { o0[r] = 0.f; o1[r] = 0.f; o2[r] = 0.f; o3[r] = 0.f; }
    const int qpos = 256 * nblk + 32 * w + c;
    const float bfar = MOBA ? lut[129] : 0.f;
    for (int ti = 0; ti < ntiles; ++ti) {
        const int cur = ti & 1;
        int kx = kxa, vx = vxa; asm volatile("" : "+v"(kx), "+v"(vx));
        if (ti + 1 < ntiles) ATT_STAGE(ti + 1, cur ^ 1);
        const int kb = 64 * ti;
        bool skip = false, nearb = false, own = false;
        if (MOBA) { own = ((ti >> 2) == nblk); const int qlo = 256 * nblk + 32 * w;
            skip = own && (kb > qlo + 31);
            nearb = (qlo - (kb + 63)) < 128; }
        if (!skip) {
            f32x16 p0, p1;
#pragma unroll
            for (int r = 0; r < 16; ++r) { p0[r] = 0.f; p1[r] = 0.f; }
            const LAS unsigned char* kbase = lds + cur * 16384 + KBUF + kra;
#pragma unroll
            for (int ks = 0; ks < 8; ++ks) { const int co = ((2 * ks + hi) ^ kx) << 4;
                const bf16x8 a0 = *(const LAS bf16x8*)(kbase + co), a1 = *(const LAS bf16x8*)(kbase + 8192 + co);
                p0 = MFMA32(a0, qf[ks], p0); p1 = MFMA32(a1, qf[ks], p1);
                if (ks == 3) __builtin_amdgcn_sched_barrier(0); }
            float offs = 0.f;
            if (MOBA) { const bool sel = own || ((selmask >> (ti >> 2)) & 1u); offs = sel ? 0.f : -__builtin_inff(); }
            if (MOBA && nearb) {
#pragma unroll
                for (int r = 0; r < 16; ++r) { const int kl = (r & 7) + 8 * hi + 16 * (r >> 3);
                    int i0 = qpos - (kb + kl) + 1, i1 = i0 - 32;
                    i0 = i0 < 0 ? 0 : (i0 > 129 ? 129 : i0); i1 = i1 < 0 ? 0 : (i1 > 129 ? 129 : i1);
                    p0[r] = __builtin_fmaf(p0[r], C1, lut[i0] + offs); p1[r] = __builtin_fmaf(p1[r], C1, lut[i1] + offs);
                    if ((r & 3) == 3) __builtin_amdgcn_sched_barrier(0); }
            } else {
                const float ob = bfar + offs;
#pragma unroll
                for (int r = 0; r < 16; ++r) { p0[r] = __builtin_fmaf(p0[r], C1, ob); p1[r] = __builtin_fmaf(p1[r], C1, ob); }
            }
            float mx = p0[0];
#pragma unroll
            for (int r = 1; r < 16; ++r) mx = fmaxf(mx, p0[r]);
#pragma unroll
            for (int r = 0; r < 16; ++r) mx = fmaxf(mx, p1[r]);
            mx = fmaxf(mx, __shfl_xor(mx, 32));
            float mn = m_run;
            if (!__all(mx - m_run <= 8.0f)) {
                mn = fmaxf(m_run, mx); const float alpha = fast_exp2(m_run - mn); m_run = mn;
                l_run *= alpha; o0 *= alpha; o1 *= alpha; o2 *= alpha; o3 *= alpha; }
            float ls = 0.f;
#pragma unroll
            for (int r = 0; r < 16; ++r) { p0[r] = fast_exp2(p0[r] - mn); p1[r] = fast_exp2(p1[r] - mn); ls += p0[r] + p1[r]; }
            l_run += ls;
            bf16x8 pf[4];
            { u32x4 t;
              t.x = pk2(p0[0], p0[1]); t.y = pk2(p0[2], p0[3]); t.z = pk2(p0[4], p0[5]); t.w = pk2(p0[6], p0[7]); pf[0] = __builtin_bit_cast(bf16x8, t);
              t.x = pk2(p0[8], p0[9]); t.y = pk2(p0[10], p0[11]); t.z = pk2(p0[12], p0[13]); t.w = pk2(p0[14], p0[15]); pf[1] = __builtin_bit_cast(bf16x8, t);
              t.x = pk2(p1[0], p1[1]); t.y = pk2(p1[2], p1[3]); t.z = pk2(p1[4], p1[5]); t.w = pk2(p1[6], p1[7]); pf[2] = __builtin_bit_cast(bf16x8, t);
              t.x = pk2(p1[8], p1[9]); t.y = pk2(p1[10], p1[11]); t.z = pk2(p1[12], p1[13]); t.w = pk2(p1[14], p1[15]); pf[3] = __builtin_bit_cast(bf16x8, t); }
            const LAS unsigned char* vbase = lds + cur * 16384 + VBUF + c * 128;
#pragma unroll
            for (int q = 0; q < 4; ++q) { const int co = ((2 * q + hi) ^ vx) << 4;
                o0 = MFMA32(*(const LAS bf16x8*)(vbase + co), pf[q], o0);
                o1 = MFMA32(*(const LAS bf16x8*)(vbase + 4096 + co), pf[q], o1);
                o2 = MFMA32(*(const LAS bf16x8*)(vbase + 8192 + co), pf[q], o2);
                o3 = MFMA32(*(const LAS bf16x8*)(vbase + 12288 + co), pf[q], o3);
                if (q == 1) __builtin_amdgcn_sched_barrier(0); }
        }
        VM_WAIT();
        __syncthreads();
    }
    const float inv = 1.0f / (l_run + __shfl_xor(l_run, 32));
    int l2 = lane; asm volatile("" : "+v"(l2));
    const int c2 = l2 & 31, h2 = l2 >> 5, qr2 = l2 >> 4, qp2 = l2 & 15;
#pragma unroll
    for (int a = 0; a < 4; ++a) {
        u32x2 t;
        t.x = pk2(o0[4 * a] * inv, o0[4 * a + 1] * inv); t.y = pk2(o0[4 * a + 2] * inv, o0[4 * a + 3] * inv); *(LAS u32x2*)(qt + qt_off(c2, a) + 8 * h2) = t;
        t.x = pk2(o1[4 * a] * inv, o1[4 * a + 1] * inv); t.y = pk2(o1[4 * a + 2] * inv, o1[4 * a + 3] * inv); *(LAS u32x2*)(qt + qt_off(c2, 4 + a) + 8 * h2) = t;
        t.x = pk2(o2[4 * a] * inv, o2[4 * a + 1] * inv); t.y = pk2(o2[4 * a + 2] * inv, o2[4 * a + 3] * inv); *(LAS u32x2*)(qt + qt_off(c2, 8 + a) + 8 * h2) = t;
        t.x = pk2(o3[4 * a] * inv, o3[4 * a + 1] * inv); t.y = pk2(o3[4 * a + 2] * inv, o3[4 * a + 3] * inv); *(LAS u32x2*)(qt + qt_off(c2, 12 + a) + 8 * h2) = t;
    }
    LDS_WAIT(); asm volatile("" ::: "memory");
#pragma unroll
    for (int i = 0; i < 8; ++i) { const u32x4 oq = *(const LAS u32x4*)(qt + qt_off(4 * i + qr2, qp2)); if (!dry) *(u32x4*)(qtile + (size_t)(4 * i + qr2) * ldq + 8 * qp2) = oq; }
    LDS_WAIT(); asm volatile("" ::: "memory");
#undef ATT_GLDS
#undef ATT_STAGE
}
}

namespace ssd {
constexpr int DT_OFF = 0, CS_OFF = 3072, SSP_OFF = 6144;
constexpr int A_BMT = 8192, A_XT = 8192 + 32768;
constexpr int C_BM = 8192, C_CM = 8192 + 32768, C_XT = 8192 + 65536;
__device__ __forceinline__ int sw_off(int row, int chunk) { return row * 256 + ((chunk ^ ((row & 3) | (((row >> 3) & 3) << 2))) << 4); }

__device__ __forceinline__ int zt_base(int w) { return w < 6 ? 106496 + w * 4096 : 133120 + (w - 6) * 4096; }
__device__ __forceinline__ int zt_off(int row, int piece) { return row * 128 + ((piece ^ (row & 7)) << 4); }
struct Par { const bf16* proj; const float* conv_w; const float* conv_b; const float* dt_bias; const float* a_log; const float* d_skip; const float* g_out; bf16* states; float* cdec; };

__device__ __forceinline__ void dtcs(LAS unsigned char* lds, int wv, const Par& P, int b, int c, int g, bool write_cdec) {
    const int tid = opaque_tid(wv), lane = tid & 63, w = wv;
    if (w < 6) {
        const int hd = g * 6 + w; const size_t row0 = (size_t)b * SEQ + c * SSD_CH + 2 * lane;
        const float r0 = bf2f(P.proj[row0 * P1W + P1_DT + hd]), r1 = bf2f(P.proj[(row0 + 1) * P1W + P1_DT + hd]);
        const float bias = P.dt_bias[hd], A = -expf(P.a_log[hd]);
        const float x0 = r0 + bias, x1 = r1 + bias;
        const float d0 = x0 > 20.f ? x0 : log1pf(expf(x0)), d1 = x1 > 20.f ? x1 : log1pf(expf(x1));
        const float la0 = d0 * A, la1 = d1 * A; const float s1 = la0 + la1; float v = s1;
#pragma unroll
        for (int off = 1; off < 64; off <<= 1) { const float t = __shfl_up(v, off); if (lane >= off) v += t; }
        LAS float* dt = (LAS float*)(lds + DT_OFF) + w * 128; LAS float* cs = (LAS float*)(lds + CS_OFF) + w * 128;
        dt[2 * lane] = d0; dt[2 * lane + 1] = d1; cs[2 * lane] = v - s1 + la0; cs[2 * lane + 1] = v;
        if (write_cdec && lane == 63) P.cdec[((size_t)b * NCHUNK + c) * SSD_H + hd] = expf(v);
    }
}
__device__ __forceinline__ void conv8(const Par& P, int b, int s0, int chx, float (&y0)[8], float (&y1)[8]) {
    float x0[11], x1[11];
    const bf16* base = P.proj + ((size_t)b * SEQ) * P1W + P1_XBC + chx;
#pragma unroll
    for (int j = 0; j < 11; ++j) { const int s = s0 - 3 + j; unsigned wv = 0u; if (s >= 0) wv = *(const unsigned*)(base + (size_t)s * P1W); x0[j] = bflo(wv); x1[j] = bfhi(wv); }
    f32x2 wj[4];
#pragma unroll
    for (int j = 0; j < 4; ++j) wj[j] = *(const f32x2*)(P.conv_w + j * CONV_DIM + chx);
    const f32x2 bb = *(const f32x2*)(P.conv_b + chx);
#pragma unroll
    for (int i = 0; i < 8; ++i) {
        const float a0 = bb.x + wj[0].x * x0[i] + wj[1].x * x0[i + 1] + wj[2].x * x0[i + 2] + wj[3].x * x0[i + 3];
        const float a1 = bb.y + wj[0].y * x1[i] + wj[1].y * x1[i + 1] + wj[2].y * x1[i + 2] + wj[3].y * x1[i + 3];
        y0[i] = silu_f(a0); y1[i] = silu_f(a1); }
}
__device__ __forceinline__ u32x4 pack8f(const float (&y)[8]) { u32x4 t; t.x = pk2(y[0], y[1]); t.y = pk2(y[2], y[3]); t.z = pk2(y[4], y[5]); t.w = pk2(y[6], y[7]); return t; }

constexpr int A_WT = 90112, A_SC = 100352;
__device__ __forceinline__ void conv_load(const Par& P, int b, int s0, int chx, unsigned (&r)[11]) {
    const bf16* base = P.proj + ((size_t)b * SEQ) * P1W + P1_XBC + chx;
#pragma unroll
    for (int j = 0; j < 11; ++j) { const int s = s0 - 3 + j; r[j] = *(const unsigned*)(base + (size_t)(s < 0 ? 0 : s) * P1W); }
}
__device__ __forceinline__ void conv_math(const LAS float* wt, int lc, int s0, const unsigned (&r)[11], float (&y0)[8], float (&y1)[8]) {
    float x0[11], x1[11];
#pragma unroll
    for (int j = 0; j < 11; ++j) { x0[j] = bflo(r[j]); x1[j] = bfhi(r[j]); }
    if (s0 == 0) {
#pragma unroll
        for (int j = 0; j < 3; ++j) { x0[j] = 0.f; x1[j] = 0.f; } }
    f32x2 wj[4];
#pragma unroll
    for (int j = 0; j < 4; ++j) wj[j] = *(const LAS f32x2*)(wt + j * 512 + lc);
    const f32x2 bb = *(const LAS f32x2*)(wt + 4 * 512 + lc);
#pragma unroll
    for (int i = 0; i < 8; ++i) {
        const float a0 = bb.x + wj[0].x * x0[i] + wj[1].x * x0[i + 1] + wj[2].x * x0[i + 2] + wj[3].x * x0[i + 3];
        const float a1 = bb.y + wj[0].y * x1[i] + wj[1].y * x1[i + 1] + wj[2].y * x1[i + 2] + wj[3].y * x1[i + 3];
        y0[i] = silu_f(a0); y1[i] = silu_f(a1); }
}
__device__ __forceinline__ void phase_a(LAS unsigned char* lds, int wv, const Par& P, int vcu, int G) {
    const int tid = opaque_tid(wv), lane = tid & 63, w = wv;
    constexpr int NIT = BATCH * NCHUNK * SSD_G;
    unsigned rB[2][11], rX[6][11], dr0 = 0, dr1 = 0;
#define A_DEC(it_) const int g = (it_) & 3, c = ((it_) >> 2) & 15, b = (it_) >> 6
#define A_LD_DT(it_) { A_DEC(it_); if (w < 6) { const size_t row0 = (size_t)b * SEQ + c * SSD_CH + 2 * lane; dr0 = P.proj[row0 * P1W + P1_DT + g * 6 + w]; dr1 = P.proj[(row0 + 1) * P1W + P1_DT + g * 6 + w]; } }
#define A_LD_B(it_) { A_DEC(it_); int t_ = tid; asm volatile("" : "+v"(t_)); _Pragma("unroll") for (int j = 0; j < 2; ++j) { const int i2 = t_ + NTHR * j, cp = i2 & 63, tg = i2 >> 6; conv_load(P, b, c * SSD_CH + 8 * tg, SSD_IN + g * SSD_N + 2 * cp, rB[j]); } }
#define A_LD_X(it_, hg) { A_DEC(it_); int t_ = tid; asm volatile("" : "+v"(t_)); _Pragma("unroll") for (int j = 0; j < 3; ++j) { const int i2 = t_ + NTHR * j, cp = i2 % 96, tg = i2 / 96; conv_load(P, b, c * SSD_CH + 8 * tg, (g * 6 + 3 * (hg) + (cp >> 5)) * SSD_P + 2 * (cp & 31), rX[3 * (hg) + j]); } }
    int it = vcu, gtab = -1;
    if (it < NIT) { A_LD_DT(it) A_LD_B(it) A_LD_X(it, 0) A_LD_X(it, 1) }
    const LAS float* wt = (const LAS float*)(lds + A_WT); const LAS float* sct = (const LAS float*)(lds + A_SC);
#pragma unroll 1
    for (; it < NIT; it += G) {
        A_DEC(it); const int itc = (it + G < NIT) ? it + G : it;
        if (g != gtab) { gtab = g;
            const int ch = tid < 128 ? SSD_IN + g * SSD_N + tid : g * 6 * SSD_P + (tid - 128);
#pragma unroll
            for (int j = 0; j < 4; ++j) ((LAS float*)(lds + A_WT))[j * 512 + tid] = P.conv_w[j * CONV_DIM + ch];
            ((LAS float*)(lds + A_WT))[4 * 512 + tid] = P.conv_b[ch];
            __syncthreads(); }
        if (w < 6) {
            const int hd = g * 6 + w; const float bias = P.dt_bias[hd], A = -expf(P.a_log[hd]);
            const float x0 = bf2f((unsigned short)dr0) + bias, x1 = bf2f((unsigned short)dr1) + bias;
            const float d0 = x0 > 20.f ? x0 : log1pf(expf(x0)), d1 = x1 > 20.f ? x1 : log1pf(expf(x1));
            const float la0 = d0 * A, la1 = d1 * A; const float s1 = la0 + la1; float v = s1;
#pragma unroll
            for (int off = 1; off < 64; off <<= 1) { const float t = __shfl_up(v, off); if (lane >= off) v += t; }
            const float cend = __shfl(v, 63);
            LAS float* sc = (LAS float*)(lds + A_SC) + w * 128;
            sc[2 * lane] = d0 * expf(cend - (v - s1 + la0)); sc[2 * lane + 1] = d1 * expf(cend - v);
            if (lane == 63) P.cdec[((size_t)b * NCHUNK + c) * SSD_H + hd] = expf(v);
        }
        int tb = tid; asm volatile("" : "+v"(tb));
#pragma unroll
        for (int j = 0; j < 2; ++j) { const int i2 = tb + NTHR * j, cp = i2 & 63, tg = i2 >> 6; float y0[8], y1[8];
            conv_math(wt, 2 * cp, c * SSD_CH + 8 * tg, rB[j], y0, y1);
            *(LAS u32x4*)(lds + A_BMT + sw_off(2 * cp, tg)) = pack8f(y0); *(LAS u32x4*)(lds + A_BMT + sw_off(2 * cp + 1, tg)) = pack8f(y1); }
        { A_LD_DT(itc) A_LD_B(itc) }
        __syncthreads();
#pragma unroll
        for (int hg = 0; hg < 2; ++hg) {
            int tx = tid; asm volatile("" : "+v"(tx));
#pragma unroll
            for (int j = 0; j < 3; ++j) { const int i2 = tx + NTHR * j, cp = i2 % 96, tg = i2 / 96; const int e3 = cp >> 5, e = 3 * hg + e3, pp = 2 * (cp & 31); float y0[8], y1[8];
                conv_math(wt, 128 + e * SSD_P + pp, c * SSD_CH + 8 * tg, rX[3 * hg + j], y0, y1);
                const f32x4 sa = *(const LAS f32x4*)(sct + e * 128 + 8 * tg), sb = *(const LAS f32x4*)(sct + e * 128 + 8 * tg + 4);
#pragma unroll
                for (int i = 0; i < 4; ++i) { y0[i] *= sa[i]; y1[i] *= sa[i]; y0[4 + i] *= sb[i]; y1[4 + i] *= sb[i]; }
                *(LAS u32x4*)(lds + A_XT + e3 * 16384 + sw_off(pp, tg)) = pack8f(y0); *(LAS u32x4*)(lds + A_XT + e3 * 16384 + sw_off(pp + 1, tg)) = pack8f(y1); }
            { if (hg == 0) A_LD_X(itc, 0) else A_LD_X(itc, 1) }
            __syncthreads();
            const int nt = w & 3, pt = w >> 2;
            int clm = tid & 31; asm volatile("" : "+v"(clm));
            const int cl = clm, hi = (tid >> 5) & 1;
            const int xo = (cl & 3) | (((cl >> 3) & 3) << 2);
#pragma unroll
            for (int e3 = 0; e3 < 3; ++e3) {
                f32x16 acc;
#pragma unroll
                for (int r = 0; r < 16; ++r) acc[r] = 0.f;
                const LAS unsigned char* ab = lds + A_BMT + (32 * nt + cl) * 256; const LAS unsigned char* bb = lds + A_XT + e3 * 16384 + (32 * pt + cl) * 256;
#pragma unroll
                for (int ks = 0; ks < 8; ++ks) { const int co = ((2 * ks + hi) ^ xo) << 4;
                    acc = MFMA32(*(const LAS bf16x8*)(ab + co), *(const LAS bf16x8*)(bb + co), acc); }
                const int hd = g * 6 + 3 * hg + e3;
                bf16* dst = P.states + ((((size_t)b * NCHUNK + c) * SSD_H + hd) * SSD_P + 32 * pt + cl) * SSD_N + 32 * nt + 4 * hi;
#pragma unroll
                for (int a = 0; a < 4; ++a) { u32x2 t; t.x = pk2(acc[4 * a], acc[4 * a + 1]); t.y = pk2(acc[4 * a + 2], acc[4 * a + 3]); *(u32x2*)(dst + 8 * a) = t; }
            }
            __syncthreads();
        }
    }
#undef A_DEC
#undef A_LD_DT
#undef A_LD_B
#undef A_LD_X
}
__device__ __forceinline__ void phase_b(const Par& P, int gtid, int gthreads, bool dry = false) {
    for (int it = gtid; it < BATCH * SSD_H * SSD_P * 16; it += gthreads) {
        const int nq = it & 15, p = (it >> 4) & 63, bh = it >> 10, h = bh % SSD_H, b = bh / SSD_H;
        u32x4 v[NCHUNK];
#pragma unroll
        for (int c = 0; c < NCHUNK; ++c) v[c] = *(const u32x4*)(P.states + ((((size_t)b * NCHUNK + c) * SSD_H + h) * SSD_P + p) * SSD_N + 8 * nq);
        float hr[8];
#pragma unroll
        for (int i = 0; i < 8; ++i) hr[i] = 0.f;
#pragma unroll
        for (int c = 0; c < NCHUNK; ++c) {
            const float dec = P.cdec[((size_t)b * NCHUNK + c) * SSD_H + h];
            u32x4 o; o.x = pk2(hr[0], hr[1]); o.y = pk2(hr[2], hr[3]); o.z = pk2(hr[4], hr[5]); o.w = pk2(hr[6], hr[7]);
            if (!dry) *(u32x4*)(P.states + ((((size_t)b * NCHUNK + c) * SSD_H + h) * SSD_P + p) * SSD_N + 8 * nq) = o;
            hr[0] = dec * hr[0] + bflo(v[c].x); hr[1] = dec * hr[1] + bfhi(v[c].x); hr[2] = dec * hr[2] + bflo(v[c].y); hr[3] = dec * hr[3] + bfhi(v[c].y);
            hr[4] = dec * hr[4] + bflo(v[c].z); hr[5] = dec * hr[5] + bfhi(v[c].z); hr[6] = dec * hr[6] + bflo(v[c].w); hr[7] = dec * hr[7] + bfhi(v[c].w);
        }
    }
}
constexpr int C_WT = 141312;
template <int WS>
__device__ __forceinline__ void conv_math_t(const LAS float* wt, int lc, int s0, const unsigned (&r)[11], float (&y0)[8], float (&y1)[8]) {
    float x0[11], x1[11];
#pragma unroll
    for (int j = 0; j < 11; ++j) { x0[j] = bflo(r[j]); x1[j] = bfhi(r[j]); }
    if (s0 == 0) {
#pragma unroll
        for (int j = 0; j < 3; ++j) { x0[j] = 0.f; x1[j] = 0.f; } }
    f32x2 wj[4];
#pragma unroll
    for (int j = 0; j < 4; ++j) wj[j] = *(const LAS f32x2*)(wt + j * WS + lc);
    const f32x2 bb = *(const LAS f32x2*)(wt + 4 * WS + lc);
#pragma unroll
    for (int i = 0; i < 8; ++i) {
        const float a0 = bb.x + wj[0].x * x0[i] + wj[1].x * x0[i + 1] + wj[2].x * x0[i + 2] + wj[3].x * x0[i + 3];
        const float a1 = bb.y + wj[0].y * x1[i] + wj[1].y * x1[i + 1] + wj[2].y * x1[i + 2] + wj[3].y * x1[i + 3];
        y0[i] = silu_f(a0); y1[i] = silu_f(a1); }
}
__device__ __forceinline__ void phase_c(LAS unsigned char* lds, int wv, const Par& P, bf16* projw, int vcu, int NG) {
    const int tid = opaque_tid(wv), w = wv;
    constexpr int NIT = BATCH * NCHUNK * SSD_G;
    unsigned rBC[4][11], rX[2][11], dr0 = 0, dr1 = 0;
#define C_DEC(it_) const int g = (it_) & 3, c = ((it_) >> 2) & 15, b = (it_) >> 6
#define C_LD_DT(it_) { C_DEC(it_); if (w < 6) { const int l_ = tid & 63; const size_t row0 = (size_t)b * SEQ + c * SSD_CH + 2 * l_; dr0 = P.proj[row0 * P1W + P1_DT + g * 6 + w]; dr1 = P.proj[(row0 + 1) * P1W + P1_DT + g * 6 + w]; } }
#define C_LD_BC(it_) { C_DEC(it_); int t_ = tid; asm volatile("" : "+v"(t_)); _Pragma("unroll") for (int j = 0; j < 4; ++j) { const int i2 = t_ + NTHR * j, cp = i2 & 127, tg = i2 >> 7; \
        conv_load(P, b, c * SSD_CH + 8 * tg, SSD_IN + (cp >> 6) * (SSD_G * SSD_N) + g * SSD_N + 2 * (cp & 63), rBC[j]); } }
#define C_LD_X(it_, ei_) { C_DEC(it_); int t_ = tid; asm volatile("" : "+v"(t_)); _Pragma("unroll") for (int j = 0; j < 2; ++j) { const int i2 = t_ + NTHR * j, cp = i2 & 63, tg = i2 >> 6; \
        conv_load(P, b, c * SSD_CH + 8 * tg, (g * 6 + 3 * (cp >> 5) + (ei_)) * SSD_P + 2 * (cp & 31), rX[j]); } }
    int it = vcu, gtab = -1;
    if (it < NIT) { C_LD_DT(it) C_LD_BC(it) C_LD_X(it, 0) }
    const LAS float* wt = (const LAS float*)(lds + C_WT);
#pragma unroll 1
    for (; it < NIT; it += NG) {
        C_DEC(it); const int itc = (it + NG < NIT) ? it + NG : it;
        if (g != gtab) { gtab = g;
#pragma unroll
            for (int q = 0; q < 2; ++q) { const int idx = tid + NTHR * q;
                if (idx < 640) { const int ch = idx < 128 ? SSD_IN + g * SSD_N + idx : idx < 256 ? SSD_IN + SSD_G * SSD_N + g * SSD_N + (idx - 128) : g * 6 * SSD_P + (idx - 256);
#pragma unroll
                    for (int j = 0; j < 4; ++j) ((LAS float*)(lds + C_WT))[j * 640 + idx] = P.conv_w[j * CONV_DIM + ch];
                    ((LAS float*)(lds + C_WT))[4 * 640 + idx] = P.conv_b[ch]; } }
            __syncthreads(); }
        if (w < 6) {
            const int lane = tid & 63, hd = g * 6 + w; const float bias = P.dt_bias[hd], A = -expf(P.a_log[hd]);
            const float x0 = bf2f((unsigned short)dr0) + bias, x1 = bf2f((unsigned short)dr1) + bias;
            const float d0 = x0 > 20.f ? x0 : log1pf(expf(x0)), d1 = x1 > 20.f ? x1 : log1pf(expf(x1));
            const float la0 = d0 * A, la1 = d1 * A; const float s1 = la0 + la1; float v = s1;
#pragma unroll
            for (int off = 1; off < 64; off <<= 1) { const float t = __shfl_up(v, off); if (lane >= off) v += t; }
            LAS float* dt = (LAS float*)(lds + DT_OFF) + w * 128; LAS float* cs = (LAS float*)(lds + CS_OFF) + w * 128;
            dt[2 * lane] = d0; dt[2 * lane + 1] = d1; cs[2 * lane] = v - s1 + la0; cs[2 * lane + 1] = v;
        }
        { int tb = tid; asm volatile("" : "+v"(tb));
#pragma unroll
          for (int j = 0; j < 4; ++j) { const int i2 = tb + NTHR * j, cp = i2 & 127, tg = i2 >> 7; float y0[8], y1[8];
            conv_math_t<640>(wt, 2 * cp, c * SSD_CH + 8 * tg, rBC[j], y0, y1);
            const int img = (cp >> 6) ? C_CM : C_BM, n2 = cp & 63;
#pragma unroll
            for (int i = 0; i < 8; ++i) *(LAS unsigned*)(lds + img + sw_off(8 * tg + i, n2 >> 2) + (n2 & 3) * 4) = pk2(y0[i], y1[i]); } }
        int lv = tid & 63; asm volatile("" : "+v"(lv));
        const int lane = lv, cl = lane & 31, hi = lane >> 5;
        __syncthreads();
    const LAS float* dtl = (const LAS float*)(lds + DT_OFF); const LAS float* csl = (const LAS float*)(lds + CS_OFF);
    const int lt = (w < 4) ? w : 7 - w, hh = w >> 2, l = 32 * lt + cl;
    const int xo = (cl & 3) | (((cl >> 3) & 3) << 2);
    const int pi = (cl & ~0xC) | ((cl & 4) << 1) | ((cl & 8) >> 1), xpi = (pi & 3) | (((pi >> 3) & 3) << 2);
    const LAS unsigned char* cmb = lds + C_CM + l * 256;
#define CF(ks) (*(const LAS bf16x8*)(cmb + (((2 * (ks) + hi) ^ xo) << 4)))
    f32x16 G[4];
#pragma unroll
    for (int st = 0; st < 4; ++st) {
#pragma unroll
        for (int r = 0; r < 16; ++r) G[st][r] = 0.f;
        if (st <= lt) { const LAS unsigned char* ab = lds + C_BM + (32 * st + pi) * 256;
#pragma unroll
            for (int ks = 0; ks < 8; ++ks) G[st] = MFMA32(*(const LAS bf16x8*)(ab + (((2 * ks + hi) ^ xpi) << 4)), CF(ks), G[st]); }
        __builtin_amdgcn_sched_barrier(0);
    }
        float sq = 0.f;
#pragma unroll 1
        for (int ei = 0; ei < 3; ++ei) {
            const int e = 3 * hh + ei, hd = g * 6 + e;
            const float csl_l = csl[e * 128 + l], dsk = P.d_skip[hd] / dtl[e * 128 + l];
            u32x4 zq[4];
            { const bf16* zr = projw + ((size_t)b * SEQ + c * SSD_CH + 32 * lt) * P1W + hd * SSD_P;
#pragma unroll
              for (int i = 0; i < 4; ++i) zq[i] = *(const u32x4*)(zr + (size_t)(8 * i + (lane >> 3)) * P1W + 8 * (lane & 7)); }
            __syncthreads();
            if (c > 0) {
                int tq = tid; asm volatile("" : "+v"(tq));
                const int ln = tq & 63, cs = ln & 15;
#pragma unroll
                for (int q = 0; q < 4; ++q) { const int hb = q >> 1, pc = w + 8 * (q & 1), r = 4 * pc + (ln >> 4);
                    const bf16* sp = P.states + ((((size_t)b * NCHUNK + c) * SSD_H + g * 6 + 3 * hb + ei) * SSD_P + r) * SSD_N + ((cs ^ ((r & 3) | (((r >> 3) & 3) << 2))) << 3);
                    __builtin_amdgcn_global_load_lds((const unsigned*)sp, (LAS unsigned*)(lds + C_BM + hb * 16384 + pc * 1024), 16, 0, 0); }
            }
            { int tx = tid; asm volatile("" : "+v"(tx));
#pragma unroll
              for (int j = 0; j < 2; ++j) { const int i2 = tx + NTHR * j, cp = i2 & 63, tg = i2 >> 6; const int hb = cp >> 5, e2 = 3 * hb + ei, pp = 2 * (cp & 31); float y0[8], y1[8];
                conv_math_t<640>(wt, 256 + e2 * SSD_P + pp, c * SSD_CH + 8 * tg, rX[j], y0, y1);
                const f32x4 sa = *(const LAS f32x4*)(dtl + e2 * 128 + 8 * tg), sb = *(const LAS f32x4*)(dtl + e2 * 128 + 8 * tg + 4);
#pragma unroll
                for (int i = 0; i < 4; ++i) { y0[i] *= sa[i]; y1[i] *= sa[i]; y0[4 + i] *= sb[i]; y1[4 + i] *= sb[i]; }
                *(LAS u32x4*)(lds + C_XT + hb * 16384 + sw_off(pp, tg)) = pack8f(y0); *(LAS u32x4*)(lds + C_XT + hb * 16384 + sw_off(pp + 1, tg)) = pack8f(y1); } }
            VM_WAIT();
            { const int itx = ei < 2 ? it : itc, eix = ei < 2 ? ei + 1 : 0; C_LD_X(itx, eix) }
            __syncthreads();
            f32x16 Y0, Y1;
#pragma unroll
            for (int r = 0; r < 16; ++r) { Y0[r] = 0.f; Y1[r] = 0.f; }
            if (c > 0) {
                const LAS unsigned char* sb0 = lds + C_BM + hh * 16384 + cl * 256; const LAS unsigned char* sb1 = sb0 + 32 * 256;
#pragma unroll
                for (int ks = 0; ks < 8; ++ks) { const bf16x8 cfk = CF(ks); const int co = ((2 * ks + hi) ^ xo) << 4;
                    Y0 = MFMA32(*(const LAS bf16x8*)(sb0 + co), cfk, Y0); Y1 = MFMA32(*(const LAS bf16x8*)(sb1 + co), cfk, Y1); }
                const float el = fast_exp2(csl_l * LOG2E);
                Y0 *= el; Y1 *= el;
            }
            int clv = cl; asm volatile("" : "+v"(clv));
            const LAS unsigned char* xb0 = lds + C_XT + hh * 16384 + cl * 256; const LAS unsigned char* xb1 = xb0 + 32 * 256;
#pragma unroll
            for (int st = 0; st < 4; ++st) {
                if (st <= lt) {
                    float mv[16];
                    const LAS float* cp8 = csl + e * 128 + 32 * st + 8 * hi;
                    const f32x4 c0 = *(const LAS f32x4*)cp8, c1 = *(const LAS f32x4*)(cp8 + 4), c2 = *(const LAS f32x4*)(cp8 + 16), c3 = *(const LAS f32x4*)(cp8 + 20);
#pragma unroll
                    for (int r = 0; r < 16; ++r) {
                        const float cs_s = (r < 4) ? c0[r & 3] : (r < 8) ? c1[r & 3] : (r < 12) ? c2[r & 3] : c3[r & 3];
                        mv[r] = G[st][r] * fast_exp2((csl_l - cs_s) * LOG2E); }
                    if (st == lt) {
#pragma unroll
                        for (int r = 0; r < 16; ++r) { const int sl = (r & 7) + 8 * hi + 16 * (r >> 3);
                            float v = mv[r]; v = (sl <= clv) ? v : 0.f; v = (sl == clv) ? v + dsk : v; mv[r] = v; }
                    }
                    u32x4 t; bf16x8 m0, m1;
                    t.x = pk2(mv[0], mv[1]); t.y = pk2(mv[2], mv[3]); t.z = pk2(mv[4], mv[5]); t.w = pk2(mv[6], mv[7]); m0 = __builtin_bit_cast(bf16x8, t);
                    t.x = pk2(mv[8], mv[9]); t.y = pk2(mv[10], mv[11]); t.z = pk2(mv[12], mv[13]); t.w = pk2(mv[14], mv[15]); m1 = __builtin_bit_cast(bf16x8, t);
                    const int co0 = ((4 * st + hi) ^ xo) << 4, co1 = ((4 * st + 2 + hi) ^ xo) << 4;
                    Y0 = MFMA32(*(const LAS bf16x8*)(xb0 + co0), m0, Y0); Y0 = MFMA32(*(const LAS bf16x8*)(xb0 + co1), m1, Y0);
                    Y1 = MFMA32(*(const LAS bf16x8*)(xb1 + co0), m0, Y1); Y1 = MFMA32(*(const LAS bf16x8*)(xb1 + co1), m1, Y1);
                }
            }
            { LAS unsigned char* zt = lds + zt_base(w);
              bf16* zrow = projw + ((size_t)b * SEQ + c * SSD_CH + 32 * lt) * P1W + hd * SSD_P;
              const int rr = lane >> 3, pc = lane & 7;
#pragma unroll
              for (int i = 0; i < 4; ++i) *(LAS u32x4*)(zt + zt_off(8 * i + rr, pc)) = zq[i];
              LDS_WAIT(); asm volatile("" ::: "memory");
              u32x2 zz0[4], zz1[4];
#pragma unroll
              for (int a = 0; a < 4; ++a) { zz0[a] = *(const LAS u32x2*)(zt + zt_off(cl, a) + 8 * hi); zz1[a] = *(const LAS u32x2*)(zt + zt_off(cl, 4 + a) + 8 * hi); }
              LDS_WAIT(); asm volatile("" ::: "memory");
#pragma unroll
              for (int a = 0; a < 4; ++a) {
                { const u32x2 zz = zz0[a];
                  const float u0 = Y0[4 * a] * silu_f(bflo(zz.x)), u1 = Y0[4 * a + 1] * silu_f(bfhi(zz.x)), u2 = Y0[4 * a + 2] * silu_f(bflo(zz.y)), u3 = Y0[4 * a + 3] * silu_f(bfhi(zz.y));
                  sq += (u0 * u0 + u1 * u1) + (u2 * u2 + u3 * u3); u32x2 t; t.x = pk2(u0, u1); t.y = pk2(u2, u3); *(LAS u32x2*)(zt + zt_off(cl, a) + 8 * hi) = t; }
                { const u32x2 zz = zz1[a];
                  const float u0 = Y1[4 * a] * silu_f(bflo(zz.x)), u1 = Y1[4 * a + 1] * silu_f(bfhi(zz.x)), u2 = Y1[4 * a + 2] * silu_f(bflo(zz.y)), u3 = Y1[4 * a + 3] * silu_f(bfhi(zz.y));
                  sq += (u0 * u0 + u1 * u1) + (u2 * u2 + u3 * u3); u32x2 t; t.x = pk2(u0, u1); t.y = pk2(u2, u3); *(LAS u32x2*)(zt + zt_off(cl, 4 + a) + 8 * hi) = t; }
              }
              LDS_WAIT(); asm volatile("" ::: "memory");
#pragma unroll
              for (int i = 0; i < 4; ++i) { const u32x4 uq = *(const LAS u32x4*)(zt + zt_off(8 * i + rr, pc)); *(u32x4*)(zrow + (size_t)(8 * i + rr) * P1W + 8 * pc) = uq; }
              LDS_WAIT(); asm volatile("" ::: "memory");
            }
    }
LAS float* ssp = (LAS float*)(lds + SSP_OFF);
    ssp[l * 4 + hh * 2 + hi] = sq;
        { C_LD_DT(itc) C_LD_BC(itc) }
    __syncthreads();
    { const int rr = lane >> 3, pc = lane & 7;
#pragma unroll
      for (int ei = 0; ei < 3; ++ei) { const int hd = g * 6 + 3 * hh + ei;
            bf16* zrow = projw + ((size_t)b * SEQ + c * SSD_CH + 32 * lt) * P1W + hd * SSD_P;
            const f32x4 g0 = *(const f32x4*)(P.g_out + hd * SSD_P + 8 * pc), g1 = *(const f32x4*)(P.g_out + hd * SSD_P + 8 * pc + 4);
#pragma unroll
            for (int i = 0; i < 4; ++i) { const int lr = 32 * lt + 8 * i + rr;
                const f32x4 s4 = *(const LAS f32x4*)(ssp + lr * 4); const float rs = 1.0f / sqrtf(((s4.x + s4.y) + (s4.z + s4.w)) * (1.0f / 384.0f) + EPS);
                u32x4* up = (u32x4*)(zrow + (size_t)(8 * i + rr) * P1W + 8 * pc);
                const u32x4 uv = *up;
                u32x4 t; t.x = pk2(bflo(uv.x) * rs * g0[0], bfhi(uv.x) * rs * g0[1]); t.y = pk2(bflo(uv.y) * rs * g0[2], bfhi(uv.y) * rs * g0[3]);
                t.z = pk2(bflo(uv.z) * rs * g1[0], bfhi(uv.z) * rs * g1[1]); t.w = pk2(bflo(uv.w) * rs * g1[2], bfhi(uv.w) * rs * g1[3]);
                *up = t; } } }
    __syncthreads();
    }
#undef CF
#undef C_DEC
#undef C_LD_DT
#undef C_LD_BC
#undef C_LD_X
}
}

constexpr size_t WS_MEMRS = 4 * MiB + 256 * 1024;
constexpr size_t WS_RS0 = 4 * MiB + 512 * 1024;
constexpr int N_PHASES = 15;

struct MoeOrder {
    pg8::StaticOrder so; const LAS int* pan; int npn;
    __device__ __forceinline__ bool next(int i, Unit& u) const { if (!so.next(i, u)) return false; u.pn = ((pan[u.pm] >> 16) & 7) * npn + u.pn; return true; }
};
struct MoeOrderSplit {
    pg8::StaticOrder so; const LAS int* pan; int npn;
    __device__ __forceinline__ int nfull() const { return (so.nwg / so.G) * so.G; }
    __device__ __forceinline__ int nsl() const { const int t = so.nwg - nfull(); return (t * 7 <= so.G) ? 7 : ((t * 2 <= so.G) ? 2 : 1); }
    __device__ __forceinline__ int ntail() const { const int t = so.nwg - nfull(); return nsl() > 1 ? t : 0; }
    __device__ __forceinline__ bool next(int i, Unit& u) const {
        const int L = i * so.G + so.c, nf = nfull(), nt = ntail(), ns = nsl();
        if (nt == 0 || L < nf) { if (L >= so.nwg) return false; so.decode(L, u); u.kt0 = 0; u.nkt = MOE_NKT; u.ti = -1; }
        else { const int s = L - nf; if (s >= nt * ns) return false; so.decode(nf + s / ns, u); u.kt0 = (s % ns) * (MOE_NKT / ns); u.nkt = MOE_NKT / ns; u.ti = s / ns; }
        u.ui = i; u.pn = ((pan[u.pm] >> 16) & 7) * npn + u.pn; return true;
    }
};

__device__ __forceinline__ void row_to_bf16(const float* xrow, bf16* orow, float* ss16, float* rs1, int lane) {
    const GAS f32x4* xr = (const GAS f32x4*)xrow + lane;
    f32x4 v[4]; float s = 0.f;
#pragma unroll
    for (int j = 0; j < 4; ++j) { v[j] = xr[64 * j]; s += (v[j].x * v[j].x + v[j].y * v[j].y) + (v[j].z * v[j].z + v[j].w * v[j].w); }
    s = wave_sum(s);
    GAS unsigned long long* o8 = (GAS unsigned long long*)orow + lane;
#pragma unroll
    for (int j = 0; j < 4; ++j) o8[64 * j] = (unsigned long long)pk2(v[j].x, v[j].y) | ((unsigned long long)pk2(v[j].z, v[j].w) << 32);
    if (lane < 16) ss16[lane] = (lane == 0) ? s : 0.f;
    if (lane == 0) *rs1 = 1.0f / sqrtf(s * (1.0f / 1024.0f) + EPS);
}

__global__ void __launch_bounds__(NTHR, 2) fwd_kernel(Args args_unused) {
#define args (*kargs())
    extern __shared__ __attribute__((aligned(16))) unsigned char lds_raw[];
    LAS unsigned char* lds = (LAS unsigned char*)lds_raw;
    const int wave = __builtin_amdgcn_readfirstlane((int)threadIdx.x >> 6);
#define tid (opaque_tid(wave))
#define lane (opaque_tid(wave) & 63)
    const int G = gridDim.x, bx = blockIdx.x;
    const int vcu = (G % 8 == 0) ? (bx % 8) * (G / 8) + bx / 8 : bx;
    unsigned char* ws = args.ws;
    gu32* ctl = (gu32*)(ws + WS_CTL);
    for (int u = tid; u < 256; u += NTHR) ((LAS unsigned*)(lds + MISC_OFF))[u] = 0u;
    __syncthreads();
    XcdBarrier bar = xcd_barrier_post((unsigned*)(ctl + CW_BAR), (volatile LAS unsigned*)(lds + MISC_OFF) + 8);
    const int lo = args.ph_lo, hi = args.ph_hi;
#ifndef ONLY_PHASE
#define ONLY_PHASE -1
#endif
#define IN(k) ((ONLY_PHASE < 0 || (k) == ONLY_PHASE) && lo <= (k) && (k) < hi)
#define SEAM(k) do { if (IN(k) && IN((k) + 1)) xcd_barrier(bar); } while (0)

    const float* x_in = args.in[0]; float* out = args.out;
    bf16* XB = (bf16*)(ws + WS_XB); float* SS = (float*)(ws + WS_SS); bf16* PROJ = (bf16*)(ws + WS_PROJ);
    float* KMEAN = (float*)(ws + WS_KMEAN);
    const LAS unsigned short* rowtab = (const LAS unsigned short*)(lds + ROWTAB_OFF);
    LAS int* pan = (LAS int*)(lds + PAN_OFF);

    constexpr int NDN_ALL = NEXP * (FF / 64) * (1024 / 32);
    const int wed_pre1 = (G == 256) ? 9216 : 0, wed_pre = (G == 256) ? NDN_ALL : 0;
#define CVT_WED_RANGE(lo_, hi_) { LAS float* scr = (LAS float*)(lds + wave * 16384); const int per_ = ((hi_) - (lo_) + NWAVES - 1) / NWAVES; \
        const int b0_ = (lo_) + wave * per_; const int cvt_end = (b0_ + per_ < (hi_)) ? b0_ + per_ : (hi_); \
        for (int it = b0_; it < cvt_end;) { const int e = it / ((FF / 64) * (1024 / 32)); int r = it % ((FF / 64) * (1024 / 32)); CVT_DECL() \
            CVT_JOB8(args.in[23] + (size_t)e * FF * 1024, nullptr, nullptr, ws + WS_WED + (size_t)e * 1024 * FF, 1024, FF, 1024, 0, 0, 1024, F8_SW2) \
            CVT_RUN(it, cvt_end); } \
        __syncthreads(); }
    if (IN(0)) {
        LAS float* scr = (LAS float*)(lds + wave * 16384);
        const int gw = vcu * NWAVES + wave, NGW = G * NWAVES;
        const float *g_mix = args.in[2], *g_mem = args.in[3], *w_moba = args.in[4], *w_ssd = args.in[5], *w_kv = args.in[6], *w_out = args.in[7], *g_ffn = args.in[15];
        constexpr int NIT = (1024 / 64) * ((3584 + 1536 + 4864 + 1024 + 1024 + 7168) / 32) + (2048 / 64) * (2048 / 32) + (3584 / 64) * (1024 / 32);
        const int cvt_c = (NIT + NGW - 1) / NGW, cvt_end = (gw + 1) * cvt_c < NIT ? (gw + 1) * cvt_c : NIT;
        for (int it = gw * cvt_c; it < cvt_end;) {
            int r = it; CVT_DECL()
            CVT_JOB(w_moba, nullptr, g_mix, (bf16*)(ws + WS_WM1), IN_MOBA, 1024, 1536, 0, 0, 1536)
            CVT_JOB(w_moba, nullptr, g_mix, (bf16*)(ws + WS_WM1) + (size_t)1536 * 1024, IN_MOBA, 1024, 512, 4608, 0, 512)
            CVT_JOB(w_moba, nullptr, g_mix, (bf16*)(ws + WS_WM1) + (size_t)2048 * 1024, IN_MOBA, 1024, 1536, 1536, 0, 1536)
            CVT_JOB(w_moba, nullptr, g_mix, (bf16*)(ws + WS_WV), IN_MOBA, 1024, 1536, 3072, 0, 1536)
            CVT_JOB(w_ssd, nullptr, g_mix + D, (bf16*)(ws + WS_WS), IN_SSD, 1024, 1536, 0, 0, 1536)
            CVT_JOB(w_ssd, nullptr, g_mix + D, (bf16*)(ws + WS_WS) + (size_t)1536 * 1024, IN_SSD, 1024, 512, 4120, 0, 512)
            CVT_JOB(w_ssd, nullptr, g_mix + D, (bf16*)(ws + WS_WS) + (size_t)2048 * 1024, IN_SSD, 1024, 2560, 1536, 0, 2560)
            CVT_JOB(w_ssd, nullptr, g_mix + D, (bf16*)(ws + WS_WS) + (size_t)4608 * 1024, IN_SSD, 1024, 256, 4096, 0, 24)
            CVT_JOB(w_kv, nullptr, g_mem, (bf16*)(ws + WS_WMK), 1024, 1024, 512, 0, 0, 512)
            CVT_JOB(w_kv + (size_t)1024 * 1024, nullptr, g_mem + D, (bf16*)(ws + WS_WMK) + (size_t)512 * 1024, 1024, 1024, 512, 0, 0, 512)
            CVT_JOB(w_kv, nullptr, g_mem, (bf16*)(ws + WS_WMV), 1024, 1024, 512, 512, 0, 512)
            CVT_JOB(w_kv + (size_t)1024 * 1024, nullptr, g_mem + D, (bf16*)(ws + WS_WMV) + (size_t)512 * 1024, 1024, 1024, 512, 512, 0, 512)
            CVT_JOB(args.in[16], args.in[17], g_ffn, (bf16*)(ws + WS_WGU), FF, 1024, 7168, 0, 1, 7168)
            CVT_JOB(w_out, nullptr, nullptr, (bf16*)(ws + WS_WO), 1024, 2048, 1024, 0, 0, 1024)
            CVT_JOB(w_out + (size_t)2048 * 1024, nullptr, nullptr, (bf16*)(ws + WS_WO) + (size_t)1024 * 2048, 1024, 2048, 1024, 0, 0, 1024)
            CVT_JOB(args.in[18], nullptr, nullptr, (bf16*)(ws + WS_WD), 1024, FF, 1024, 0, 0, 1024)
            CVT_RUN(it, cvt_end);
        }
        for (int m = gw; m < T; m += NGW) row_to_bf16(x_in + (size_t)m * D, XB + (size_t)m * D, SS + (size_t)m * 16, (float*)(ws + WS_RS0) + m, lane);
        for (int m = gw; m < MROWS; m += NGW) row_to_bf16(args.in[1] + (size_t)m * D, (bf16*)(ws + WS_MEMB) + (size_t)m * D, (float*)(ws + WS_MEMSS) + (size_t)m * 16, (float*)(ws + WS_MEMRS) + m, lane);
        __syncthreads();
    }
    SEAM(0);
    if (IN(1)) {
        { pg8::Gemm g{XB, (const bf16*)(ws + WS_WM1), D, D}; pg8::StaticOrder S; S.init(T / 256, P0W / 256, G, bx);
          EpiScale E{PROJ, P0W, SS, KMEAN, 2048};
          pg8::gemm_phase<EpiScale, pg8::StaticOrder, false>(lds, g, S, E, rowtab, wave); }
        { pg8::Gemm g{(const bf16*)(ws + WS_WV), XB, D, D}; pg8::StaticOrder S; S.init(MOBA_W / 256, T / 256, G, bx);
          EpiVT E{(bf16*)(ws + WS_VT), T, (const float*)(ws + WS_RS0)};
          pg8::gemm_phase<EpiVT, pg8::StaticOrder, false>(lds, g, S, E, rowtab, wave); }
        { pg8::Gemm g{(const bf16*)(ws + WS_MEMB), (const bf16*)(ws + WS_WMK), D, D}; pg8::StaticOrder S; S.init(MROWS / 256, 2, G, bx);
          EpiScale E{(bf16*)(ws + WS_KMEM), 1024, (const float*)(ws + WS_MEMSS), nullptr, 0};
          pg8::gemm_phase<EpiScale, pg8::StaticOrder, false>(lds, g, S, E, rowtab, wave); }
        { pg8::Gemm g{(const bf16*)(ws + WS_WMV), (const bf16*)(ws + WS_MEMB), D, D}; pg8::StaticOrder S; S.init(2, MROWS / 256, G, (bx + G - 32) % G);
          EpiVT E{(bf16*)(ws + WS_VMEMT), MROWS, (const float*)(ws + WS_MEMRS)};
          pg8::gemm_phase<EpiVT, pg8::StaticOrder, false>(lds, g, S, E, rowtab, wave); }
        if (wed_pre1 > 0 && bx >= 64) { const int lo = (bx - 64) * 48; CVT_WED_RANGE(lo, lo + 48) }
    }
    SEAM(1);
    if (IN(2)) { const bool dry = false;
        for (int it = vcu; it < BATCH * MOBA_H * 4; it += G) {
            const int bh = it >> 2, pr = it & 3, b = bh / MOBA_H, h = bh % MOBA_H;
#pragma unroll 1
            for (int half = 0; half < 2; ++half) { const int n = half ? pr : 7 - pr;
                att::attn_unit<true>(lds, wave, PROJ + ((size_t)b * SEQ + 256 * n) * P0W + h * HD, P0W, PROJ + ((size_t)b * SEQ) * P0W + 2048 + h * HD, P0W,
                                     (const bf16*)(ws + WS_VT) + (size_t)(h * HD) * T + (size_t)b * SEQ, T, 4 * (n + 1), n, KMEAN + (size_t)(b * NBLK) * MOBA_W + h * HD, args.in[8], h, dry); }
        }
        for (int it = vcu; it < BATCH * MEM_H * 8; it += G) {
            const int b = it >> 5, mh = (it >> 3) & 3, qt = it & 7;
            att::attn_unit<false>(lds, wave, PROJ + ((size_t)b * SEQ + 256 * qt) * P0W + 1536 + mh * HD, P0W, (const bf16*)(ws + WS_KMEM) + ((size_t)b * MEM_LEN) * 1024 + mh * HD, 1024,
                                  (const bf16*)(ws + WS_VMEMT) + (size_t)(mh * HD) * MROWS + b * MEM_LEN, MROWS, 4, 0, nullptr, nullptr, 0, dry);
        }
    }
    SEAM(2);
    if (IN(3)) {
        pg8::Gemm g{PROJ, (const bf16*)(ws + WS_WO), P0W, MIXW}; pg8::StaticOrder S; S.init(T / 256, 4, G, bx);
        EpiResid<false, true, false> E{nullptr, nullptr, XB, SS, nullptr};
        pg8::gemm_phase<EpiResid<false, true, false>, pg8::StaticOrder, false>(lds, g, S, E, rowtab, wave);
    }
    SEAM(3);
    if (IN(4)) {
        pg8::Gemm g{XB, (const bf16*)(ws + WS_WGU), D, D}; pg8::StaticOrder S; S.init(T / 256, 28, G, bx);
        EpiGateUp<false> E{(bf16*)(ws + WS_ACT), SS, rowtab};
        pg8::gemm_phase<EpiGateUp<false>, pg8::StaticOrder, false>(lds, g, S, E, rowtab, wave);
    }
    SEAM(4);
    if (IN(5)) {
        pg8::Gemm g{(const bf16*)(ws + WS_ACT), (const bf16*)(ws + WS_WD), FF, FF}; pg8::StaticOrder S; S.init(T / 256, 4, G, bx);
        EpiResid<false, true, false> E{nullptr, nullptr, XB, SS, nullptr};
        pg8::gemm_phase<EpiResid<false, true, false>, pg8::StaticOrder, false>(lds, g, S, E, rowtab, wave);
    }
    SEAM(5);
    if (IN(6)) {
        pg8::Gemm g{XB, (const bf16*)(ws + WS_WS), D, D}; pg8::StaticOrder S; S.init(T / 256, P1W / 256, G, bx);
        EpiScale E{PROJ, P1W, SS, nullptr, 0};
        pg8::gemm_phase<EpiScale, pg8::StaticOrder, false>(lds, g, S, E, rowtab, wave);
        { pg8::Gemm g2{(const bf16*)(ws + WS_MEMB), (const bf16*)(ws + WS_WMK) + (size_t)512 * 1024, D, D}; pg8::StaticOrder S2; S2.init(MROWS / 256, 2, G, (bx + G - 128) % G);
          EpiScale E2{(bf16*)(ws + WS_KMEM) + 512, 1024, (const float*)(ws + WS_MEMSS), nullptr, 0};
          pg8::gemm_phase<EpiScale, pg8::StaticOrder, false>(lds, g2, S2, E2, rowtab, wave); }
        { pg8::Gemm g2{(const bf16*)(ws + WS_WMV) + (size_t)512 * 1024, (const bf16*)(ws + WS_MEMB), D, D}; pg8::StaticOrder S2; S2.init(2, MROWS / 256, G, (bx + G - 160) % G);
          EpiVT E2{(bf16*)(ws + WS_VMEMT) + (size_t)512 * MROWS, MROWS, (const float*)(ws + WS_MEMRS)};
          pg8::gemm_phase<EpiVT, pg8::StaticOrder, false>(lds, g2, S2, E2, rowtab, wave); }
        if (wed_pre > wed_pre1 && bx >= 192) { const int lo = wed_pre1 + (bx - 192) * 80; CVT_WED_RANGE(lo, lo + 80) }
    }
    SEAM(6);
    const ssd::Par SP{PROJ, args.in[9], args.in[10], args.in[11], args.in[12], args.in[13], args.in[14], (bf16*)(ws + WS_STATES), (float*)(ws + WS_CDEC)};
    if (IN(7)) { const bool dry = false;
        ssd::phase_a(lds, wave, SP, vcu, G);
        for (int it = vcu; it < BATCH * MEM_H * 8; it += G) {
            const int b = it >> 5, mh = (it >> 3) & 3, qt = it & 7;
            att::attn_unit<false>(lds, wave, PROJ + ((size_t)b * SEQ + 256 * qt) * P1W + 1536 + mh * HD, P1W, (const bf16*)(ws + WS_KMEM) + ((size_t)b * MEM_LEN) * 1024 + 512 + mh * HD, 1024,
                                  (const bf16*)(ws + WS_VMEMT) + (size_t)(512 + mh * HD) * MROWS + b * MEM_LEN, MROWS, 4, 0, nullptr, nullptr, 0, dry);
        }
    }
    SEAM(7);
    if (IN(8)) { ssd::phase_b(SP, bx * NTHR + tid, G * NTHR); }
    SEAM(8);
    if (IN(9)) {
        ssd::phase_c(lds, wave, SP, PROJ, vcu, G);
    }
    SEAM(9);
    if (IN(10)) {
        pg8::Gemm g{PROJ, (const bf16*)(ws + WS_WO) + (size_t)1024 * 2048, P1W, MIXW}; pg8::StaticOrder S; S.init(T / 256, 4, G, bx);
        EpiResid<true, true, false> E{nullptr, nullptr, XB, SS, ws + WS_XB8};
        pg8::gemm_phase<EpiResid<true, true, false>, pg8::StaticOrder, false>(lds, g, S, E, rowtab, wave);
    }
    SEAM(10);
    float* GW = (float*)(ws + WS_GW); int* LIST = (int*)(ws + WS_LIST);
    if (IN(11)) {
        LAS int* e1s = (LAS int*)lds; LAS int* e2s = e1s + 128; LAS int* lr0 = e1s + 256; LAS int* lr1 = e1s + 384; LAS int* basel = e1s + 512;
        const float* wr = args.in[19]; const float* br = args.in[20]; const float* gf = args.in[15] + D;
        f32x4 wa[16], wb[16];
#pragma unroll
        for (int j = 0; j < 4; ++j)
#pragma unroll
            for (int q = 0; q < 4; ++q) { const int k = 256 * j + 4 * lane + q; const float gk = gf[k];
                wa[4 * j + q] = *(const f32x4*)(wr + (size_t)k * 8) * gk; wb[4 * j + q] = *(const f32x4*)(wr + (size_t)k * 8 + 4) * gk; }
        const f32x4 ba = *(const f32x4*)br, bb = *(const f32x4*)(br + 4);
        for (int blk = bx; blk < T / 128; blk += G) {
#pragma unroll 1
            for (int i = 0; i < 16; ++i) {
                const int tl = wave * 16 + i, row = blk * 128 + tl;
                const GAS u32x2* xr = (const GAS u32x2*)(XB + (size_t)row * D) + lane;
                f32x4 a0 = {0.f, 0.f, 0.f, 0.f}, a1 = {0.f, 0.f, 0.f, 0.f}; float s = 0.f;
#pragma unroll
                for (int j = 0; j < 4; ++j) { const u32x2 xw = xr[64 * j]; const f32x4 v = {bflo(xw.x), bfhi(xw.x), bflo(xw.y), bfhi(xw.y)}; s += (v.x * v.x + v.y * v.y) + (v.z * v.z + v.w * v.w);
                    a0 += wa[4 * j] * v.x + wa[4 * j + 1] * v.y + wa[4 * j + 2] * v.z + wa[4 * j + 3] * v.w;
                    a1 += wb[4 * j] * v.x + wb[4 * j + 1] * v.y + wb[4 * j + 2] * v.z + wb[4 * j + 3] * v.w; }
                s = wave_sum(s); const float rs = 1.0f / sqrtf(s * (1.0f / 1024.0f) + EPS);
                float lg[8];
#pragma unroll
                for (int e = 0; e < 4; ++e) { lg[e] = wave_sum(a0[e]) * rs + ba[e]; lg[4 + e] = wave_sum(a1[e]) * rs + bb[e]; }
                int i1 = 0; float l1 = lg[0];
#pragma unroll
                for (int e = 1; e < 8; ++e) if (lg[e] > l1) { l1 = lg[e]; i1 = e; }
                int i2 = -1; float l2 = -__builtin_inff();
#pragma unroll
                for (int e = 0; e < 8; ++e) if (e != i1 && lg[e] > l2) { l2 = lg[e]; i2 = e; }
                const float w1 = 1.0f / (1.0f + expf(l2 - l1));
                if (lane == 0) { e1s[tl] = i1; e2s[tl] = i2; GW[(size_t)row * 2] = w1; GW[(size_t)row * 2 + 1] = 1.0f - w1; ((float*)(ws + WS_RSG))[row] = rs; }
            }
            __syncthreads();
            if (tid < 16) { const int k = tid >> 3, e = tid & 7; int cnt = 0;
                for (int t = 0; t < 128; ++t) { const int ee = k ? e2s[t] : e1s[t]; if (ee == e) { if (k) lr1[t] = cnt; else lr0[t] = cnt; ++cnt; } }
                basel[tid] = (int)__hip_atomic_fetch_add((unsigned*)(ctl + CW_CNT + 64 * tid), (unsigned)cnt, __ATOMIC_RELAXED, __HIP_MEMORY_SCOPE_AGENT); }
            __syncthreads();
            if (tid < 256) { const int k = tid >> 7, t = tid & 127, e = k ? e2s[t] : e1s[t], pos = basel[k * 8 + e] + (k ? lr1[t] : lr0[t]);
                LIST[(size_t)(k * 8 + e) * MOE_CAP + pos] = blk * 128 + t; }
            __syncthreads();
        }
        LAS float* scr = (LAS float*)(lds + 4096 + wave * 16384);
        const int gw = vcu * NWAVES + wave, NGW = G * NWAVES;
        const float* gf1 = args.in[15] + D;
        constexpr int NGU = (1024 / 64) * (7168 / 32), NDN = (FF / 64) * (1024 / 32);
        const int NITE = NEXP * NGU + (NDN_ALL - wed_pre);
        const int cvt_c = ((NITE + NGW - 1) / NGW), cvt_end = (gw + 1) * cvt_c < NITE ? (gw + 1) * cvt_c : NITE;
        for (int it = gw * cvt_c; it < cvt_end;) {
            CVT_DECL()
            int r;
            if (it < NEXP * NGU) { const int e = it / NGU; r = it % NGU;
                CVT_JOB8(args.in[21] + (size_t)e * 1024 * FF, args.in[22] + (size_t)e * 1024 * FF, gf1, ws + WS_WEGU + (size_t)e * 7168 * 1024, FF, 1024, 7168, 0, 1, 7168, F8_SW1) }
            else { const int iw = wed_pre + (it - NEXP * NGU), e = iw / NDN; r = iw % NDN;
                CVT_JOB8(args.in[23] + (size_t)e * FF * 1024, nullptr, nullptr, ws + WS_WED + (size_t)e * 1024 * FF, 1024, FF, 1024, 0, 0, 1024, F8_SW2) }
            CVT_RUN(it, cvt_end);
        }
        __syncthreads();
    }
    SEAM(11);
#define MOE_TABLES() \
        if (tid < 16) pan[288 + tid] = (int)__hip_atomic_load((unsigned*)(ctl + CW_CNT + 64 * tid), __ATOMIC_RELAXED, __HIP_MEMORY_SCOPE_AGENT); \
        __syncthreads(); \
        int cum[17]; cum[0] = 0; \
        _Pragma("unroll") for (int q = 0; q < 16; ++q) cum[q + 1] = cum[q] + ((pan[288 + q] + 255) >> 8); \
        const int NP = cum[16]; \
        { const int p_ = tid; if (p_ < NP) { int gi = 0; \
            _Pragma("unroll") for (int q = 1; q < 16; ++q) gi += (p_ >= cum[q]) ? 1 : 0; \
            int cg = 0; \
            _Pragma("unroll") for (int q = 0; q < 16; ++q) cg = (q == gi) ? cum[q] : cg; \
            pan[p_] = (gi << 16) | (p_ - cg); } } \
        __syncthreads();
#define MOE_ROWTAB(S) { Unit u; LAS unsigned short* rt = (LAS unsigned short*)(lds + ROWTAB_OFF); \
        for (int i = 0; i < 32 && S.next(i, u); ++i) { const int t_ = tid; \
            if (t_ < 256) { const int gi = pan[u.pm] >> 16, off = (pan[u.pm] & 0xffff) * 256 + t_; rt[u.ui * 256 + t_] = (unsigned short)((off < pan[288 + gi]) ? LIST[(size_t)gi * MOE_CAP + off] : 0xFFFF); } } } \
        __syncthreads();
    if (IN(12)) {
        MOE_TABLES()
        MoeOrder S; S.so.init(NP, 28, G, bx); S.pan = pan; S.npn = 28;
        MOE_ROWTAB(S)
        int kdim = D; asm volatile("" : "+s"(kdim));
        pg8::Gemm g{(const bf16*)(ws + WS_XB8), (const bf16*)(ws + WS_WEGU), D, kdim};
        EpiGateUp<true> E{(bf16*)(ws + WS_ACTM), nullptr, rowtab};
        pg8::gemm_phase<EpiGateUp<true>, MoeOrder, true, false, 1>(lds, g, S, E, rowtab, wave);
    }
    SEAM(12);
    if (IN(13)) {
        MOE_TABLES()
        MoeOrderSplit S; S.so.init(NP, 4, G, bx); S.pan = pan; S.npn = 4;
        MOE_ROWTAB(S)
        pg8::Gemm g{(const bf16*)(ws + WS_ACTM), (const bf16*)(ws + WS_WED), FF, FF};
        float* mscr = (float*)(ws + WS_WM1);
        bf16* yp0 = (bf16*)(ws + WS_YP0);
        const int nsl = S.nsl();
        EpiMoeDown E{yp0, (unsigned)((WS_YP1 - WS_YP0) / 2), GW, pan, rowtab, mscr, nsl};
        pg8::gemm_phase<EpiMoeDown, MoeOrderSplit, false, true, 1>(lds, g, S, E, rowtab, wave);
        const int ntl = S.ntail();
        if (ntl > 0) { xcd_barrier(bar);
            const int gw = vcu * NWAVES + wave, NGW = G * NWAVES, nf = S.nfull();
            for (int ri = gw; ri < ntl * 256; ri += NGW) { const int ti = ri >> 8, r = ri & 255; Unit u; S.so.decode(nf + ti, u);
                const int gi = pan[u.pm] >> 16, k = gi >> 3, off = (pan[u.pm] & 0xffff) * 256 + r;
                if (off < pan[288 + gi]) { const int tok = LIST[(size_t)gi * MOE_CAP + off]; const float w = GW[(size_t)tok * 2 + k] * (1.0f / (F8_SH * F8_SW2));
                    const float* sp = mscr + (size_t)(ti * nsl) * 65536 + r * 256 + 4 * lane; f32x4 a = *(const f32x4*)sp;
                    for (int q = 1; q < nsl; ++q) a += *(const f32x4*)(sp + (size_t)q * 65536);
                    a = a * w; u32x2 t2; t2.x = pk2(a[0], a[1]); t2.y = pk2(a[2], a[3]); *(u32x2*)(yp0 + (size_t)k * ((WS_YP1 - WS_YP0) / 2) + (size_t)tok * D + u.pn * 256 + 4 * lane) = t2; } } }
    }
    SEAM(13);
    if (IN(14)) {
        const int gw = vcu * NWAVES + wave, NGW = G * NWAVES;
        f32x4 gfin[4];
#pragma unroll
        for (int j = 0; j < 4; ++j) gfin[j] = *((const f32x4*)args.in[24] + lane + 64 * j);
        for (int m = gw; m < T; m += NGW) {
            const int ln = lane;
            GAS f32x4* xr = (GAS f32x4*)(out + (size_t)m * D) + ln; f32x4 v[4]; float s = 0.f;
            const GAS u32x2* xs = (const GAS u32x2*)(XB + (size_t)m * D) + ln;
            const GAS u32x2* y0 = (const GAS u32x2*)(ws + WS_YP0 + (size_t)m * D * 2) + ln; const GAS u32x2* y1 = (const GAS u32x2*)(ws + WS_YP1 + (size_t)m * D * 2) + ln;
#pragma unroll
            for (int j = 0; j < 4; ++j) { const u32x2 xw = xs[64 * j]; v[j] = (f32x4){bflo(xw.x), bfhi(xw.x), bflo(xw.y), bfhi(xw.y)}; const u32x2 a = y0[64 * j], b = y1[64 * j];
                v[j].x += bflo(a.x) + bflo(b.x); v[j].y += bfhi(a.x) + bfhi(b.x); v[j].z += bflo(a.y) + bflo(b.y); v[j].w += bfhi(a.y) + bfhi(b.y);
                s += (v[j].x * v[j].x + v[j].y * v[j].y) + (v[j].z * v[j].z + v[j].w * v[j].w); }
            s = wave_sum(s); const float rs = 1.0f / sqrtf(s * (1.0f / 1024.0f) + EPS);
#pragma unroll
            for (int j = 0; j < 4; ++j) xr[64 * j] = v[j] * rs * gfin[j];
        }
    }
#undef IN
#undef SEAM
#undef tid
#undef lane
#undef args
}

extern "C" void kernel_launch(void* const* d_in, const int* in_sizes, int n_in, void* d_out, int out_size, void* d_ws, size_t ws_size, hipStream_t stream) {
    static int grid = 0;
    if (grid == 0) {
        if (n_in != 25 || in_sizes[0] != T * D || out_size != T * D || ws_size < WS_END) { fprintf(stderr, "kernel_launch: unexpected shapes / workspace (n_in %d, ws %zu); nothing launched\n", n_in, ws_size); grid = -1; return; }
        int dev = 0, cus = 0, per_cu = 0;
        if (hipGetDevice(&dev) != hipSuccess || hipDeviceGetAttribute(&cus, hipDeviceAttributeMultiprocessorCount, dev) != hipSuccess) { grid = -1; return; }
        if (hipFuncSetAttribute((const void*)fwd_kernel, hipFuncAttributeMaxDynamicSharedMemorySize, LDS_BYTES) != hipSuccess) { fprintf(stderr, "kernel_launch: hipFuncSetAttribute failed\n"); grid = -1; return; }
        if (hipOccupancyMaxActiveBlocksPerMultiprocessor(&per_cu, (const void*)fwd_kernel, NTHR, LDS_BYTES) != hipSuccess || per_cu < 1) { fprintf(stderr, "kernel_launch: occupancy query says %d\n", per_cu); }
        (void)hipGetLastError();
        grid = cus;
    }
    if (grid < 0) return;
    if (hipMemsetAsync((char*)d_ws, 0, ZERO_BYTES, stream) != hipSuccess) return;
    Args a{};
    for (int i = 0; i < 25; ++i) a.in[i] = (const float*)d_in[i];
    a.out = (float*)d_out; a.ws = (unsigned char*)d_ws;
    a.ph_lo = 0; a.ph_hi = N_PHASES;
    hipLaunchKernelGGL(fwd_kernel, dim3(grid), dim3(NTHR), LDS_BYTES, stream, a);
}
```

```cpp
#include <hip/hip_runtime.h>
#include <cstdio>
#include <cstdint>

#define GAS __attribute__((address_space(1)))
#define LAS __attribute__((address_space(3)))
typedef unsigned short bf16;
typedef short bf16x8 __attribute__((ext_vector_type(8)));
typedef float f32x2 __attribute__((ext_vector_type(2)));
typedef float f32x4 __attribute__((ext_vector_type(4)));
typedef float f32x16 __attribute__((ext_vector_type(16)));
typedef unsigned u32x2 __attribute__((ext_vector_type(2)));
typedef unsigned u32x4 __attribute__((ext_vector_type(4)));
typedef int i32x4 __attribute__((ext_vector_type(4)));
typedef int i32x8 __attribute__((ext_vector_type(8)));
typedef __bf16 bf16x2_t __attribute__((ext_vector_type(2)));
typedef GAS unsigned gu32;

constexpr int D = 1024, BATCH = 16, SEQ = 2048, T = BATCH * SEQ;
constexpr int MEM_LEN = 256, MROWS = BATCH * MEM_LEN;
constexpr int MOBA_H = 12, HD = 128, MOBA_W = 1536, NBLK = 8;
constexpr int MEM_H = 4, MEM_W = 512;
constexpr int SSD_H = 24, SSD_P = 64, SSD_IN = 1536, SSD_G = 4, SSD_N = 128, SSD_CH = 128, NCHUNK = SEQ / SSD_CH, CONV_DIM = 2560;
constexpr int IN_MOBA = 5120, IN_SSD = 4632, MIXW = 2048, FF = 3584, NEXP = 8;
constexpr int P0W = 3584;
constexpr int P1W = 4864;
constexpr int P1_XBC = 2048, P1_DT = 4608;
constexpr float EPS = 1e-6f;
constexpr float LOG2E = 1.4426950408889634f;
constexpr int MOE_CAP = T;
constexpr int MOE_MAXP = 272;

constexpr size_t MiB = 1u << 20;
constexpr size_t WS_CTL = 0, WS_KMEAN = 1 * MiB, ZERO_BYTES = 2 * MiB;
constexpr size_t WS_SS = 2 * MiB;
constexpr size_t WS_MEMSS = 4 * MiB;
constexpr size_t WS_GW = 5 * MiB;
constexpr size_t WS_LIST = 6 * MiB;
constexpr size_t WS_CDEC = 8 * MiB;
constexpr size_t WS_WM1 = 9 * MiB;
constexpr size_t WS_WV = 16 * MiB;
constexpr size_t WS_WS = 19 * MiB;
constexpr size_t WS_WMK = 29 * MiB;
constexpr size_t WS_WMV = 31 * MiB;
constexpr size_t WS_WO = 33 * MiB;
constexpr size_t WS_WGU = 41 * MiB;
constexpr size_t WS_WD = 55 * MiB;
constexpr size_t WS_MEMB = 62 * MiB;
constexpr size_t WS_KMEM = 70 * MiB;
constexpr size_t WS_VMEMT = 78 * MiB;
constexpr size_t WS_XB = 86 * MiB;
constexpr size_t WS_BIG = 150 * MiB;
constexpr size_t WS_PROJ = WS_BIG;
constexpr size_t WS_VT = 374 * MiB;
constexpr size_t WS_ACT = WS_BIG;
constexpr size_t WS_STATES = 454 * MiB;
constexpr size_t WS_ACTM = WS_BIG;
constexpr size_t WS_WED = 550 * MiB;
constexpr size_t WS_WEGU = 416 * MiB;
constexpr size_t WS_XB8 = 472 * MiB;
constexpr size_t WS_YP0 = 416 * MiB;
constexpr size_t WS_YP1 = 480 * MiB;
constexpr size_t WS_RSG = 544 * MiB;
constexpr size_t WS_END = 555 * MiB;
static_assert(WS_PROJ + (size_t)T * P0W * 2 <= WS_VT && WS_VT + (size_t)MOBA_W * T * 2 <= 470 * MiB, "layer 0 map");
static_assert(WS_PROJ + (size_t)T * P1W * 2 <= WS_STATES && WS_STATES + (size_t)BATCH * NCHUNK * SSD_H * SSD_P * SSD_N * 2 <= 550 * MiB, "layer 1 map");
static_assert(WS_ACTM + (size_t)MOE_MAXP * 256 * FF <= 388 * MiB && WS_WED + (size_t)NEXP * 1024 * FF <= 578 * MiB && WS_WED >= 550 * MiB && 388 * MiB <= WS_WEGU && WS_WEGU + (size_t)NEXP * 7168 * 1024 <= WS_XB8 && WS_XB8 + (size_t)T * D <= WS_RSG && WS_YP0 + (size_t)T * D * 2 <= WS_YP1 && WS_YP1 + (size_t)T * D * 2 <= WS_RSG && WS_RSG + (size_t)T * 4 <= WS_END && WS_XB8 >= WS_PROJ + (size_t)T * P1W * 2, "moe map");
constexpr int CW_BAR = 4096;
constexpr int CW_CNT = 16384;

constexpr int RING_BYTES = 131072;
constexpr int MISC_OFF = RING_BYTES;
constexpr int PAN_OFF = RING_BYTES + 1024;
constexpr int ROWTAB_OFF = RING_BYTES + 3072;
constexpr int LDS_BYTES = ROWTAB_OFF + 16 * 1024 + 4096;
constexpr int NWAVES = 8, NTHR = 512;

__device__ __forceinline__ unsigned pk2(float lo, float hi) { f32x2 v = {lo, hi}; bf16x2_t b = __builtin_convertvector(v, bf16x2_t); return __builtin_bit_cast(unsigned, b); }
__device__ __forceinline__ float bf2f(unsigned short b) { return __uint_as_float(((unsigned)b) << 16); }
__device__ __forceinline__ float bflo(unsigned w) { return __uint_as_float(w << 16); }
__device__ __forceinline__ float bfhi(unsigned w) { return __uint_as_float(w & 0xffff0000u); }
__device__ __forceinline__ float fast_exp2(float x) { return __builtin_amdgcn_exp2f(x); }
__device__ __forceinline__ float fast_rcp(float x) { return __builtin_amdgcn_rcpf(x); }
__device__ __forceinline__ float silu_f(float x) { return x * fast_rcp(1.0f + fast_exp2(-x * LOG2E)); }
__device__ __forceinline__ float wave_sum(float v) {
#pragma unroll
    for (int o = 1; o < 64; o <<= 1) v += __shfl_xor(v, o);
    return v;
}
__device__ __forceinline__ int opaque_tid(int wv) { int l = __builtin_amdgcn_mbcnt_hi(~0u, __builtin_amdgcn_mbcnt_lo(~0u, 0u)); asm volatile("" : "+v"(l)); return wv * 64 + l; }
struct Args { const float* in[25]; float* out; unsigned char* ws; int ph_lo, ph_hi; };
static_assert(sizeof(Args) == 25 * 8 + 8 + 8 + 8, "Args has no padding");

typedef const __attribute__((address_space(4))) Args* kargs_t;
__device__ __forceinline__ kargs_t kargs() { kargs_t p = (kargs_t)__builtin_amdgcn_kernarg_segment_ptr(); asm volatile("" : "+s"(p)); return p; }
#define LDS_WAIT() asm volatile("s_waitcnt lgkmcnt(0)" ::: "memory")
#define VM_WAIT() asm volatile("s_waitcnt vmcnt(0)" ::: "memory")
#define MFMA32(a, b, c) __builtin_amdgcn_mfma_f32_32x32x16_bf16((a), (b), (c), 0, 0, 0)

#define XB_TMO      128
#define XB_XCNT(j)  (256  + 64 * (j))
#define XB_XSUB(j)  (1280 + 64 * (j))
#define XB_XGEN(j)  (2304 + 64 * (j))
#define XB_TOP      3328
#define XB_TOPGEN   3392
#define XCD_BAR_WORDS 3456
#define XB_SPIN_CAP (1u << 18)

__device__ __forceinline__ unsigned xb_ld(unsigned* p)              { return __hip_atomic_load(p, __ATOMIC_RELAXED, __HIP_MEMORY_SCOPE_AGENT); }
__device__ __forceinline__ unsigned xb_add(unsigned* p, unsigned v) { return __hip_atomic_fetch_add(p, v, __ATOMIC_RELAXED, __HIP_MEMORY_SCOPE_AGENT); }
__device__ __forceinline__ unsigned xb_xcc_id() { return (unsigned)__builtin_amdgcn_s_getreg((3 << 11) | 20) & 0xFu; }
#define XB_SPIN(cond, bar) do { unsigned _sp = 0; while (cond) { __builtin_amdgcn_s_sleep(1); \
    if ((++_sp & 255u) == 0u) { if (xb_ld(&(bar)[XB_TMO])) break; if (_sp > XB_SPIN_CAP) { atomicAdd(&(bar)[XB_TMO], 1u); break; } } } } while (0)

struct XcdBarrier {
    unsigned* bar; unsigned x;
    volatile LAS unsigned* st;
};

__device__ __forceinline__ XcdBarrier xcd_barrier_post(unsigned* bar, volatile LAS unsigned* st) {
    XcdBarrier b; b.bar = bar; b.x = xb_xcc_id(); b.st = st;
    if (threadIdx.x == 0) (void)xb_add(&bar[XB_XCNT(b.x)], 1u);
    return b;
}
__device__ __forceinline__ void xcd_barrier_complete(unsigned* bar, unsigned x, unsigned& nloc, unsigned& nx) {
    const unsigned G = gridDim.x * gridDim.y * gridDim.z;
    unsigned sum, cnt, mine, sp = 0u;
    for (;;) {
        sum = 0u; cnt = 0u; mine = 0u;
#pragma unroll
        for (unsigned j = 0; j < 16; ++j) { const unsigned c = xb_ld(&bar[XB_XCNT(j)]); sum += c; cnt += (c > 0u) ? 1u : 0u; mine = (j == x) ? c : mine; }
        if (sum == G) break;
        __builtin_amdgcn_s_sleep(1);
        if ((++sp & 255u) == 0u) { if (xb_ld(&bar[XB_TMO])) break; if (sp > XB_SPIN_CAP) { atomicAdd(&bar[XB_TMO], 1u); break; } }
    }
    nloc = mine > 0u ? mine : 1u; nx = cnt > 0u ? cnt : 1u;
}

__device__ __forceinline__ void xcd_barrier(const XcdBarrier& b) {
    asm volatile("s_waitcnt vmcnt(0)" ::: "memory");
    __syncthreads();
    if (threadIdx.x == 0) {
        unsigned* bar = b.bar;
        __builtin_amdgcn_s_waitcnt(0);
        unsigned nloc = b.st[0], nx = b.st[1];
        if (nloc == 0u) { xcd_barrier_complete(bar, b.x, nloc, nx); b.st[0] = nloc; b.st[1] = nx; }
        const unsigned old = xb_add(&bar[XB_XSUB(b.x)], 1u);
        const unsigned gen = old / nloc;
        if (old + 1u == (gen + 1u) * nloc) {
            __builtin_amdgcn_fence(__ATOMIC_RELEASE, "agent");
            asm volatile("s_waitcnt vmcnt(0)" ::: "memory");
            const unsigned og = xb_add(&bar[XB_TOP], 1u);
            const unsigned tg = og / nx;
            if (og + 1u == (tg + 1u) * nx) xb_add(&bar[XB_TOPGEN], 1u);
            else XB_SPIN(xb_ld(&bar[XB_TOPGEN]) == tg, bar);
            __builtin_amdgcn_fence(__ATOMIC_ACQUIRE, "agent");
            xb_add(&bar[XB_XGEN(b.x)], 1u);
            asm volatile("s_waitcnt vmcnt(0)" ::: "memory");
        } else {
            XB_SPIN(xb_ld(&bar[XB_XGEN(b.x)]) == gen, bar);
            __builtin_amdgcn_fence(__ATOMIC_ACQUIRE, "agent");
            asm volatile("s_waitcnt vmcnt(0)" ::: "memory");
        }
    }
    __syncthreads();
}


namespace pg8 {
constexpr int BM = 256, BK = 64, HALF = 128, HTB = HALF * BK * 2, STAGE_BYTES = 8 * HTB, NXCD = 8, WGM = 8;
__host__ __device__ __forceinline__ int lds_byte(int r, int c) { const int st = (r >> 4) * 2 + (c >> 5), rr = r & 15, cc = c & 31, ob = rr * 64 + cc * 2; return st * 1024 + (ob ^ (((ob >> 9) & 1) << 5)); }
__host__ __device__ __forceinline__ void stage_rc(int b, int& R, int& C) { const int st = b / 1024, sb = b % 1024, swz = sb ^ (((sb >> 9) & 1) << 5); R = (st >> 1) * 16 + swz / 64; C = (st & 1) * 32 + (swz % 64) / 2; }
__host__ __device__ __forceinline__ int perm32(int rho) { const int n = rho >> 4, i = rho & 15; return 8 * (i >> 2) + 4 * n + (i & 3); }

struct Unit { int pm, pn, ui, kt0, nkt, ti; };
struct Gemm { const bf16* A; const bf16* Bt; int lda, K; };

struct StaticOrder {
    int nM, nN, nwg, G, c;
    __device__ __forceinline__ void init(int nM_, int nN_, int G_, int c_) { nM = nM_; nN = nN_; nwg = nM * nN; G = G_; c = c_; }
    __device__ __forceinline__ void decode(int wgid, Unit& u) const {
        { const int q = nwg / NXCD, r = nwg % NXCD, xcd = wgid % NXCD, off = wgid / NXCD; wgid = (xcd < r ? xcd * (q + 1) : r * (q + 1) + (xcd - r) * q) + off; }
        const int nig = WGM * nN, gid = wgid / nig, fm = gid * WGM, gsz = (nM - fm) < WGM ? (nM - fm) : WGM;
        u.pm = fm + ((wgid % nig) % gsz); u.pn = (wgid % nig) / gsz;
    }
    __device__ __forceinline__ bool next(int i, Unit& u) const {
        const int L = i * G + c; if (L >= nwg) return false;
        decode(L, u); u.ui = i; u.kt0 = 0; u.nkt = 0; u.ti = -1; return true;
    }
};

template <class Epi, class Sched, bool GATHER, bool KSPLIT = false, int ESZ = 2>
__device__ __forceinline__ void gemm_phase(LAS unsigned char* lds, const Gemm g, const Sched& S, const Epi& E, const LAS unsigned short* rowtab, int wv) {
    const int tid = opaque_tid(wv), wid = wv, lane = tid & 63, wr = wid >> 2, wc = wid & 3, fr = lane & 15, fq = lane >> 4;
    const int K = g.K, nt = K * ESZ / 128, lda = g.lda;
    unsigned voffB[2];
    unsigned vA00, vA01, vA10, vA11;
#pragma unroll
    for (int i = 0; i < 2; ++i) { int R, C; stage_rc(tid * 16 + i * 8192, R, C); const int Rb = Epi::PERM ? ((R & ~31) + perm32(R & 31)) : R;
        voffB[i] = (unsigned)(Rb * K * ESZ + C * 2); }
#define PG8_RC() int RA0, CA0, RA1, CA1; { int t_ = tid; asm volatile("" : "+v"(t_)); stage_rc(t_ * 16, RA0, CA0); stage_rc(t_ * 16 + 8192, RA1, CA1); }
    const size_t kstep = (size_t)(BK * 2);
    const size_t hstepB = (size_t)HALF * K * ESZ, tstepB = 2 * hstepB;
    const size_t tstepA = (size_t)BM * lda * ESZ;
    const size_t hA = GATHER ? 0 : (size_t)HALF * lda * ESZ;
    const unsigned ldsw = (unsigned)wid * 1024u;
    const int aoff = lds_byte(wr * 64 + fr, fq * 8), boff = lds_byte(wc * 32 + fr, fq * 8);
#define PG8_SA(b, h) (((b) * 2 + (h)) * HTB)
#define PG8_SB(b, h) ((4 + (b) * 2 + (h)) * HTB)
#define PG8_GLDS(gptr, ldsoff) __builtin_amdgcn_global_load_lds((const unsigned*)(gptr), (LAS unsigned*)(lds + (ldsoff)), 16, 0, 0)
#define PG8_GLDS_S(gbase, voff, ldsoff) do { unsigned keep_; asm volatile("s_mov_b32 %0, m0\n\ts_mov_b32 m0, %3\n\ts_nop 0\n\tglobal_load_lds_dwordx4 %1, %2\n\ts_mov_b32 m0, %0" \
        : "=&s"(keep_) : "v"(voff), "s"(gbase), "s"((unsigned)(size_t)(lds + (ldsoff))) : "memory"); } while (0)
#define PG8_STAGE_B(bufoff, gbase) do { if constexpr (ESZ == 1) { PG8_GLDS_S((const char*)(gbase), voffB[0], (bufoff) + ldsw); PG8_GLDS_S((const char*)(gbase) + (size_t)64 * K * ESZ, voffB[0], (bufoff) + ldsw + 8192); } \
        else { PG8_GLDS((const char*)(gbase) + voffB[0], (bufoff) + ldsw); PG8_GLDS((const char*)(gbase) + voffB[1], (bufoff) + ldsw + 8192); } } while (0)
#define PG8_STAGE_A(bufoff, gbase, v0, v1) do { if constexpr (ESZ == 1) { PG8_GLDS_S((const char*)(gbase), (v0), (bufoff) + ldsw); \
            if constexpr (GATHER) PG8_GLDS_S((const char*)(gbase), (v1), (bufoff) + ldsw + 8192); else PG8_GLDS_S((const char*)(gbase) + (size_t)64 * lda * ESZ, (v0), (bufoff) + ldsw + 8192); } \
        else { PG8_GLDS((const char*)(gbase) + (v0), (bufoff) + ldsw); PG8_GLDS((const char*)(gbase) + (v1), (bufoff) + ldsw + 8192); } } while (0)
#define PG8_STAGE_AG(bufoff, gbase, half, uix, v0, v1) do { if constexpr (GATHER) { const LAS unsigned short* q_ = rtp0 + (uix) * 256 + (half) * 128; int t0_ = q_[0], t1_ = q_[64]; \
            t0_ = t0_ == 0xFFFF ? 0 : t0_; t1_ = t1_ == 0xFFFF ? 0 : t1_;        \
            PG8_GLDS_S((const char*)(gbase), (unsigned)(t0_ * lda * ESZ) + cb2, (bufoff) + ldsw); PG8_GLDS_S((const char*)(gbase), (unsigned)(t1_ * lda * ESZ) + cb2, (bufoff) + ldsw + 8192); } \
        else PG8_STAGE_A(bufoff, (gbase) + ((half) ? hA : 0), v0, v1); } while (0)
#define PG8_LDA(dst, b, h) do { _Pragma("unroll") for (int m = 0; m < 4; ++m) { \
        if constexpr (ESZ == 2) { _Pragma("unroll") for (int k = 0; k < 2; ++k) dst[m][k] = *(const LAS bf16x8*)(lds + PG8_SA(b, h) + aoff + m * 2048 + k * 1024); } \
        else dst##8[m] = __builtin_shufflevector(*(const LAS i32x4*)(lds + PG8_SA(b, h) + aoff + m * 2048), *(const LAS i32x4*)(lds + PG8_SA(b, h) + aoff + m * 2048 + 1024), 0, 1, 2, 3, 4, 5, 6, 7); } } while (0)
#define PG8_LDB(dst, b, h) do { _Pragma("unroll") for (int n = 0; n < 2; ++n) { \
        if constexpr (ESZ == 2) { _Pragma("unroll") for (int k = 0; k < 2; ++k) dst[n][k] = *(const LAS bf16x8*)(lds + PG8_SB(b, h) + boff + n * 2048 + k * 1024); } \
        else dst##8[n] = __builtin_shufflevector(*(const LAS i32x4*)(lds + PG8_SB(b, h) + boff + n * 2048), *(const LAS i32x4*)(lds + PG8_SB(b, h) + boff + n * 2048 + 1024), 0, 1, 2, 3, 4, 5, 6, 7); } } while (0)
#define PG8_MMA(ai, bj, At, Bt) do { __builtin_amdgcn_s_setprio(1); _Pragma("unroll") for (int m = 0; m < 4; ++m) _Pragma("unroll") for (int n = 0; n < 2; ++n) { \
        if constexpr (ESZ == 2) { _Pragma("unroll") for (int k = 0; k < 2; ++k) acc[ai][bj][m][n] = __builtin_amdgcn_mfma_f32_16x16x32_bf16(Bt[n][k], At[m][k], acc[ai][bj][m][n], 0, 0, 0); } \
        else acc[ai][bj][m][n] = __builtin_amdgcn_mfma_scale_f32_16x16x128_f8f6f4(Bt##8[n], At##8[m], acc[ai][bj][m][n], 0, 0, 0, 0, 0, 0); } \
        __builtin_amdgcn_s_setprio(0); } while (0)
#define PG8_WAIT_V(n) asm volatile("s_waitcnt vmcnt(" #n ")" ::: "memory")
#define PG8_WAIT_L(n) asm volatile("s_waitcnt lgkmcnt(" #n ")" ::: "memory")
#define PG8_BAR __builtin_amdgcn_s_barrier()
#define PG8_SCHED __builtin_amdgcn_sched_barrier(0)
    Unit cur, nxt; int ui = 0;
    if (!S.next(0, cur)) return;
    f32x4 acc[2][2][4][2];
#pragma unroll
    for (int a = 0; a < 2; ++a)
#pragma unroll
        for (int b = 0; b < 2; ++b)
#pragma unroll
            for (int m = 0; m < 4; ++m)
#pragma unroll
                for (int n = 0; n < 2; ++n) acc[a][b][m][n] = (f32x4){0.f, 0.f, 0.f, 0.f};
    bf16x8 At[4][2], B0[2][2], B1[2][2];
    i32x8 At8[4], B08[2], B18[2];
    const char* cA; const char* cB = (const char*)g.Bt + (size_t)cur.pn * tstepB + (KSPLIT ? (size_t)cur.kt0 * kstep : 0);
    const LAS unsigned short* rtp0 = rowtab; unsigned cb2 = 0;
    if constexpr (GATHER) {
        static_assert(!GATHER || ESZ == 1, "gathered A rows: fp8 body only");
        cA = (const char*)g.A; PG8_RC();
        rtp0 = rowtab + RA0; cb2 = (unsigned)(CA0 * 2); vA00 = vA01 = vA10 = vA11 = 0;
    } else {
        cA = (const char*)g.A + (size_t)cur.pm * tstepA + (KSPLIT ? (size_t)cur.kt0 * kstep : 0); PG8_RC();
        vA00 = (unsigned)(RA0 * lda * ESZ + CA0 * 2); vA01 = (unsigned)(RA1 * lda * ESZ + CA1 * 2);
        vA10 = vA00; vA11 = vA01;
    }
    PG8_STAGE_B(PG8_SB(0, 0), cB); PG8_STAGE_B(PG8_SB(0, 1), cB + hstepB); PG8_STAGE_AG(PG8_SA(0, 0), cA, 0, cur.ui, vA00, vA01); PG8_STAGE_AG(PG8_SA(0, 1), cA, 1, cur.ui, vA10, vA11);
    if (wr == 1) PG8_BAR;
    PG8_WAIT_V(2); PG8_BAR;
    PG8_STAGE_B(PG8_SB(1, 0), cB + kstep); PG8_STAGE_AG(PG8_SA(1, 0), cA + kstep, 0, cur.ui, vA00, vA01); PG8_STAGE_B(PG8_SB(1, 1), cB + hstepB + kstep);
    PG8_WAIT_V(6); PG8_BAR;
    for (;;) {
        const bool has_next = S.next(ui + 1, nxt);
        const char* nA; const char* nB = has_next ? (const char*)g.Bt + (size_t)nxt.pn * tstepB + (KSPLIT ? (size_t)nxt.kt0 * kstep : 0) : cB;
        const int cnt = KSPLIT ? cur.nkt : nt;
        if constexpr (GATHER) {
            nA = cA;
        } else {
            nA = has_next ? (const char*)g.A + (size_t)nxt.pm * tstepA + (KSPLIT ? (size_t)nxt.kt0 * kstep : 0) : cA;
        }
        for (int t = 0; t < cnt; t += 2) {
            const bool last = (t == cnt - 2);
            const char* a1 = cA + (size_t)(t + 1) * kstep;
            const char* a2 = last ? nA : cA + (size_t)(t + 2) * kstep; const char* b2 = last ? nB : cB + (size_t)(t + 2) * kstep;
            const char* a3 = a2 + kstep; const char* b3 = b2 + kstep;
            unsigned w00 = vA00, w01 = vA01, w10 = vA10, w11 = vA11;
            const int uiN = (last && has_next) ? nxt.ui : cur.ui;
            PG8_LDB(B0, 0, 0); PG8_LDB(B1, 0, 1); PG8_SCHED; PG8_LDA(At, 0, 0); PG8_STAGE_AG(PG8_SA(1, 1), a1, 1, cur.ui, vA10, vA11);
            PG8_WAIT_V(8); PG8_WAIT_L(0); PG8_BAR; PG8_MMA(0, 0, At, B0); PG8_MMA(0, 1, At, B1); PG8_BAR; PG8_SCHED;
            PG8_LDA(At, 0, 1); PG8_STAGE_B(PG8_SB(0, 0), b2); PG8_STAGE_B(PG8_SB(0, 1), b2 + hstepB); PG8_STAGE_AG(PG8_SA(0, 0), a2, 0, uiN, w00, w01);
            PG8_WAIT_V(8); PG8_WAIT_L(0); PG8_BAR; PG8_MMA(1, 0, At, B0); PG8_MMA(1, 1, At, B1); PG8_BAR; PG8_SCHED;
            PG8_LDB(B0, 1, 0); PG8_LDB(B1, 1, 1); PG8_SCHED; PG8_LDA(At, 1, 0); PG8_STAGE_AG(PG8_SA(0, 1), a2, 1, uiN, w10, w11);
            PG8_WAIT_V(8); PG8_WAIT_L(0); PG8_BAR; PG8_MMA(0, 0, At, B0); PG8_MMA(0, 1, At, B1); PG8_BAR; PG8_SCHED;
            PG8_LDA(At, 1, 1); PG8_STAGE_B(PG8_SB(1, 0), b3); PG8_STAGE_B(PG8_SB(1, 1), b3 + hstepB); PG8_STAGE_AG(PG8_SA(1, 0), a3, 0, uiN, w00, w01);
            PG8_WAIT_V(8); PG8_WAIT_L(0); PG8_BAR; PG8_MMA(1, 0, At, B0); PG8_MMA(1, 1, At, B1); PG8_BAR; PG8_SCHED;
        }
        if (wr == 0) PG8_BAR;
        if constexpr (ESZ == 1) { const int l2_ = opaque_tid(wv) & 63; E(acc, cur, wr, wc, l2_ & 15, l2_ >> 4); }
        else E(acc, cur, wr, wc, fr, fq);
        if (!has_next) break;
#pragma unroll
        for (int a = 0; a < 2; ++a)
#pragma unroll
            for (int b = 0; b < 2; ++b)
#pragma unroll
                for (int m = 0; m < 4; ++m)
#pragma unroll
                    for (int n = 0; n < 2; ++n) acc[a][b][m][n] = (f32x4){0.f, 0.f, 0.f, 0.f};
        cur = nxt; cA = nA; cB = nB; ++ui;
        if (wr == 1) PG8_BAR;
    }
    PG8_WAIT_V(0);
    PG8_BAR;
#undef PG8_SA
#undef PG8_SB
#undef PG8_GLDS
#undef PG8_RC
#undef PG8_GLDS_S
#undef PG8_STAGE_A
#undef PG8_STAGE_AG
#undef PG8_STAGE_B
#undef PG8_LDA
#undef PG8_LDB
#undef PG8_MMA
#undef PG8_WAIT_V
#undef PG8_WAIT_L
#undef PG8_BAR
#undef PG8_SCHED
}
}

constexpr int MOE_NKT = FF / 128;
#ifndef MOE_NSLICE
#define MOE_NSLICE 7
#endif
using pg8::Unit;
__device__ __forceinline__ f32x4 row_ss_load(const float* SS, int row, int fq) { return *(const f32x4*)(SS + (unsigned)(row * 16 + 4 * fq)); }
__device__ __forceinline__ float row_rs_from(const f32x4 p) {
    float s = (p.x + p.y) + (p.z + p.w);
    s += __shfl_xor(s, 16); s += __shfl_xor(s, 32);
    return __builtin_amdgcn_rsqf(s + 1024.0f * EPS) * 32.0f;
}
constexpr float F8_SX = 8.f, F8_SW1 = 64.f, F8_SH = 4.f, F8_SW2 = 128.f;
template <bool CLAMP = false> __device__ __forceinline__ unsigned pk4_fp8(float a, float b, float c, float d) {
    if (CLAMP) { a = __builtin_amdgcn_fmed3f(a, -448.f, 448.f); b = __builtin_amdgcn_fmed3f(b, -448.f, 448.f); c = __builtin_amdgcn_fmed3f(c, -448.f, 448.f); d = __builtin_amdgcn_fmed3f(d, -448.f, 448.f); }
    int r = 0; r = __builtin_amdgcn_cvt_pk_fp8_f32(a, b, r, false); r = __builtin_amdgcn_cvt_pk_fp8_f32(c, d, r, true); return (unsigned)r; }
__device__ __forceinline__ u32x4 pack8(const f32x4 a, const f32x4 b) { u32x4 w; w.x = pk2(a[0], a[1]); w.y = pk2(a[2], a[3]); w.z = pk2(b[0], b[1]); w.w = pk2(b[2], b[3]); return w; }

constexpr float ATT_QSCALE = 0.08838834764831845f * LOG2E;
struct EpiScale {
    static constexpr bool PERM = true;
    bf16* O; int ldc; const float* SS; float* kmean; int kcol0; int qp0, qp1;
    __device__ __forceinline__ void operator()(const f32x4 (&acc)[2][2][4][2], const Unit& u, int wr, int wc, int fr, int fq) const {
        const int row0 = u.pm * 256 + wr * 64 + fr, col0 = u.pn * 256 + wc * 32 + 8 * fq;
        const bool dok = (kmean != nullptr) && (u.pn * 256 >= kcol0);
        const float qsc = (u.pn >= qp0 && u.pn < qp1) ? ATT_QSCALE : 1.0f;
        f32x4 ks[2][2];
#pragma unroll
        for (int bj = 0; bj < 2; ++bj)
#pragma unroll
            for (int n = 0; n < 2; ++n) ks[bj][n] = (f32x4){0.f, 0.f, 0.f, 0.f};
        f32x4 pp[2][4];
#pragma unroll
        for (int ai = 0; ai < 2; ++ai)
#pragma unroll
            for (int m = 0; m < 4; ++m) pp[ai][m] = row_ss_load(SS, row0 + ai * 128 + m * 16, fq);
#pragma unroll
        for (int ai = 0; ai < 2; ++ai)
#pragma unroll
            for (int m = 0; m < 4; ++m) {
                const int row = row0 + ai * 128 + m * 16; const float rs = row_rs_from(pp[ai][m]) * qsc;
                bf16* rowp = O + (size_t)row * ldc + col0;
#pragma unroll
                for (int bj = 0; bj < 2; ++bj) { const f32x4 v0 = acc[ai][bj][m][0] * rs, v1 = acc[ai][bj][m][1] * rs;
                    ks[bj][0] += v0; ks[bj][1] += v1;
                    *(u32x4*)(rowp + bj * 128) = pack8(v0, v1); }
            }
        if (dok) {
#pragma unroll
            for (int bj = 0; bj < 2; ++bj)
#pragma unroll
                for (int n = 0; n < 2; ++n)
#pragma unroll
                    for (int j = 0; j < 4; ++j) { float v = ks[bj][n][j];
                        v += __shfl_xor(v, 1); v += __shfl_xor(v, 2); v += __shfl_xor(v, 4); v += __shfl_xor(v, 8);
                        if (fr == 0) unsafeAtomicAdd(kmean + (size_t)u.pm * MOBA_W + (col0 + bj * 128 + 4 * n + j - kcol0), v); }
        }
    }
};
struct EpiVT {
    static constexpr bool PERM = true;
    bf16* O; int ldc; const float* RS;
    __device__ __forceinline__ void operator()(const f32x4 (&acc)[2][2][4][2], const Unit& u, int wr, int wc, int fr, int fq) const {
        const int row0 = u.pm * 256 + wr * 64 + fr, col0 = u.pn * 256 + wc * 32 + 8 * fq;
        f32x4 rs[2][2];
#pragma unroll
        for (int bj = 0; bj < 2; ++bj) { rs[bj][0] = *(const f32x4*)(RS + col0 + bj * 128); rs[bj][1] = *(const f32x4*)(RS + col0 + bj * 128 + 4); }
#pragma unroll
        for (int ai = 0; ai < 2; ++ai)
#pragma unroll
            for (int m = 0; m < 4; ++m) {
                bf16* rowp = O + (size_t)(row0 + ai * 128 + m * 16) * ldc + col0;
#pragma unroll
                for (int bj = 0; bj < 2; ++bj) *(u32x4*)(rowp + bj * 128) = pack8(acc[ai][bj][m][0] * rs[bj][0], acc[ai][bj][m][1] * rs[bj][1]);
            }
    }
};
template <bool F8, bool BASEBF, bool WF32> struct EpiResid {
    static constexpr bool PERM = true;
    const float* base; float* out; bf16* xb; float* SS; unsigned char* xb8;
    __device__ __forceinline__ void operator()(const f32x4 (&acc)[2][2][4][2], const Unit& u, int wr, int wc, int fr, int fq) const {
        const int row0 = u.pm * 256 + wr * 64 + fr, col0 = u.pn * 256 + wc * 32 + 8 * fq;
        static_assert(BASEBF, "EpiResid: the residual base is the bf16 stream");
        u32x4 bw[2][4][2];
#pragma unroll
        for (int ai = 0; ai < 2; ++ai)
#pragma unroll
            for (int m = 0; m < 4; ++m)
#pragma unroll
                for (int bj = 0; bj < 2; ++bj) bw[ai][m][bj] = *(const u32x4*)(xb + (unsigned)((row0 + ai * 128 + m * 16) * D + col0 + bj * 128));
#pragma unroll
        for (int ai = 0; ai < 2; ++ai)
#pragma unroll
            for (int m = 0; m < 4; ++m) {
                const int row = row0 + ai * 128 + m * 16; const unsigned off = (unsigned)(row * D + col0); float sq = 0.f;
#pragma unroll
                for (int bj = 0; bj < 2; ++bj) {
                    const u32x4 b = bw[ai][m][bj];
                    const f32x4 b0 = (f32x4){bflo(b.x), bfhi(b.x), bflo(b.y), bfhi(b.y)}, b1 = (f32x4){bflo(b.z), bfhi(b.z), bflo(b.w), bfhi(b.w)};
                    const f32x4 v0 = acc[ai][bj][m][0] + b0, v1 = acc[ai][bj][m][1] + b1;
                    if (WF32) { *(f32x4*)(out + off + bj * 128) = v0; *(f32x4*)(out + off + bj * 128 + 4) = v1; }
                    else *(u32x4*)(xb + off + bj * 128) = pack8(v0, v1);
                    if (F8) { u32x2 t8; t8.x = pk4_fp8(v0[0] * F8_SX, v0[1] * F8_SX, v0[2] * F8_SX, v0[3] * F8_SX); t8.y = pk4_fp8(v1[0] * F8_SX, v1[1] * F8_SX, v1[2] * F8_SX, v1[3] * F8_SX); *(u32x2*)(xb8 + off + bj * 128) = t8; }
                    sq += (v0[0] * v0[0] + v0[1] * v0[1]) + (v0[2] * v0[2] + v0[3] * v0[3]) + (v1[0] * v1[0] + v1[1] * v1[1]) + (v1[2] * v1[2] + v1[3] * v1[3]);
                }
                sq += __shfl_xor(sq, 16); sq += __shfl_xor(sq, 32);
                if (fq == 0) SS[(unsigned)(row * 16 + u.pn * 4 + wc)] = sq;
            }
    }
};
template <bool MOE> struct EpiGateUp {
    static constexpr bool PERM = true;
    bf16* O; const float* SS; const LAS unsigned short* rowtab;
    __device__ __forceinline__ void operator()(const f32x4 (&acc)[2][2][4][2], const Unit& u, int wr, int wc, int fr, int fq) const {
        if (MOE) asm volatile("" : "+v"(fr), "+v"(fq));
        const int pnl = MOE ? (u.pn % 28) : u.pn, colo = pnl * 128 + wc * 32 + 8 * fq;
        f32x4 pp[2][4]; float rsm[2][4];
        const float* rsg_ = MOE ? (const float*)((*kargs()).ws + WS_RSG) : nullptr;
#pragma unroll
        for (int ai = 0; ai < 2; ++ai)
#pragma unroll
            for (int m = 0; m < 4; ++m) { const int orow = u.pm * 256 + ai * 128 + wr * 64 + m * 16 + fr;
                if (MOE) { int tk_ = rowtab[u.ui * 256 + ai * 128 + wr * 64 + m * 16 + fr]; tk_ = tk_ == 0xFFFF ? 0 : tk_; rsm[ai][m] = rsg_[(unsigned)tk_]; } else pp[ai][m] = row_ss_load(SS, orow, fq); }
#pragma unroll
        for (int ai = 0; ai < 2; ++ai)
#pragma unroll
            for (int m = 0; m < 4; ++m) {
                const int rl = ai * 128 + wr * 64 + m * 16 + fr, orow = u.pm * 256 + rl;
                const float rs = MOE ? rsm[ai][m] * (1.0f / (F8_SX * F8_SW1)) : row_rs_from(pp[ai][m]);
                const f32x4 g0 = acc[ai][0][m][0] * rs, g1 = acc[ai][0][m][1] * rs, u0 = acc[ai][1][m][0] * rs, u1 = acc[ai][1][m][1] * rs;
                f32x4 h0, h1;
#pragma unroll
                for (int j = 0; j < 4; ++j) { h0[j] = silu_f(g0[j]) * u0[j]; h1[j] = silu_f(g1[j]) * u1[j]; }
                if (MOE) { u32x2 t8; t8.x = pk4_fp8(h0[0] * F8_SH, h0[1] * F8_SH, h0[2] * F8_SH, h0[3] * F8_SH); t8.y = pk4_fp8(h1[0] * F8_SH, h1[1] * F8_SH, h1[2] * F8_SH, h1[3] * F8_SH);
                           *(u32x2*)((unsigned char*)O + (unsigned)(orow * FF + colo)) = t8; }
                else *(u32x4*)(O + (size_t)orow * FF + colo) = pack8(h0, h1);
            }
    }
};
struct EpiMoeDown {
    static constexpr bool PERM = true;
    bf16* yp0; unsigned ypstride; const float* GW; const LAS int* pan; const LAS unsigned short* rowtab; float* scr; int nsl;
    __device__ __forceinline__ void operator()(const f32x4 (&acc)[2][2][4][2], const Unit& u, int wr, int wc, int fr, int fq) const {
        asm volatile("" : "+v"(fr), "+v"(fq));
        const int pnl = u.pn & 3, col0 = pnl * 256 + wc * 32 + 8 * fq;
        if (u.ti >= 0) {
            float* sp = scr + ((size_t)(u.ti * nsl + u.kt0 / u.nkt)) * 65536 + wc * 32 + 8 * fq;
#pragma unroll
            for (int ai = 0; ai < 2; ++ai)
#pragma unroll
                for (int m = 0; m < 4; ++m) { float* rp = sp + (ai * 128 + wr * 64 + m * 16 + fr) * 256;
#pragma unroll
                    for (int bj = 0; bj < 2; ++bj) { *(f32x4*)(rp + bj * 128) = acc[ai][bj][m][0]; *(f32x4*)(rp + bj * 128 + 4) = acc[ai][bj][m][1]; } }
            return;
        }
        const int k = (pan[u.pm] >> 19) & 1;
        bf16* yp = yp0 + (size_t)k * ypstride;
        int tk[2][4]; float wt[2][4];
#pragma unroll
        for (int ai = 0; ai < 2; ++ai)
#pragma unroll
            for (int m = 0; m < 4; ++m) tk[ai][m] = rowtab[u.ui * 256 + ai * 128 + wr * 64 + m * 16 + fr];
#pragma unroll
        for (int ai = 0; ai < 2; ++ai)
#pragma unroll
            for (int m = 0; m < 4; ++m) wt[ai][m] = GW[(unsigned)((tk[ai][m] == 0xFFFF ? 0 : tk[ai][m]) * 2 + k)];
#pragma unroll
        for (int ai = 0; ai < 2; ++ai)
#pragma unroll
            for (int m = 0; m < 4; ++m) {
                const int tok = tk[ai][m];
                if (tok != 0xFFFF) { const float w = wt[ai][m] * (1.0f / (F8_SH * F8_SW2)); bf16* p = yp + (unsigned)(tok * D + col0);
#pragma unroll
                    for (int bj = 0; bj < 2; ++bj) *(u32x4*)(p + bj * 128) = pack8(acc[ai][bj][m][0] * w, acc[ai][bj][m][1] * w); }
                asm volatile("" ::: "memory");
            }
    }
};

struct CvtJ { const float* s0; const float* s1; const float* g; bf16* d; int ld, K, nr, c0, md, nv, n, f8; float sc; };
__device__ __forceinline__ void cvt_load(const CvtJ& J, int item, int lane, f32x4 (&v)[8]) {
    const int nblk = J.nr / 32, kb = item / nblk, nb = item % nblk, k0 = 64 * kb, n0 = 32 * nb;
    const float* src = J.s0; int col = J.c0 + n0;
    if (J.md == 1) { const int blk = n0 >> 8, r = n0 & 255; src = (r < 128) ? J.s0 : J.s1; col = blk * 128 + (r & 127); }
    const int lr = lane >> 3, lc = (lane & 7) * 4;
    const bool ok = (n0 + lc) < J.nv;
#pragma unroll
    for (int i = 0; i < 8; ++i) { v[i] = (f32x4){0.f, 0.f, 0.f, 0.f}; if (ok) v[i] = *(const GAS f32x4*)(src + (size_t)(k0 + 8 * i + lr) * J.ld + col + lc); }
    if (J.g) {
#pragma unroll
        for (int i = 0; i < 8; ++i) v[i] = v[i] * J.g[k0 + 8 * i + lr];
    }
}
__device__ __forceinline__ void cvt_store(const CvtJ& J, int item, int lane, LAS float* scr, const f32x4 (&v)[8]) {
    const int nblk = J.nr / 32, kb = item / nblk, nb = item % nblk, k0 = 64 * kb, n0 = 32 * nb;
    const int lr = lane >> 3, lc = (lane & 7) * 4;
#pragma unroll
    for (int i = 0; i < 8; ++i) { LAS float* sp = scr + (8 * i + lr) * 33 + lc; sp[0] = v[i].x; sp[1] = v[i].y; sp[2] = v[i].z; sp[3] = v[i].w; }
    LDS_WAIT(); asm volatile("" ::: "memory");
    if (J.f8) {
        const int c4 = lane & 3; const float sc = J.sc;
#pragma unroll
        for (int j = 0; j < 2; ++j) { const int n = (lane >> 2) + 16 * j; const LAS float* s = scr + (16 * c4) * 33 + n;
            u32x4 o; o.x = pk4_fp8<true>(s[0 * 33] * sc, s[1 * 33] * sc, s[2 * 33] * sc, s[3 * 33] * sc); o.y = pk4_fp8<true>(s[4 * 33] * sc, s[5 * 33] * sc, s[6 * 33] * sc, s[7 * 33] * sc);
            o.z = pk4_fp8<true>(s[8 * 33] * sc, s[9 * 33] * sc, s[10 * 33] * sc, s[11 * 33] * sc); o.w = pk4_fp8<true>(s[12 * 33] * sc, s[13 * 33] * sc, s[14 * 33] * sc, s[15 * 33] * sc);
            *(GAS u32x4*)((unsigned char*)J.d + (size_t)(n0 + n) * J.K + k0 + 16 * c4) = o; }
    } else {
    const int c = lane & 7;
#pragma unroll
    for (int j = 0; j < 4; ++j) { const int n = (lane >> 3) + 8 * j; const LAS float* s = scr + (8 * c) * 33 + n;
        u32x4 o; o.x = pk2(s[0 * 33], s[1 * 33]); o.y = pk2(s[2 * 33], s[3 * 33]); o.z = pk2(s[4 * 33], s[5 * 33]); o.w = pk2(s[6 * 33], s[7 * 33]);
        *(GAS u32x4*)(J.d + (size_t)(n0 + n) * J.K + k0 + 8 * c) = o; }
    }
    LDS_WAIT(); asm volatile("" ::: "memory");
}
#define CVT_DECL() CvtJ J; J.s0 = nullptr; J.s1 = nullptr; J.g = nullptr; J.d = nullptr; J.ld = 0; J.K = 64; J.nr = 32; J.c0 = 0; J.md = 0; J.nv = 0; J.n = 0; J.f8 = 0; J.sc = 1.f; bool j_found = false;
#define CVT_JOB(src0, src1, gain, dst, ld_, K_, nrows, col0, mode, nvalid) { const int _n = ((K_) / 64) * ((nrows) / 32); \
    if (!j_found) { if (r < _n) { J.s0 = (src0); J.s1 = (src1); J.g = (gain); J.d = (dst); J.ld = (ld_); J.K = (K_); J.nr = (nrows); J.c0 = (col0); J.md = (mode); J.nv = (nvalid); J.n = _n; j_found = true; } else r -= _n; } }
#define CVT_JOB8(src0, src1, gain, dst, ld_, K_, nrows, col0, mode, nvalid, scale) { const int _n = ((K_) / 64) * ((nrows) / 32); \
    if (!j_found) { if (r < _n) { J.s0 = (src0); J.s1 = (src1); J.g = (gain); J.d = (bf16*)(dst); J.ld = (ld_); J.K = (K_); J.nr = (nrows); J.c0 = (col0); J.md = (mode); J.nv = (nvalid); J.n = _n; J.f8 = 1; J.sc = (scale); j_found = true; } else r -= _n; } }
#define CVT_RUN(it, end) do { int m_ = J.n - r; if ((end) - (it) < m_) m_ = (end) - (it); if (!j_found || m_ < 1) m_ = 1; \
    if (j_found) { f32x4 va[8], vb[8], vc[8]; cvt_load(J, r, lane, va); if (m_ > 1) cvt_load(J, r + 1, lane, vb);       \
        for (int j_ = 0; j_ < m_; j_ += 3) { \
            if (j_ + 2 < m_) cvt_load(J, r + j_ + 2, lane, vc); cvt_store(J, r + j_, lane, scr, va); \
            if (j_ + 1 < m_) { if (j_ + 3 < m_) cvt_load(J, r + j_ + 3, lane, va); cvt_store(J, r + j_ + 1, lane, scr, vb); } \
            if (j_ + 2 < m_) { if (j_ + 4 < m_) cvt_load(J, r + j_ + 4, lane, vb); cvt_store(J, r + j_ + 2, lane, scr, vc); } } } \
    (it) += m_; } while (0)

namespace att {
constexpr int KBUF = 0, VBUF = 32768, LUT_OFF = 65536, KM_OFF = 65536 + 1024;
__device__ __forceinline__ int ks_off(int row, int chunk) { return row * 256 + ((chunk ^ ((row & 3) | (((row >> 3) & 3) << 2))) << 4); }
__device__ __forceinline__ int vs_off(int row, int chunk) { return row * 128 + ((chunk ^ (((row >> 1) & 1) | (((row >> 3) & 3) << 1))) << 4); }
__device__ __forceinline__ int qt_base(int w) { return w < 7 ? 73728 + w * 8192 : 133120; }
__device__ __forceinline__ int qt_off(int row, int piece) { return row * 256 + ((piece ^ (row & 15)) << 4); }

template <bool MOBA>
__device__ __forceinline__ void attn_unit(LAS unsigned char* lds, int wv, bf16* Qb, int ldq, const bf16* Kb, int ldk, const bf16* VTb, int ldvt, int ntiles,
                                          int nblk, const float* ksum_bh, const float* rel_bias, int head, bool dry = false) {
    const int tid = opaque_tid(wv), lane = tid & 63, w = wv, c = lane & 31, hi = lane >> 5;
    int kofs0, kofs1, vofs0, vofs1;
    { const int r0 = w * 4 + (lane >> 4), r1 = r0 + 32, cs = lane & 15;
      kofs0 = r0 * ldk + ((cs ^ ((r0 & 3) | (((r0 >> 3) & 3) << 2))) << 3); kofs1 = r1 * ldk + ((cs ^ ((r1 & 3) | (((r1 >> 3) & 3) << 2))) << 3);
      const int v0 = w * 8 + (lane >> 3), v1 = v0 + 64, cv = lane & 7;
      vofs0 = v0 * ldvt + ((cv ^ (((v0 >> 1) & 1) | (((v0 >> 3) & 3) << 1))) << 3); vofs1 = v1 * ldvt + ((cv ^ (((v1 >> 1) & 1) | (((v1 >> 3) & 3) << 1))) << 3); }
#define ATT_GLDS(gptr, ldsoff) __builtin_amdgcn_global_load_lds((const unsigned*)(gptr), (LAS unsigned*)(lds + (ldsoff)), 16, 0, 0)
#define ATT_STAGE(ti, buf) do { const bf16* kt_ = Kb + (size_t)(64 * (ti)) * ldk; const bf16* vt_ = VTb + 64 * (ti); \
        ATT_GLDS(kt_ + kofs0, (buf) * 16384 + KBUF + w * 1024); ATT_GLDS(kt_ + kofs1, (buf) * 16384 + KBUF + 8192 + w * 1024); \
        ATT_GLDS(vt_ + vofs0, (buf) * 16384 + VBUF + w * 1024); ATT_GLDS(vt_ + vofs1, (buf) * 16384 + VBUF + 8192 + w * 1024); } while (0)
    ATT_STAGE(0, 0);
    LAS float* lut = (LAS float*)(lds + LUT_OFF);
    LAS float* km = (LAS float*)(lds + KM_OFF);
    if (MOBA) {
        if (tid < 130) { float v;
            if (tid == 0) v = -__builtin_inff();
            else { const int d = tid - 1; int bk;
                if (d < 16) bk = d; else if (d >= 128) bk = 31;
                else bk = 16 + (d >= 19) + (d >= 21) + (d >= 24) + (d >= 27) + (d >= 31) + (d >= 35) + (d >= 40) + (d >= 46) + (d >= 52) + (d >= 59) + (d >= 67) + (d >= 77) + (d >= 87) + (d >= 99) + (d >= 113);
                v = rel_bias[bk * MOBA_H + head] * LOG2E; }
            lut[tid] = v; }
        for (int idx = tid; idx < nblk * 128; idx += NTHR) km[idx] = ksum_bh[(size_t)(idx >> 7) * MOBA_W + (idx & 127)];
    }
    LAS unsigned char* qt = lds + qt_base(w);
    bf16* qtile = Qb + (size_t)(32 * w) * ldq;
    const int qr = lane >> 4, qp = lane & 15;
    { u32x4 qq[8];
#pragma unroll
      for (int i = 0; i < 8; ++i) qq[i] = *(const u32x4*)(qtile + (size_t)(4 * i + qr) * ldq + 8 * qp);
#pragma unroll
      for (int i = 0; i < 8; ++i) *(LAS u32x4*)(qt + qt_off(4 * i + qr, qp)) = qq[i]; }
    LDS_WAIT(); asm volatile("" ::: "memory");
    bf16x8 qf[8];
#pragma unroll
    for (int ks = 0; ks < 8; ++ks) qf[ks] = *(const LAS bf16x8*)(qt + qt_off(c, 2 * ks + hi));
    LDS_WAIT(); asm volatile("" ::: "memory");
    VM_WAIT();
    __syncthreads();
    unsigned selmask = 0;
    if (MOBA) {
        if (nblk <= 3) selmask = (1u << nblk) - 1u;
        else {
            float g[7];
#pragma unroll
            for (int j = 0; j < 7; ++j) { g[j] = -__builtin_inff();
                if (j < nblk) { float s = 0.f;
#pragma unroll
                    for (int ks = 0; ks < 8; ++ks) { const LAS float* kp = km + j * 128 + 16 * ks + 8 * hi; const f32x4 k0 = *(const LAS f32x4*)kp, k1 = *(const LAS f32x4*)(kp + 4);
                        const u32x4 qw = __builtin_bit_cast(u32x4, qf[ks]);
                        s += bflo(qw.x) * k0[0] + bfhi(qw.x) * k0[1] + bflo(qw.y) * k0[2] + bfhi(qw.y) * k0[3] + bflo(qw.z) * k1[0] + bfhi(qw.z) * k1[1] + bflo(qw.w) * k1[2] + bfhi(qw.w) * k1[3]; }
                    s += __shfl_xor(s, 32); g[j] = s; } }
#pragma unroll
            for (int pick = 0; pick < 3; ++pick) { float best = -__builtin_inff(); int bi = 0;
#pragma unroll
                for (int j = 0; j < 7; ++j) { const bool cand = (j < nblk) && !((selmask >> j) & 1u) && (g[j] > best); best = cand ? g[j] : best; bi = cand ? j : bi; }
                selmask |= 1u << bi; }
        }
    }
    const int pi = (c & ~0xC) | ((c & 4) << 1) | ((c & 8) >> 1);
    const int kra = ks_off(pi, 0) & ~0xF0, kxa = (pi & 3) | (((pi >> 3) & 3) << 2);
    const int vxa = ((c >> 1) & 1) | (((c >> 3) & 3) << 1);
    float m_run = -1e30f, l_run = 0.f;
    f32x16 o0, o1, o2, o3;
#pragma unroll
    for (int r = 0; r < 16; ++r) { o0[r] = 0.f; o1[r] = 0.f; o2[r] = 0.f; o3[r] = 0.f; }
    const int qpos = 256 * nblk + 32 * w + c;
    const float bfar = MOBA ? lut[129] : 0.f;
    for (int ti = 0; ti < ntiles; ++ti) {
        const int cur = ti & 1;
        int kx = kxa, vx = vxa; asm volatile("" : "+v"(kx), "+v"(vx));
        if (ti + 1 < ntiles) ATT_STAGE(ti + 1, cur ^ 1);
        const int kb = 64 * ti;
        bool skip = false, nearb = false, own = false;
        if (MOBA) { own = ((ti >> 2) == nblk); const int qlo = 256 * nblk + 32 * w;
            skip = own && (kb > qlo + 31);
            nearb = (qlo - (kb + 63)) < 128; }
        if (!skip) {
            float offs = 0.f;
            if (MOBA) { const bool sel = own || ((selmask >> (ti >> 2)) & 1u); offs = sel ? 0.f : -__builtin_inff(); }
            const bool first = m_run < -1e29f;
            const float mref = first ? 0.f : m_run;
            const float cinit = ((MOBA && nearb) ? offs : bfar + offs) - mref;
            f32x16 p0, p1;
#pragma unroll
            for (int r = 0; r < 16; ++r) { p0[r] = cinit; p1[r] = cinit; }
            const LAS unsigned char* kbase = lds + cur * 16384 + KBUF + kra;
#pragma unroll
            for (int ks = 0; ks < 8; ++ks) { const int co = ((2 * ks + hi) ^ kx) << 4;
                const bf16x8 a0 = *(const LAS bf16x8*)(kbase + co), a1 = *(const LAS bf16x8*)(kbase + 8192 + co);
                p0 = MFMA32(a0, qf[ks], p0); p1 = MFMA32(a1, qf[ks], p1);
                if (ks == 3) __builtin_amdgcn_sched_barrier(0); }
            if (MOBA && nearb) {
#pragma unroll
                for (int r = 0; r < 16; ++r) { const int kl = (r & 7) + 8 * hi + 16 * (r >> 3);
                    int i0 = qpos - (kb + kl) + 1, i1 = i0 - 32;
                    i0 = i0 < 0 ? 0 : (i0 > 129 ? 129 : i0); i1 = i1 < 0 ? 0 : (i1 > 129 ? 129 : i1);
                    p0[r] += lut[i0]; p1[r] += lut[i1];
                    if ((r & 3) == 3) __builtin_amdgcn_sched_barrier(0); }
            }
            float mx = p0[0];
#pragma unroll
            for (int r = 1; r < 16; ++r) mx = fmaxf(mx, p0[r]);
#pragma unroll
            for (int r = 0; r < 16; ++r) mx = fmaxf(mx, p1[r]);
            mx = fmaxf(mx, __shfl_xor(mx, 32));
            if (!__all(mx <= 8.0f && !first)) {
                const float mn = fmaxf(m_run, mx + mref); const float alpha = fast_exp2(m_run - mn); m_run = mn;
                l_run *= alpha; o0 *= alpha; o1 *= alpha; o2 *= alpha; o3 *= alpha;
                const float sub = mn - mref;
#pragma unroll
                for (int r = 0; r < 16; ++r) { p0[r] -= sub; p1[r] -= sub; } }
            float ls = 0.f;
#pragma unroll
            for (int r = 0; r < 16; ++r) { p0[r] = fast_exp2(p0[r]); p1[r] = fast_exp2(p1[r]); ls += p0[r] + p1[r]; }
            l_run += ls;
            bf16x8 pf[4];
            { u32x4 t;
              t.x = pk2(p0[0], p0[1]); t.y = pk2(p0[2], p0[3]); t.z = pk2(p0[4], p0[5]); t.w = pk2(p0[6], p0[7]); pf[0] = __builtin_bit_cast(bf16x8, t);
              t.x = pk2(p0[8], p0[9]); t.y = pk2(p0[10], p0[11]); t.z = pk2(p0[12], p0[13]); t.w = pk2(p0[14], p0[15]); pf[1] = __builtin_bit_cast(bf16x8, t);
              t.x = pk2(p1[0], p1[1]); t.y = pk2(p1[2], p1[3]); t.z = pk2(p1[4], p1[5]); t.w = pk2(p1[6], p1[7]); pf[2] = __builtin_bit_cast(bf16x8, t);
              t.x = pk2(p1[8], p1[9]); t.y = pk2(p1[10], p1[11]); t.z = pk2(p1[12], p1[13]); t.w = pk2(p1[14], p1[15]); pf[3] = __builtin_bit_cast(bf16x8, t); }
            const LAS unsigned char* vbase = lds + cur * 16384 + VBUF + c * 128;
#pragma unroll
            for (int q = 0; q < 4; ++q) { const int co = ((2 * q + hi) ^ vx) << 4;
                o0 = MFMA32(*(const LAS bf16x8*)(vbase + co), pf[q], o0);
                o1 = MFMA32(*(const LAS bf16x8*)(vbase + 4096 + co), pf[q], o1);
                o2 = MFMA32(*(const LAS bf16x8*)(vbase + 8192 + co), pf[q], o2);
                o3 = MFMA32(*(const LAS bf16x8*)(vbase + 12288 + co), pf[q], o3);
                if (q == 1) __builtin_amdgcn_sched_barrier(0); }
        }
        VM_WAIT();
        __syncthreads();
    }
    const float inv = 1.0f / (l_run + __shfl_xor(l_run, 32));
    int l2 = lane; asm volatile("" : "+v"(l2));
    const int c2 = l2 & 31, h2 = l2 >> 5, qr2 = l2 >> 4, qp2 = l2 & 15;
#pragma unroll
    for (int a = 0; a < 4; ++a) {
        u32x2 t;
        t.x = pk2(o0[4 * a] * inv, o0[4 * a + 1] * inv); t.y = pk2(o0[4 * a + 2] * inv, o0[4 * a + 3] * inv); *(LAS u32x2*)(qt + qt_off(c2, a) + 8 * h2) = t;
        t.x = pk2(o1[4 * a] * inv, o1[4 * a + 1] * inv); t.y = pk2(o1[4 * a + 2] * inv, o1[4 * a + 3] * inv); *(LAS u32x2*)(qt + qt_off(c2, 4 + a) + 8 * h2) = t;
        t.x = pk2(o2[4 * a] * inv, o2[4 * a + 1] * inv); t.y = pk2(o2[4 * a + 2] * inv, o2[4 * a + 3] * inv); *(LAS u32x2*)(qt + qt_off(c2, 8 + a) + 8 * h2) = t;
        t.x = pk2(o3[4 * a] * inv, o3[4 * a + 1] * inv); t.y = pk2(o3[4 * a + 2] * inv, o3[4 * a + 3] * inv); *(LAS u32x2*)(qt + qt_off(c2, 12 + a) + 8 * h2) = t;
    }
    LDS_WAIT(); asm volatile("" ::: "memory");
#pragma unroll
    for (int i = 0; i < 8; ++i) { const u32x4 oq = *(const LAS u32x4*)(qt + qt_off(4 * i + qr2, qp2)); if (!dry) *(u32x4*)(qtile + (size_t)(4 * i + qr2) * ldq + 8 * qp2) = oq; }
    LDS_WAIT(); asm volatile("" ::: "memory");
#undef ATT_GLDS
#undef ATT_STAGE
}
}

namespace ssd {
constexpr int DT_OFF = 0, CS_OFF = 3072, SSP_OFF = 6144;
constexpr int A_BMT = 8192, A_XT = 8192 + 32768;
constexpr int C_BM = 8192, C_CM = 8192 + 32768, C_XT = 8192 + 65536;
__device__ __forceinline__ int sw_off(int row, int chunk) { return row * 256 + ((chunk ^ ((row & 3) | (((row >> 3) & 3) << 2))) << 4); }

__device__ __forceinline__ int zt_base(int w) { return w < 6 ? 106496 + w * 4096 : 133120 + (w - 6) * 4096; }
__device__ __forceinline__ int zt_off(int row, int piece) { return row * 128 + ((piece ^ (row & 7)) << 4); }
struct Par { const bf16* proj; const float* conv_w; const float* conv_b; const float* dt_bias; const float* a_log; const float* d_skip; const float* g_out; bf16* states; float* cdec; };

__device__ __forceinline__ void dtcs(LAS unsigned char* lds, int wv, const Par& P, int b, int c, int g, bool write_cdec) {
    const int tid = opaque_tid(wv), lane = tid & 63, w = wv;
    if (w < 6) {
        const int hd = g * 6 + w; const size_t row0 = (size_t)b * SEQ + c * SSD_CH + 2 * lane;
        const float r0 = bf2f(P.proj[row0 * P1W + P1_DT + hd]), r1 = bf2f(P.proj[(row0 + 1) * P1W + P1_DT + hd]);
        const float bias = P.dt_bias[hd], A = -expf(P.a_log[hd]);
        const float x0 = r0 + bias, x1 = r1 + bias;
        const float d0 = x0 > 20.f ? x0 : log1pf(expf(x0)), d1 = x1 > 20.f ? x1 : log1pf(expf(x1));
        const float la0 = d0 * A, la1 = d1 * A; const float s1 = la0 + la1; float v = s1;
#pragma unroll
        for (int off = 1; off < 64; off <<= 1) { const float t = __shfl_up(v, off); if (lane >= off) v += t; }
        LAS float* dt = (LAS float*)(lds + DT_OFF) + w * 128; LAS float* cs = (LAS float*)(lds + CS_OFF) + w * 128;
        dt[2 * lane] = d0; dt[2 * lane + 1] = d1; cs[2 * lane] = v - s1 + la0; cs[2 * lane + 1] = v;
        if (write_cdec && lane == 63) P.cdec[((size_t)b * NCHUNK + c) * SSD_H + hd] = expf(v);
    }
}
__device__ __forceinline__ void conv8(const Par& P, int b, int s0, int chx, float (&y0)[8], float (&y1)[8]) {
    float x0[11], x1[11];
    const bf16* base = P.proj + ((size_t)b * SEQ) * P1W + P1_XBC + chx;
#pragma unroll
    for (int j = 0; j < 11; ++j) { const int s = s0 - 3 + j; unsigned wv = 0u; if (s >= 0) wv = *(const unsigned*)(base + (size_t)s * P1W); x0[j] = bflo(wv); x1[j] = bfhi(wv); }
    f32x2 wj[4];
#pragma unroll
    for (int j = 0; j < 4; ++j) wj[j] = *(const f32x2*)(P.conv_w + j * CONV_DIM + chx);
    const f32x2 bb = *(const f32x2*)(P.conv_b + chx);
#pragma unroll
    for (int i = 0; i < 8; ++i) {
        const float a0 = bb.x + wj[0].x * x0[i] + wj[1].x * x0[i + 1] + wj[2].x * x0[i + 2] + wj[3].x * x0[i + 3];
        const float a1 = bb.y + wj[0].y * x1[i] + wj[1].y * x1[i + 1] + wj[2].y * x1[i + 2] + wj[3].y * x1[i + 3];
        y0[i] = silu_f(a0); y1[i] = silu_f(a1); }
}
__device__ __forceinline__ u32x4 pack8f(const float (&y)[8]) { u32x4 t; t.x = pk2(y[0], y[1]); t.y = pk2(y[2], y[3]); t.z = pk2(y[4], y[5]); t.w = pk2(y[6], y[7]); return t; }

constexpr int A_WT = 90112, A_SC = 100352;
__device__ __forceinline__ void conv_load(const Par& P, int b, int s0, int chx, unsigned (&r)[11]) {
    const bf16* base = P.proj + ((size_t)b * SEQ) * P1W + P1_XBC + chx;
#pragma unroll
    for (int j = 0; j < 11; ++j) { const int s = s0 - 3 + j; r[j] = *(const unsigned*)(base + (size_t)(s < 0 ? 0 : s) * P1W); }
}
__device__ __forceinline__ void conv_math(const LAS float* wt, int lc, int s0, const unsigned (&r)[11], float (&y0)[8], float (&y1)[8]) {
    float x0[11], x1[11];
#pragma unroll
    for (int j = 0; j < 11; ++j) { x0[j] = bflo(r[j]); x1[j] = bfhi(r[j]); }
    if (s0 == 0) {
#pragma unroll
        for (int j = 0; j < 3; ++j) { x0[j] = 0.f; x1[j] = 0.f; } }
    f32x2 wj[4];
#pragma unroll
    for (int j = 0; j < 4; ++j) wj[j] = *(const LAS f32x2*)(wt + j * 512 + lc);
    const f32x2 bb = *(const LAS f32x2*)(wt + 4 * 512 + lc);
#pragma unroll
    for (int i = 0; i < 8; ++i) {
        const float a0 = bb.x + wj[0].x * x0[i] + wj[1].x * x0[i + 1] + wj[2].x * x0[i + 2] + wj[3].x * x0[i + 3];
        const float a1 = bb.y + wj[0].y * x1[i] + wj[1].y * x1[i + 1] + wj[2].y * x1[i + 2] + wj[3].y * x1[i + 3];
        y0[i] = silu_f(a0); y1[i] = silu_f(a1); }
}
__device__ __forceinline__ void phase_a(LAS unsigned char* lds, int wv, const Par& P, int vcu, int G) {
    const int tid = opaque_tid(wv), lane = tid & 63, w = wv;
    constexpr int NIT = BATCH * NCHUNK * SSD_G;
    unsigned rB[2][11], rX[6][11], dr0 = 0, dr1 = 0;
#define A_DEC(it_) const int g = (it_) & 3, c = ((it_) >> 2) & 15, b = (it_) >> 6
#define A_LD_DT(it_) { A_DEC(it_); if (w < 6) { const size_t row0 = (size_t)b * SEQ + c * SSD_CH + 2 * lane; dr0 = P.proj[row0 * P1W + P1_DT + g * 6 + w]; dr1 = P.proj[(row0 + 1) * P1W + P1_DT + g * 6 + w]; } }
#define A_LD_B(it_) { A_DEC(it_); int t_ = tid; asm volatile("" : "+v"(t_)); _Pragma("unroll") for (int j = 0; j < 2; ++j) { const int i2 = t_ + NTHR * j, cp = i2 & 63, tg = i2 >> 6; conv_load(P, b, c * SSD_CH + 8 * tg, SSD_IN + g * SSD_N + 2 * cp, rB[j]); } }
#define A_LD_X(it_, hg) { A_DEC(it_); int t_ = tid; asm volatile("" : "+v"(t_)); _Pragma("unroll") for (int j = 0; j < 3; ++j) { const int i2 = t_ + NTHR * j, cp = i2 % 96, tg = i2 / 96; conv_load(P, b, c * SSD_CH + 8 * tg, (g * 6 + 3 * (hg) + (cp >> 5)) * SSD_P + 2 * (cp & 31), rX[3 * (hg) + j]); } }
    int it = vcu, gtab = -1;
    if (it < NIT) { A_LD_DT(it) A_LD_B(it) A_LD_X(it, 0) A_LD_X(it, 1) }
    const LAS float* wt = (const LAS float*)(lds + A_WT); const LAS float* sct = (const LAS float*)(lds + A_SC);
#pragma unroll 1
    for (; it < NIT; it += G) {
        A_DEC(it); const int itc = (it + G < NIT) ? it + G : it;
        if (g != gtab) { gtab = g;
            const int ch = tid < 128 ? SSD_IN + g * SSD_N + tid : g * 6 * SSD_P + (tid - 128);
#pragma unroll
            for (int j = 0; j < 4; ++j) ((LAS float*)(lds + A_WT))[j * 512 + tid] = P.conv_w[j * CONV_DIM + ch];
            ((LAS float*)(lds + A_WT))[4 * 512 + tid] = P.conv_b[ch];
            __syncthreads(); }
        if (w < 6) {
            const int hd = g * 6 + w; const float bias = P.dt_bias[hd], A = -expf(P.a_log[hd]);
            const float x0 = bf2f((unsigned short)dr0) + bias, x1 = bf2f((unsigned short)dr1) + bias;
            const float d0 = x0 > 20.f ? x0 : log1pf(expf(x0)), d1 = x1 > 20.f ? x1 : log1pf(expf(x1));
            const float la0 = d0 * A, la1 = d1 * A; const float s1 = la0 + la1; float v = s1;
#pragma unroll
            for (int off = 1; off < 64; off <<= 1) { const float t = __shfl_up(v, off); if (lane >= off) v += t; }
            const float cend = __shfl(v, 63);
            LAS float* sc = (LAS float*)(lds + A_SC) + w * 128;
            sc[2 * lane] = d0 * expf(cend - (v - s1 + la0)); sc[2 * lane + 1] = d1 * expf(cend - v);
            if (lane == 63) P.cdec[((size_t)b * NCHUNK + c) * SSD_H + hd] = expf(v);
        }
        int tb = tid; asm volatile("" : "+v"(tb));
#pragma unroll
        for (int j = 0; j < 2; ++j) { const int i2 = tb + NTHR * j, cp = i2 & 63, tg = i2 >> 6; float y0[8], y1[8];
            conv_math(wt, 2 * cp, c * SSD_CH + 8 * tg, rB[j], y0, y1);
            *(LAS u32x4*)(lds + A_BMT + sw_off(2 * cp, tg)) = pack8f(y0); *(LAS u32x4*)(lds + A_BMT + sw_off(2 * cp + 1, tg)) = pack8f(y1); }
        { A_LD_DT(itc) A_LD_B(itc) }
        __syncthreads();
#pragma unroll
        for (int hg = 0; hg < 2; ++hg) {
            int tx = tid; asm volatile("" : "+v"(tx));
#pragma unroll
            for (int j = 0; j < 3; ++j) { const int i2 = tx + NTHR * j, cp = i2 % 96, tg = i2 / 96; const int e3 = cp >> 5, e = 3 * hg + e3, pp = 2 * (cp & 31); float y0[8], y1[8];
                conv_math(wt, 128 + e * SSD_P + pp, c * SSD_CH + 8 * tg, rX[3 * hg + j], y0, y1);
                const f32x4 sa = *(const LAS f32x4*)(sct + e * 128 + 8 * tg), sb = *(const LAS f32x4*)(sct + e * 128 + 8 * tg + 4);
#pragma unroll
                for (int i = 0; i < 4; ++i) { y0[i] *= sa[i]; y1[i] *= sa[i]; y0[4 + i] *= sb[i]; y1[4 + i] *= sb[i]; }
                *(LAS u32x4*)(lds + A_XT + e3 * 16384 + sw_off(pp, tg)) = pack8f(y0); *(LAS u32x4*)(lds + A_XT + e3 * 16384 + sw_off(pp + 1, tg)) = pack8f(y1); }
            { if (hg == 0) A_LD_X(itc, 0) else A_LD_X(itc, 1) }
            __syncthreads();
            const int nt = w & 3, pt = w >> 2;
            int clm = tid & 31; asm volatile("" : "+v"(clm));
            const int cl = clm, hi = (tid >> 5) & 1;
            const int xo = (cl & 3) | (((cl >> 3) & 3) << 2);
#pragma unroll
            for (int e3 = 0; e3 < 3; ++e3) {
                f32x16 acc;
#pragma unroll
                for (int r = 0; r < 16; ++r) acc[r] = 0.f;
                const LAS unsigned char* ab = lds + A_BMT + (32 * nt + cl) * 256; const LAS unsigned char* bb = lds + A_XT + e3 * 16384 + (32 * pt + cl) * 256;
#pragma unroll
                for (int ks = 0; ks < 8; ++ks) { const int co = ((2 * ks + hi) ^ xo) << 4;
                    acc = MFMA32(*(const LAS bf16x8*)(ab + co), *(const LAS bf16x8*)(bb + co), acc); }
                const int hd = g * 6 + 3 * hg + e3;
                bf16* dst = P.states + ((((size_t)b * NCHUNK + c) * SSD_H + hd) * SSD_P + 32 * pt + cl) * SSD_N + 32 * nt + 4 * hi;
#pragma unroll
                for (int a = 0; a < 4; ++a) { u32x2 t; t.x = pk2(acc[4 * a], acc[4 * a + 1]); t.y = pk2(acc[4 * a + 2], acc[4 * a + 3]); *(u32x2*)(dst + 8 * a) = t; }
            }
            __syncthreads();
        }
    }
#undef A_DEC
#undef A_LD_DT
#undef A_LD_B
#undef A_LD_X
}
__device__ __forceinline__ void phase_b(const Par& P, int gtid, int gthreads, bool dry = false) {
    for (int it = gtid; it < BATCH * SSD_H * SSD_P * 16; it += gthreads) {
        const int nq = it & 15, p = (it >> 4) & 63, bh = it >> 10, h = bh % SSD_H, b = bh / SSD_H;
        u32x4 v[NCHUNK];
#pragma unroll
        for (int c = 0; c < NCHUNK; ++c) v[c] = *(const u32x4*)(P.states + ((((size_t)b * NCHUNK + c) * SSD_H + h) * SSD_P + p) * SSD_N + 8 * nq);
        float hr[8];
#pragma unroll
        for (int i = 0; i < 8; ++i) hr[i] = 0.f;
#pragma unroll
        for (int c = 0; c < NCHUNK; ++c) {
            const float dec = P.cdec[((size_t)b * NCHUNK + c) * SSD_H + h];
            u32x4 o; o.x = pk2(hr[0], hr[1]); o.y = pk2(hr[2], hr[3]); o.z = pk2(hr[4], hr[5]); o.w = pk2(hr[6], hr[7]);
            if (!dry) *(u32x4*)(P.states + ((((size_t)b * NCHUNK + c) * SSD_H + h) * SSD_P + p) * SSD_N + 8 * nq) = o;
            hr[0] = dec * hr[0] + bflo(v[c].x); hr[1] = dec * hr[1] + bfhi(v[c].x); hr[2] = dec * hr[2] + bflo(v[c].y); hr[3] = dec * hr[3] + bfhi(v[c].y);
            hr[4] = dec * hr[4] + bflo(v[c].z); hr[5] = dec * hr[5] + bfhi(v[c].z); hr[6] = dec * hr[6] + bflo(v[c].w); hr[7] = dec * hr[7] + bfhi(v[c].w);
        }
    }
}
constexpr int C_WT = 141312;
template <int WS>
__device__ __forceinline__ void conv_math_t(const LAS float* wt, int lc, int s0, const unsigned (&r)[11], float (&y0)[8], float (&y1)[8]) {
    float x0[11], x1[11];
#pragma unroll
    for (int j = 0; j < 11; ++j) { x0[j] = bflo(r[j]); x1[j] = bfhi(r[j]); }
    if (s0 == 0) {
#pragma unroll
        for (int j = 0; j < 3; ++j) { x0[j] = 0.f; x1[j] = 0.f; } }
    f32x2 wj[4];
#pragma unroll
    for (int j = 0; j < 4; ++j) wj[j] = *(const LAS f32x2*)(wt + j * WS + lc);
    const f32x2 bb = *(const LAS f32x2*)(wt + 4 * WS + lc);
#pragma unroll
    for (int i = 0; i < 8; ++i) {
        const float a0 = bb.x + wj[0].x * x0[i] + wj[1].x * x0[i + 1] + wj[2].x * x0[i + 2] + wj[3].x * x0[i + 3];
        const float a1 = bb.y + wj[0].y * x1[i] + wj[1].y * x1[i + 1] + wj[2].y * x1[i + 2] + wj[3].y * x1[i + 3];
        y0[i] = silu_f(a0); y1[i] = silu_f(a1); }
}
__device__ __forceinline__ void phase_c(LAS unsigned char* lds, int wv, const Par& P, bf16* projw, int vcu, int NG) {
    const int tid = opaque_tid(wv), w = wv;
    constexpr int NIT = BATCH * NCHUNK * SSD_G;
    unsigned rBC[4][11], rX[2][11], dr0 = 0, dr1 = 0;
#define C_DEC(it_) const int g = (it_) & 3, c = ((it_) >> 2) & 15, b = (it_) >> 6
#define C_LD_DT(it_) { C_DEC(it_); if (w < 6) { const int l_ = tid & 63; const size_t row0 = (size_t)b * SEQ + c * SSD_CH + 2 * l_; dr0 = P.proj[row0 * P1W + P1_DT + g * 6 + w]; dr1 = P.proj[(row0 + 1) * P1W + P1_DT + g * 6 + w]; } }
#define C_LD_BC(it_) { C_DEC(it_); int t_ = tid; asm volatile("" : "+v"(t_)); _Pragma("unroll") for (int j = 0; j < 4; ++j) { const int i2 = t_ + NTHR * j, cp = i2 & 127, tg = i2 >> 7; \
        conv_load(P, b, c * SSD_CH + 8 * tg, SSD_IN + (cp >> 6) * (SSD_G * SSD_N) + g * SSD_N + 2 * (cp & 63), rBC[j]); } }
#define C_LD_X(it_, ei_) { C_DEC(it_); int t_ = tid; asm volatile("" : "+v"(t_)); _Pragma("unroll") for (int j = 0; j < 2; ++j) { const int i2 = t_ + NTHR * j, cp = i2 & 63, tg = i2 >> 6; \
        conv_load(P, b, c * SSD_CH + 8 * tg, (g * 6 + 3 * (cp >> 5) + (ei_)) * SSD_P + 2 * (cp & 31), rX[j]); } }
    int it = vcu, gtab = -1;
    if (it < NIT) { C_LD_DT(it) C_LD_BC(it) C_LD_X(it, 0) }
    const LAS float* wt = (const LAS float*)(lds + C_WT);
#pragma unroll 1
    for (; it < NIT; it += NG) {
        C_DEC(it); const int itc = (it + NG < NIT) ? it + NG : it;
        if (g != gtab) { gtab = g;
#pragma unroll
            for (int q = 0; q < 2; ++q) { const int idx = tid + NTHR * q;
                if (idx < 640) { const int ch = idx < 128 ? SSD_IN + g * SSD_N + idx : idx < 256 ? SSD_IN + SSD_G * SSD_N + g * SSD_N + (idx - 128) : g * 6 * SSD_P + (idx - 256);
#pragma unroll
                    for (int j = 0; j < 4; ++j) ((LAS float*)(lds + C_WT))[j * 640 + idx] = P.conv_w[j * CONV_DIM + ch];
                    ((LAS float*)(lds + C_WT))[4 * 640 + idx] = P.conv_b[ch]; } }
            __syncthreads(); }
        if (w < 6) {
            const int lane = tid & 63, hd = g * 6 + w; const float bias = P.dt_bias[hd], A = -expf(P.a_log[hd]);
            const float x0 = bf2f((unsigned short)dr0) + bias, x1 = bf2f((unsigned short)dr1) + bias;
            const float d0 = x0 > 20.f ? x0 : log1pf(expf(x0)), d1 = x1 > 20.f ? x1 : log1pf(expf(x1));
            const float la0 = d0 * A, la1 = d1 * A; const float s1 = la0 + la1; float v = s1;
#pragma unroll
            for (int off = 1; off < 64; off <<= 1) { const float t = __shfl_up(v, off); if (lane >= off) v += t; }
            LAS float* dt = (LAS float*)(lds + DT_OFF) + w * 128; LAS float* cs = (LAS float*)(lds + CS_OFF) + w * 128;
            dt[2 * lane] = d0; dt[2 * lane + 1] = d1; cs[2 * lane] = v - s1 + la0; cs[2 * lane + 1] = v;
        }
        { int tb = tid; asm volatile("" : "+v"(tb));
#pragma unroll
          for (int j = 0; j < 4; ++j) { const int i2 = tb + NTHR * j, cp = i2 & 127, tg = i2 >> 7; float y0[8], y1[8];
            conv_math_t<640>(wt, 2 * cp, c * SSD_CH + 8 * tg, rBC[j], y0, y1);
            const int img = (cp >> 6) ? C_CM : C_BM, n2 = cp & 63;
#pragma unroll
            for (int i = 0; i < 8; ++i) *(LAS unsigned*)(lds + img + sw_off(8 * tg + i, n2 >> 2) + (n2 & 3) * 4) = pk2(y0[i], y1[i]); } }
        int lv = tid & 63; asm volatile("" : "+v"(lv));
        const int lane = lv, cl = lane & 31, hi = lane >> 5;
        __syncthreads();
    const LAS float* dtl = (const LAS float*)(lds + DT_OFF); const LAS float* csl = (const LAS float*)(lds + CS_OFF);
    const int lt = (w < 4) ? w : 7 - w, hh = w >> 2, l = 32 * lt + cl;
    const int xo = (cl & 3) | (((cl >> 3) & 3) << 2);
    const int pi = (cl & ~0xC) | ((cl & 4) << 1) | ((cl & 8) >> 1), xpi = (pi & 3) | (((pi >> 3) & 3) << 2);
    const LAS unsigned char* cmb = lds + C_CM + l * 256;
#define CF(ks) (*(const LAS bf16x8*)(cmb + (((2 * (ks) + hi) ^ xo) << 4)))
    f32x16 G[4];
#pragma unroll
    for (int st = 0; st < 4; ++st) {
#pragma unroll
        for (int r = 0; r < 16; ++r) G[st][r] = 0.f;
        if (st <= lt) { const LAS unsigned char* ab = lds + C_BM + (32 * st + pi) * 256;
#pragma unroll
            for (int ks = 0; ks < 8; ++ks) G[st] = MFMA32(*(const LAS bf16x8*)(ab + (((2 * ks + hi) ^ xpi) << 4)), CF(ks), G[st]); }
        __builtin_amdgcn_sched_barrier(0);
    }
        float sq = 0.f;
#pragma unroll 1
        for (int ei = 0; ei < 3; ++ei) {
            const int e = 3 * hh + ei, hd = g * 6 + e;
            const float csl_l = csl[e * 128 + l], dsk = P.d_skip[hd] / dtl[e * 128 + l];
            u32x4 zq[4];
            { const bf16* zr = projw + ((size_t)b * SEQ + c * SSD_CH + 32 * lt) * P1W + hd * SSD_P;
#pragma unroll
              for (int i = 0; i < 4; ++i) zq[i] = *(const u32x4*)(zr + (size_t)(8 * i + (lane >> 3)) * P1W + 8 * (lane & 7)); }
            __syncthreads();
            if (c > 0) {
                int tq = tid; asm volatile("" : "+v"(tq));
                const int ln = tq & 63, cs = ln & 15;
#pragma unroll
                for (int q = 0; q < 4; ++q) { const int hb = q >> 1, pc = w + 8 * (q & 1), r = 4 * pc + (ln >> 4);
                    const bf16* sp = P.states + ((((size_t)b * NCHUNK + c) * SSD_H + g * 6 + 3 * hb + ei) * SSD_P + r) * SSD_N + ((cs ^ ((r & 3) | (((r >> 3) & 3) << 2))) << 3);
                    __builtin_amdgcn_global_load_lds((const unsigned*)sp, (LAS unsigned*)(lds + C_BM + hb * 16384 + pc * 1024), 16, 0, 0); }
            }
            { int tx = tid; asm volatile("" : "+v"(tx));
#pragma unroll
              for (int j = 0; j < 2; ++j) { const int i2 = tx + NTHR * j, cp = i2 & 63, tg = i2 >> 6; const int hb = cp >> 5, e2 = 3 * hb + ei, pp = 2 * (cp & 31); float y0[8], y1[8];
                conv_math_t<640>(wt, 256 + e2 * SSD_P + pp, c * SSD_CH + 8 * tg, rX[j], y0, y1);
                const f32x4 sa = *(const LAS f32x4*)(dtl + e2 * 128 + 8 * tg), sb = *(const LAS f32x4*)(dtl + e2 * 128 + 8 * tg + 4);
#pragma unroll
                for (int i = 0; i < 4; ++i) { y0[i] *= sa[i]; y1[i] *= sa[i]; y0[4 + i] *= sb[i]; y1[4 + i] *= sb[i]; }
                *(LAS u32x4*)(lds + C_XT + hb * 16384 + sw_off(pp, tg)) = pack8f(y0); *(LAS u32x4*)(lds + C_XT + hb * 16384 + sw_off(pp + 1, tg)) = pack8f(y1); } }
            VM_WAIT();
            { const int itx = ei < 2 ? it : itc, eix = ei < 2 ? ei + 1 : 0; C_LD_X(itx, eix) }
            __syncthreads();
            f32x16 Y0, Y1;
#pragma unroll
            for (int r = 0; r < 16; ++r) { Y0[r] = 0.f; Y1[r] = 0.f; }
            if (c > 0) {
                const LAS unsigned char* sb0 = lds + C_BM + hh * 16384 + cl * 256; const LAS unsigned char* sb1 = sb0 + 32 * 256;
#pragma unroll
                for (int ks = 0; ks < 8; ++ks) { const bf16x8 cfk = CF(ks); const int co = ((2 * ks + hi) ^ xo) << 4;
                    Y0 = MFMA32(*(const LAS bf16x8*)(sb0 + co), cfk, Y0); Y1 = MFMA32(*(const LAS bf16x8*)(sb1 + co), cfk, Y1); }
                const float el = fast_exp2(csl_l * LOG2E);
                Y0 *= el; Y1 *= el;
            }
            int clv = cl; asm volatile("" : "+v"(clv));
            const LAS unsigned char* xb0 = lds + C_XT + hh * 16384 + cl * 256; const LAS unsigned char* xb1 = xb0 + 32 * 256;
#pragma unroll
            for (int st = 0; st < 4; ++st) {
                if (st <= lt) {
                    float mv[16];
                    const LAS float* cp8 = csl + e * 128 + 32 * st + 8 * hi;
                    const f32x4 c0 = *(const LAS f32x4*)cp8, c1 = *(const LAS f32x4*)(cp8 + 4), c2 = *(const LAS f32x4*)(cp8 + 16), c3 = *(const LAS f32x4*)(cp8 + 20);
#pragma unroll
                    for (int r = 0; r < 16; ++r) {
                        const float cs_s = (r < 4) ? c0[r & 3] : (r < 8) ? c1[r & 3] : (r < 12) ? c2[r & 3] : c3[r & 3];
                        mv[r] = G[st][r] * fast_exp2((csl_l - cs_s) * LOG2E); }
                    if (st == lt) {
#pragma unroll
                        for (int r = 0; r < 16; ++r) { const int sl = (r & 7) + 8 * hi + 16 * (r >> 3);
                            float v = mv[r]; v = (sl <= clv) ? v : 0.f; v = (sl == clv) ? v + dsk : v; mv[r] = v; }
                    }
                    u32x4 t; bf16x8 m0, m1;
                    t.x = pk2(mv[0], mv[1]); t.y = pk2(mv[2], mv[3]); t.z = pk2(mv[4], mv[5]); t.w = pk2(mv[6], mv[7]); m0 = __builtin_bit_cast(bf16x8, t);
                    t.x = pk2(mv[8], mv[9]); t.y = pk2(mv[10], mv[11]); t.z = pk2(mv[12], mv[13]); t.w = pk2(mv[14], mv[15]); m1 = __builtin_bit_cast(bf16x8, t);
                    const int co0 = ((4 * st + hi) ^ xo) << 4, co1 = ((4 * st + 2 + hi) ^ xo) << 4;
                    Y0 = MFMA32(*(const LAS bf16x8*)(xb0 + co0), m0, Y0); Y0 = MFMA32(*(const LAS bf16x8*)(xb0 + co1), m1, Y0);
                    Y1 = MFMA32(*(const LAS bf16x8*)(xb1 + co0), m0, Y1); Y1 = MFMA32(*(const LAS bf16x8*)(xb1 + co1), m1, Y1);
                }
            }
            { LAS unsigned char* zt = lds + zt_base(w);
              bf16* zrow = projw + ((size_t)b * SEQ + c * SSD_CH + 32 * lt) * P1W + hd * SSD_P;
              const int rr = lane >> 3, pc = lane & 7;
#pragma unroll
              for (int i = 0; i < 4; ++i) *(LAS u32x4*)(zt + zt_off(8 * i + rr, pc)) = zq[i];
              LDS_WAIT(); asm volatile("" ::: "memory");
              u32x2 zz0[4], zz1[4];
#pragma unroll
              for (int a = 0; a < 4; ++a) { zz0[a] = *(const LAS u32x2*)(zt + zt_off(cl, a) + 8 * hi); zz1[a] = *(const LAS u32x2*)(zt + zt_off(cl, 4 + a) + 8 * hi); }
              LDS_WAIT(); asm volatile("" ::: "memory");
#pragma unroll
              for (int a = 0; a < 4; ++a) {
                { const u32x2 zz = zz0[a];
                  const float u0 = Y0[4 * a] * silu_f(bflo(zz.x)), u1 = Y0[4 * a + 1] * silu_f(bfhi(zz.x)), u2 = Y0[4 * a + 2] * silu_f(bflo(zz.y)), u3 = Y0[4 * a + 3] * silu_f(bfhi(zz.y));
                  sq += (u0 * u0 + u1 * u1) + (u2 * u2 + u3 * u3); u32x2 t; t.x = pk2(u0, u1); t.y = pk2(u2, u3); *(LAS u32x2*)(zt + zt_off(cl, a) + 8 * hi) = t; }
                { const u32x2 zz = zz1[a];
                  const float u0 = Y1[4 * a] * silu_f(bflo(zz.x)), u1 = Y1[4 * a + 1] * silu_f(bfhi(zz.x)), u2 = Y1[4 * a + 2] * silu_f(bflo(zz.y)), u3 = Y1[4 * a + 3] * silu_f(bfhi(zz.y));
                  sq += (u0 * u0 + u1 * u1) + (u2 * u2 + u3 * u3); u32x2 t; t.x = pk2(u0, u1); t.y = pk2(u2, u3); *(LAS u32x2*)(zt + zt_off(cl, 4 + a) + 8 * hi) = t; }
              }
              LDS_WAIT(); asm volatile("" ::: "memory");
#pragma unroll
              for (int i = 0; i < 4; ++i) { const u32x4 uq = *(const LAS u32x4*)(zt + zt_off(8 * i + rr, pc)); *(u32x4*)(zrow + (size_t)(8 * i + rr) * P1W + 8 * pc) = uq; }
              LDS_WAIT(); asm volatile("" ::: "memory");
            }
    }
LAS float* ssp = (LAS float*)(lds + SSP_OFF);
    ssp[l * 4 + hh * 2 + hi] = sq;
        { C_LD_DT(itc) C_LD_BC(itc) }
    __syncthreads();
    { const int rr = lane >> 3, pc = lane & 7;
#pragma unroll
      for (int ei = 0; ei < 3; ++ei) { const int hd = g * 6 + 3 * hh + ei;
            bf16* zrow = projw + ((size_t)b * SEQ + c * SSD_CH + 32 * lt) * P1W + hd * SSD_P;
            const f32x4 g0 = *(const f32x4*)(P.g_out + hd * SSD_P + 8 * pc), g1 = *(const f32x4*)(P.g_out + hd * SSD_P + 8 * pc + 4);
#pragma unroll
            for (int i = 0; i < 4; ++i) { const int lr = 32 * lt + 8 * i + rr;
                const f32x4 s4 = *(const LAS f32x4*)(ssp + lr * 4); const float rs = 1.0f / sqrtf(((s4.x + s4.y) + (s4.z + s4.w)) * (1.0f / 384.0f) + EPS);
                u32x4* up = (u32x4*)(zrow + (size_t)(8 * i + rr) * P1W + 8 * pc);
                const u32x4 uv = *up;
                u32x4 t; t.x = pk2(bflo(uv.x) * rs * g0[0], bfhi(uv.x) * rs * g0[1]); t.y = pk2(bflo(uv.y) * rs * g0[2], bfhi(uv.y) * rs * g0[3]);
                t.z = pk2(bflo(uv.z) * rs * g1[0], bfhi(uv.z) * rs * g1[1]); t.w = pk2(bflo(uv.w) * rs * g1[2], bfhi(uv.w) * rs * g1[3]);
                *up = t; } } }
    __syncthreads();
    }
#undef CF
#undef C_DEC
#undef C_LD_DT
#undef C_LD_BC
#undef C_LD_X
}
}

constexpr size_t WS_MEMRS = 4 * MiB + 256 * 1024;
constexpr size_t WS_RS0 = 4 * MiB + 512 * 1024;
constexpr int N_PHASES = 15;

struct MoeOrder {
    pg8::StaticOrder so; const LAS int* pan; int npn;
    __device__ __forceinline__ bool next(int i, Unit& u) const { if (!so.next(i, u)) return false; u.pn = ((pan[u.pm] >> 16) & 7) * npn + u.pn; return true; }
};
struct MoeOrderSplit {
    pg8::StaticOrder so; const LAS int* pan; int npn;
    __device__ __forceinline__ int nfull() const { return (so.nwg / so.G) * so.G; }
    __device__ __forceinline__ int nsl() const { const int t = so.nwg - nfull(); return (t * 7 <= so.G) ? 7 : ((t * 2 <= so.G) ? 2 : 1); }
    __device__ __forceinline__ int ntail() const { const int t = so.nwg - nfull(); return nsl() > 1 ? t : 0; }
    __device__ __forceinline__ bool next(int i, Unit& u) const {
        const int L = i * so.G + so.c, nf = nfull(), nt = ntail(), ns = nsl();
        if (nt == 0 || L < nf) { if (L >= so.nwg) return false; so.decode(L, u); u.kt0 = 0; u.nkt = MOE_NKT; u.ti = -1; }
        else { const int s = L - nf; if (s >= nt * ns) return false; so.decode(nf + s / ns, u); u.kt0 = (s % ns) * (MOE_NKT / ns); u.nkt = MOE_NKT / ns; u.ti = s / ns; }
        u.ui = i; u.pn = ((pan[u.pm] >> 16) & 7) * npn + u.pn; return true;
    }
};

__device__ __forceinline__ void row_to_bf16(const float* xrow, bf16* orow, float* ss16, float* rs1, int lane) {
    const GAS f32x4* xr = (const GAS f32x4*)xrow + lane;
    f32x4 v[4]; float s = 0.f;
#pragma unroll
    for (int j = 0; j < 4; ++j) { v[j] = xr[64 * j]; s += (v[j].x * v[j].x + v[j].y * v[j].y) + (v[j].z * v[j].z + v[j].w * v[j].w); }
    s = wave_sum(s);
    GAS unsigned long long* o8 = (GAS unsigned long long*)orow + lane;
#pragma unroll
    for (int j = 0; j < 4; ++j) o8[64 * j] = (unsigned long long)pk2(v[j].x, v[j].y) | ((unsigned long long)pk2(v[j].z, v[j].w) << 32);
    if (lane < 16) ss16[lane] = (lane == 0) ? s : 0.f;
    if (lane == 0) *rs1 = 1.0f / sqrtf(s * (1.0f / 1024.0f) + EPS);
}

__global__ void __launch_bounds__(NTHR, 2) fwd_kernel(Args args_unused) {
#define args (*kargs())
    extern __shared__ __attribute__((aligned(16))) unsigned char lds_raw[];
    LAS unsigned char* lds = (LAS unsigned char*)lds_raw;
    const int wave = __builtin_amdgcn_readfirstlane((int)threadIdx.x >> 6);
#define tid (opaque_tid(wave))
#define lane (opaque_tid(wave) & 63)
    const int G = gridDim.x, bx = blockIdx.x;
    const int vcu = (G % 8 == 0) ? (bx % 8) * (G / 8) + bx / 8 : bx;
    unsigned char* ws = args.ws;
    gu32* ctl = (gu32*)(ws + WS_CTL);
    for (int u = tid; u < 256; u += NTHR) ((LAS unsigned*)(lds + MISC_OFF))[u] = 0u;
    __syncthreads();
    XcdBarrier bar = xcd_barrier_post((unsigned*)(ctl + CW_BAR), (volatile LAS unsigned*)(lds + MISC_OFF) + 8);
    const int lo = args.ph_lo, hi = args.ph_hi;
#ifndef ONLY_PHASE
#define ONLY_PHASE -1
#endif
#define IN(k) ((ONLY_PHASE < 0 || (k) == ONLY_PHASE) && lo <= (k) && (k) < hi)
#define SEAM(k) do { if (IN(k) && IN((k) + 1)) xcd_barrier(bar); } while (0)

    const float* x_in = args.in[0]; float* out = args.out;
    bf16* XB = (bf16*)(ws + WS_XB); float* SS = (float*)(ws + WS_SS); bf16* PROJ = (bf16*)(ws + WS_PROJ);
    float* KMEAN = (float*)(ws + WS_KMEAN);
    const LAS unsigned short* rowtab = (const LAS unsigned short*)(lds + ROWTAB_OFF);
    LAS int* pan = (LAS int*)(lds + PAN_OFF);

    constexpr int NDN_ALL = NEXP * (FF / 64) * (1024 / 32);
    const int wed_pre1 = (G == 256) ? 9216 : 0, wed_pre = (G == 256) ? NDN_ALL : 0;
#define CVT_WED_RANGE(lo_, hi_) { LAS float* scr = (LAS float*)(lds + wave * 16384); const int per_ = ((hi_) - (lo_) + NWAVES - 1) / NWAVES; \
        const int b0_ = (lo_) + wave * per_; const int cvt_end = (b0_ + per_ < (hi_)) ? b0_ + per_ : (hi_); \
        for (int it = b0_; it < cvt_end;) { const int e = it / ((FF / 64) * (1024 / 32)); int r = it % ((FF / 64) * (1024 / 32)); CVT_DECL() \
            CVT_JOB8(args.in[23] + (size_t)e * FF * 1024, nullptr, nullptr, ws + WS_WED + (size_t)e * 1024 * FF, 1024, FF, 1024, 0, 0, 1024, F8_SW2) \
            CVT_RUN(it, cvt_end); } \
        __syncthreads(); }
    if (IN(0)) {
        LAS float* scr = (LAS float*)(lds + wave * 16384);
        const int gw = vcu * NWAVES + wave, NGW = G * NWAVES;
        const float *g_mix = args.in[2], *g_mem = args.in[3], *w_moba = args.in[4], *w_ssd = args.in[5], *w_kv = args.in[6], *w_out = args.in[7], *g_ffn = args.in[15];
        constexpr int NIT = (1024 / 64) * ((3584 + 1536 + 4864 + 1024 + 1024 + 7168) / 32) + (2048 / 64) * (2048 / 32) + (3584 / 64) * (1024 / 32);
        const int cvt_c = (NIT + NGW - 1) / NGW, cvt_end = (gw + 1) * cvt_c < NIT ? (gw + 1) * cvt_c : NIT;
        for (int it = gw * cvt_c; it < cvt_end;) {
            int r = it; CVT_DECL()
            CVT_JOB(w_moba, nullptr, g_mix, (bf16*)(ws + WS_WM1), IN_MOBA, 1024, 1536, 0, 0, 1536)
            CVT_JOB(w_moba, nullptr, g_mix, (bf16*)(ws + WS_WM1) + (size_t)1536 * 1024, IN_MOBA, 1024, 512, 4608, 0, 512)
            CVT_JOB(w_moba, nullptr, g_mix, (bf16*)(ws + WS_WM1) + (size_t)2048 * 1024, IN_MOBA, 1024, 1536, 1536, 0, 1536)
            CVT_JOB(w_moba, nullptr, g_mix, (bf16*)(ws + WS_WV), IN_MOBA, 1024, 1536, 3072, 0, 1536)
            CVT_JOB(w_ssd, nullptr, g_mix + D, (bf16*)(ws + WS_WS), IN_SSD, 1024, 1536, 0, 0, 1536)
            CVT_JOB(w_ssd, nullptr, g_mix + D, (bf16*)(ws + WS_WS) + (size_t)1536 * 1024, IN_SSD, 1024, 512, 4120, 0, 512)
            CVT_JOB(w_ssd, nullptr, g_mix + D, (bf16*)(ws + WS_WS) + (size_t)2048 * 1024, IN_SSD, 1024, 2560, 1536, 0, 2560)
            CVT_JOB(w_ssd, nullptr, g_mix + D, (bf16*)(ws + WS_WS) + (size_t)4608 * 1024, IN_SSD, 1024, 256, 4096, 0, 24)
            CVT_JOB(w_kv, nullptr, g_mem, (bf16*)(ws + WS_WMK), 1024, 1024, 512, 0, 0, 512)
            CVT_JOB(w_kv + (size_t)1024 * 1024, nullptr, g_mem + D, (bf16*)(ws + WS_WMK) + (size_t)512 * 1024, 1024, 1024, 512, 0, 0, 512)
            CVT_JOB(w_kv, nullptr, g_mem, (bf16*)(ws + WS_WMV), 1024, 1024, 512, 512, 0, 512)
            CVT_JOB(w_kv + (size_t)1024 * 1024, nullptr, g_mem + D, (bf16*)(ws + WS_WMV) + (size_t)512 * 1024, 1024, 1024, 512, 512, 0, 512)
            CVT_JOB(args.in[16], args.in[17], g_ffn, (bf16*)(ws + WS_WGU), FF, 1024, 7168, 0, 1, 7168)
            CVT_JOB(w_out, nullptr, nullptr, (bf16*)(ws + WS_WO), 1024, 2048, 1024, 0, 0, 1024)
            CVT_JOB(w_out + (size_t)2048 * 1024, nullptr, nullptr, (bf16*)(ws + WS_WO) + (size_t)1024 * 2048, 1024, 2048, 1024, 0, 0, 1024)
            CVT_JOB(args.in[18], nullptr, nullptr, (bf16*)(ws + WS_WD), 1024, FF, 1024, 0, 0, 1024)
            CVT_RUN(it, cvt_end);
        }
        for (int m = gw; m < T; m += NGW) row_to_bf16(x_in + (size_t)m * D, XB + (size_t)m * D, SS + (size_t)m * 16, (float*)(ws + WS_RS0) + m, lane);
        for (int m = gw; m < MROWS; m += NGW) row_to_bf16(args.in[1] + (size_t)m * D, (bf16*)(ws + WS_MEMB) + (size_t)m * D, (float*)(ws + WS_MEMSS) + (size_t)m * 16, (float*)(ws + WS_MEMRS) + m, lane);
        __syncthreads();
    }
    SEAM(0);
    if (IN(1)) {
        { pg8::Gemm g{XB, (const bf16*)(ws + WS_WM1), D, D}; pg8::StaticOrder S; S.init(T / 256, P0W / 256, G, bx);
          EpiScale E{PROJ, P0W, SS, KMEAN, 2048, 0, 8};
          pg8::gemm_phase<EpiScale, pg8::StaticOrder, false>(lds, g, S, E, rowtab, wave); }
        { pg8::Gemm g{(const bf16*)(ws + WS_WV), XB, D, D}; pg8::StaticOrder S; S.init(MOBA_W / 256, T / 256, G, bx);
          EpiVT E{(bf16*)(ws + WS_VT), T, (const float*)(ws + WS_RS0)};
          pg8::gemm_phase<EpiVT, pg8::StaticOrder, false>(lds, g, S, E, rowtab, wave); }
        { pg8::Gemm g{(const bf16*)(ws + WS_MEMB), (const bf16*)(ws + WS_WMK), D, D}; pg8::StaticOrder S; S.init(MROWS / 256, 2, G, bx);
          EpiScale E{(bf16*)(ws + WS_KMEM), 1024, (const float*)(ws + WS_MEMSS), nullptr, 0, 0, 0};
          pg8::gemm_phase<EpiScale, pg8::StaticOrder, false>(lds, g, S, E, rowtab, wave); }
        { pg8::Gemm g{(const bf16*)(ws + WS_WMV), (const bf16*)(ws + WS_MEMB), D, D}; pg8::StaticOrder S; S.init(2, MROWS / 256, G, (bx + G - 32) % G);
          EpiVT E{(bf16*)(ws + WS_VMEMT), MROWS, (const float*)(ws + WS_MEMRS)};
          pg8::gemm_phase<EpiVT, pg8::StaticOrder, false>(lds, g, S, E, rowtab, wave); }
        if (wed_pre1 > 0 && bx >= 64) { const int lo = (bx - 64) * 48; CVT_WED_RANGE(lo, lo + 48) }
    }
    SEAM(1);
    if (IN(2)) { const bool dry = false;
        for (int it = vcu; it < BATCH * MOBA_H * 4; it += G) {
            const int bh = it >> 2, pr = it & 3, b = bh / MOBA_H, h = bh % MOBA_H;
#pragma unroll 1
            for (int half = 0; half < 2; ++half) { const int n = half ? pr : 7 - pr;
                att::attn_unit<true>(lds, wave, PROJ + ((size_t)b * SEQ + 256 * n) * P0W + h * HD, P0W, PROJ + ((size_t)b * SEQ) * P0W + 2048 + h * HD, P0W,
                                     (const bf16*)(ws + WS_VT) + (size_t)(h * HD) * T + (size_t)b * SEQ, T, 4 * (n + 1), n, KMEAN + (size_t)(b * NBLK) * MOBA_W + h * HD, args.in[8], h, dry); }
        }
        for (int it = vcu; it < BATCH * MEM_H * 8; it += G) {
            const int b = it >> 5, mh = (it >> 3) & 3, qt = it & 7;
            att::attn_unit<false>(lds, wave, PROJ + ((size_t)b * SEQ + 256 * qt) * P0W + 1536 + mh * HD, P0W, (const bf16*)(ws + WS_KMEM) + ((size_t)b * MEM_LEN) * 1024 + mh * HD, 1024,
                                  (const bf16*)(ws + WS_VMEMT) + (size_t)(mh * HD) * MROWS + b * MEM_LEN, MROWS, 4, 0, nullptr, nullptr, 0, dry);
        }
    }
    SEAM(2);
    if (IN(3)) {
        pg8::Gemm g{PROJ, (const bf16*)(ws + WS_WO), P0W, MIXW}; pg8::StaticOrder S; S.init(T / 256, 4, G, bx);
        EpiResid<false, true, false> E{nullptr, nullptr, XB, SS, nullptr};
        pg8::gemm_phase<EpiResid<false, true, false>, pg8::StaticOrder, false>(lds, g, S, E, rowtab, wave);
    }
    SEAM(3);
    if (IN(4)) {
        pg8::Gemm g{XB, (const bf16*)(ws + WS_WGU), D, D}; pg8::StaticOrder S; S.init(T / 256, 28, G, bx);
        EpiGateUp<false> E{(bf16*)(ws + WS_ACT), SS, rowtab};
        pg8::gemm_phase<EpiGateUp<false>, pg8::StaticOrder, false>(lds, g, S, E, rowtab, wave);
    }
    SEAM(4);
    if (IN(5)) {
        pg8::Gemm g{(const bf16*)(ws + WS_ACT), (const bf16*)(ws + WS_WD), FF, FF}; pg8::StaticOrder S; S.init(T / 256, 4, G, bx);
        EpiResid<false, true, false> E{nullptr, nullptr, XB, SS, nullptr};
        pg8::gemm_phase<EpiResid<false, true, false>, pg8::StaticOrder, false>(lds, g, S, E, rowtab, wave);
    }
    SEAM(5);
    if (IN(6)) {
        pg8::Gemm g{XB, (const bf16*)(ws + WS_WS), D, D}; pg8::StaticOrder S; S.init(T / 256, P1W / 256, G, bx);
        EpiScale E{PROJ, P1W, SS, nullptr, 0, 6, 8};
        pg8::gemm_phase<EpiScale, pg8::StaticOrder, false>(lds, g, S, E, rowtab, wave);
        { pg8::Gemm g2{(const bf16*)(ws + WS_MEMB), (const bf16*)(ws + WS_WMK) + (size_t)512 * 1024, D, D}; pg8::StaticOrder S2; S2.init(MROWS / 256, 2, G, (bx + G - 128) % G);
          EpiScale E2{(bf16*)(ws + WS_KMEM) + 512, 1024, (const float*)(ws + WS_MEMSS), nullptr, 0, 0, 0};
          pg8::gemm_phase<EpiScale, pg8::StaticOrder, false>(lds, g2, S2, E2, rowtab, wave); }
        { pg8::Gemm g2{(const bf16*)(ws + WS_WMV) + (size_t)512 * 1024, (const bf16*)(ws + WS_MEMB), D, D}; pg8::StaticOrder S2; S2.init(2, MROWS / 256, G, (bx + G - 160) % G);
          EpiVT E2{(bf16*)(ws + WS_VMEMT) + (size_t)512 * MROWS, MROWS, (const float*)(ws + WS_MEMRS)};
          pg8::gemm_phase<EpiVT, pg8::StaticOrder, false>(lds, g2, S2, E2, rowtab, wave); }
        if (wed_pre > wed_pre1 && bx >= 192) { const int lo = wed_pre1 + (bx - 192) * 80; CVT_WED_RANGE(lo, lo + 80) }
    }
    SEAM(6);
    const ssd::Par SP{PROJ, args.in[9], args.in[10], args.in[11], args.in[12], args.in[13], args.in[14], (bf16*)(ws + WS_STATES), (float*)(ws + WS_CDEC)};
    if (IN(7)) { const bool dry = false;
        ssd::phase_a(lds, wave, SP, vcu, G);
        for (int it = vcu; it < BATCH * MEM_H * 8; it += G) {
            const int b = it >> 5, mh = (it >> 3) & 3, qt = it & 7;
            att::attn_unit<false>(lds, wave, PROJ + ((size_t)b * SEQ + 256 * qt) * P1W + 1536 + mh * HD, P1W, (const bf16*)(ws + WS_KMEM) + ((size_t)b * MEM_LEN) * 1024 + 512 + mh * HD, 1024,
                                  (const bf16*)(ws + WS_VMEMT) + (size_t)(512 + mh * HD) * MROWS + b * MEM_LEN, MROWS, 4, 0, nullptr, nullptr, 0, dry);
        }
    }
    SEAM(7);
    if (IN(8)) { ssd::phase_b(SP, bx * NTHR + tid, G * NTHR); }
    SEAM(8);
    if (IN(9)) {
        ssd::phase_c(lds, wave, SP, PROJ, vcu, G);
    }
    SEAM(9);
    if (IN(10)) {
        pg8::Gemm g{PROJ, (const bf16*)(ws + WS_WO) + (size_t)1024 * 2048, P1W, MIXW}; pg8::StaticOrder S; S.init(T / 256, 4, G, bx);
        EpiResid<true, true, false> E{nullptr, nullptr, XB, SS, ws + WS_XB8};
        pg8::gemm_phase<EpiResid<true, true, false>, pg8::StaticOrder, false>(lds, g, S, E, rowtab, wave);
    }
    SEAM(10);
    float* GW = (float*)(ws + WS_GW); int* LIST = (int*)(ws + WS_LIST);
    if (IN(11)) {
        LAS int* e1s = (LAS int*)lds; LAS int* e2s = e1s + 128; LAS int* lr0 = e1s + 256; LAS int* lr1 = e1s + 384; LAS int* basel = e1s + 512;
        const float* wr = args.in[19]; const float* br = args.in[20]; const float* gf = args.in[15] + D;
        f32x4 wa[16], wb[16];
#pragma unroll
        for (int j = 0; j < 4; ++j)
#pragma unroll
            for (int q = 0; q < 4; ++q) { const int k = 256 * j + 4 * lane + q; const float gk = gf[k];
                wa[4 * j + q] = *(const f32x4*)(wr + (size_t)k * 8) * gk; wb[4 * j + q] = *(const f32x4*)(wr + (size_t)k * 8 + 4) * gk; }
        const f32x4 ba = *(const f32x4*)br, bb = *(const f32x4*)(br + 4);
        for (int blk = bx; blk < T / 128; blk += G) {
#pragma unroll 1
            for (int i = 0; i < 16; ++i) {
                const int tl = wave * 16 + i, row = blk * 128 + tl;
                const GAS u32x2* xr = (const GAS u32x2*)(XB + (size_t)row * D) + lane;
                f32x4 a0 = {0.f, 0.f, 0.f, 0.f}, a1 = {0.f, 0.f, 0.f, 0.f}; float s = 0.f;
#pragma unroll
                for (int j = 0; j < 4; ++j) { const u32x2 xw = xr[64 * j]; const f32x4 v = {bflo(xw.x), bfhi(xw.x), bflo(xw.y), bfhi(xw.y)}; s += (v.x * v.x + v.y * v.y) + (v.z * v.z + v.w * v.w);
                    a0 += wa[4 * j] * v.x + wa[4 * j + 1] * v.y + wa[4 * j + 2] * v.z + wa[4 * j + 3] * v.w;
                    a1 += wb[4 * j] * v.x + wb[4 * j + 1] * v.y + wb[4 * j + 2] * v.z + wb[4 * j + 3] * v.w; }
                s = wave_sum(s); const float rs = 1.0f / sqrtf(s * (1.0f / 1024.0f) + EPS);
                float lg[8];
#pragma unroll
                for (int e = 0; e < 4; ++e) { lg[e] = wave_sum(a0[e]) * rs + ba[e]; lg[4 + e] = wave_sum(a1[e]) * rs + bb[e]; }
                int i1 = 0; float l1 = lg[0];
#pragma unroll
                for (int e = 1; e < 8; ++e) if (lg[e] > l1) { l1 = lg[e]; i1 = e; }
                int i2 = -1; float l2 = -__builtin_inff();
#pragma unroll
                for (int e = 0; e < 8; ++e) if (e != i1 && lg[e] > l2) { l2 = lg[e]; i2 = e; }
                const float w1 = 1.0f / (1.0f + expf(l2 - l1));
                if (lane == 0) { e1s[tl] = i1; e2s[tl] = i2; GW[(size_t)row * 2] = w1; GW[(size_t)row * 2 + 1] = 1.0f - w1; ((float*)(ws + WS_RSG))[row] = rs; }
            }
            __syncthreads();
            if (tid < 16) { const int k = tid >> 3, e = tid & 7; int cnt = 0;
                for (int t = 0; t < 128; ++t) { const int ee = k ? e2s[t] : e1s[t]; if (ee == e) { if (k) lr1[t] = cnt; else lr0[t] = cnt; ++cnt; } }
                basel[tid] = (int)__hip_atomic_fetch_add((unsigned*)(ctl + CW_CNT + 64 * tid), (unsigned)cnt, __ATOMIC_RELAXED, __HIP_MEMORY_SCOPE_AGENT); }
            __syncthreads();
            if (tid < 256) { const int k = tid >> 7, t = tid & 127, e = k ? e2s[t] : e1s[t], pos = basel[k * 8 + e] + (k ? lr1[t] : lr0[t]);
                LIST[(size_t)(k * 8 + e) * MOE_CAP + pos] = blk * 128 + t; }
            __syncthreads();
        }
        LAS float* scr = (LAS float*)(lds + 4096 + wave * 16384);
        const int gw = vcu * NWAVES + wave, NGW = G * NWAVES;
        const float* gf1 = args.in[15] + D;
        constexpr int NGU = (1024 / 64) * (7168 / 32), NDN = (FF / 64) * (1024 / 32);
        const int NITE = NEXP * NGU + (NDN_ALL - wed_pre);
        const int cvt_c = ((NITE + NGW - 1) / NGW), cvt_end = (gw + 1) * cvt_c < NITE ? (gw + 1) * cvt_c : NITE;
        for (int it = gw * cvt_c; it < cvt_end;) {
            CVT_DECL()
            int r;
            if (it < NEXP * NGU) { const int e = it / NGU; r = it % NGU;
                CVT_JOB8(args.in[21] + (size_t)e * 1024 * FF, args.in[22] + (size_t)e * 1024 * FF, gf1, ws + WS_WEGU + (size_t)e * 7168 * 1024, FF, 1024, 7168, 0, 1, 7168, F8_SW1) }
            else { const int iw = wed_pre + (it - NEXP * NGU), e = iw / NDN; r = iw % NDN;
                CVT_JOB8(args.in[23] + (size_t)e * FF * 1024, nullptr, nullptr, ws + WS_WED + (size_t)e * 1024 * FF, 1024, FF, 1024, 0, 0, 1024, F8_SW2) }
            CVT_RUN(it, cvt_end);
        }
        __syncthreads();
    }
    SEAM(11);
#define MOE_TABLES() \
        if (tid < 16) pan[288 + tid] = (int)__hip_atomic_load((unsigned*)(ctl + CW_CNT + 64 * tid), __ATOMIC_RELAXED, __HIP_MEMORY_SCOPE_AGENT); \
        __syncthreads(); \
        int cum[17]; cum[0] = 0; \
        _Pragma("unroll") for (int q = 0; q < 16; ++q) cum[q + 1] = cum[q] + ((pan[288 + q] + 255) >> 8); \
        const int NP = cum[16]; \
        { const int p_ = tid; if (p_ < NP) { int gi = 0; \
            _Pragma("unroll") for (int q = 1; q < 16; ++q) gi += (p_ >= cum[q]) ? 1 : 0; \
            int cg = 0; \
            _Pragma("unroll") for (int q = 0; q < 16; ++q) cg = (q == gi) ? cum[q] : cg; \
            pan[p_] = (gi << 16) | (p_ - cg); } } \
        __syncthreads();
#define MOE_ROWTAB(S) { Unit u; LAS unsigned short* rt = (LAS unsigned short*)(lds + ROWTAB_OFF); \
        for (int i = 0; i < 32 && S.next(i, u); ++i) { const int t_ = tid; \
            if (t_ < 256) { const int gi = pan[u.pm] >> 16, off = (pan[u.pm] & 0xffff) * 256 + t_; rt[u.ui * 256 + t_] = (unsigned short)((off < pan[288 + gi]) ? LIST[(size_t)gi * MOE_CAP + off] : 0xFFFF); } } } \
        __syncthreads();
    if (IN(12)) {
        MOE_TABLES()
        MoeOrder S; S.so.init(NP, 28, G, bx); S.pan = pan; S.npn = 28;
        MOE_ROWTAB(S)
        int kdim = D; asm volatile("" : "+s"(kdim));
        pg8::Gemm g{(const bf16*)(ws + WS_XB8), (const bf16*)(ws + WS_WEGU), D, kdim};
        EpiGateUp<true> E{(bf16*)(ws + WS_ACTM), nullptr, rowtab};
        pg8::gemm_phase<EpiGateUp<true>, MoeOrder, true, false, 1>(lds, g, S, E, rowtab, wave);
    }
    SEAM(12);
    if (IN(13)) {
        MOE_TABLES()
        MoeOrderSplit S; S.so.init(NP, 4, G, bx); S.pan = pan; S.npn = 4;
        MOE_ROWTAB(S)
        pg8::Gemm g{(const bf16*)(ws + WS_ACTM), (const bf16*)(ws + WS_WED), FF, FF};
        float* mscr = (float*)(ws + WS_WM1);
        bf16* yp0 = (bf16*)(ws + WS_YP0);
        const int nsl = S.nsl();
        EpiMoeDown E{yp0, (unsigned)((WS_YP1 - WS_YP0) / 2), GW, pan, rowtab, mscr, nsl};
        pg8::gemm_phase<EpiMoeDown, MoeOrderSplit, false, true, 1>(lds, g, S, E, rowtab, wave);
        const int ntl = S.ntail();
        if (ntl > 0) { xcd_barrier(bar);
            const int gw = vcu * NWAVES + wave, NGW = G * NWAVES, nf = S.nfull();
            for (int ri = gw; ri < ntl * 256; ri += NGW) { const int ti = ri >> 8, r = ri & 255; Unit u; S.so.decode(nf + ti, u);
                const int gi = pan[u.pm] >> 16, k = gi >> 3, off = (pan[u.pm] & 0xffff) * 256 + r;
                if (off < pan[288 + gi]) { const int tok = LIST[(size_t)gi * MOE_CAP + off]; const float w = GW[(size_t)tok * 2 + k] * (1.0f / (F8_SH * F8_SW2));
                    const float* sp = mscr + (size_t)(ti * nsl) * 65536 + r * 256 + 4 * lane; f32x4 a = *(const f32x4*)sp;
                    for (int q = 1; q < nsl; ++q) a += *(const f32x4*)(sp + (size_t)q * 65536);
                    a = a * w; u32x2 t2; t2.x = pk2(a[0], a[1]); t2.y = pk2(a[2], a[3]); *(u32x2*)(yp0 + (size_t)k * ((WS_YP1 - WS_YP0) / 2) + (size_t)tok * D + u.pn * 256 + 4 * lane) = t2; } } }
    }
    SEAM(13);
    if (IN(14)) {
        const int gw = vcu * NWAVES + wave, NGW = G * NWAVES;
        f32x4 gfin[4];
#pragma unroll
        for (int j = 0; j < 4; ++j) gfin[j] = *((const f32x4*)args.in[24] + lane + 64 * j);
        for (int m = gw; m < T; m += NGW) {
            const int ln = lane;
            GAS f32x4* xr = (GAS f32x4*)(out + (size_t)m * D) + ln; f32x4 v[4]; float s = 0.f;
            const GAS u32x2* xs = (const GAS u32x2*)(XB + (size_t)m * D) + ln;
            const GAS u32x2* y0 = (const GAS u32x2*)(ws + WS_YP0 + (size_t)m * D * 2) + ln; const GAS u32x2* y1 = (const GAS u32x2*)(ws + WS_YP1 + (size_t)m * D * 2) + ln;
#pragma unroll
            for (int j = 0; j < 4; ++j) { const u32x2 xw = xs[64 * j]; v[j] = (f32x4){bflo(xw.x), bfhi(xw.x), bflo(xw.y), bfhi(xw.y)}; const u32x2 a = y0[64 * j], b = y1[64 * j];
                v[j].x += bflo(a.x) + bflo(b.x); v[j].y += bfhi(a.x) + bfhi(b.x); v[j].z += bflo(a.y) + bflo(b.y); v[j].w += bfhi(a.y) + bfhi(b.y);
                s += (v[j].x * v[j].x + v[j].y * v[j].y) + (v[j].z * v[j].z + v[j].w * v[j].w); }
            s = wave_sum(s); const float rs = 1.0f / sqrtf(s * (1.0f / 1024.0f) + EPS);
#pragma unroll
            for (int j = 0; j < 4; ++j) xr[64 * j] = v[j] * rs * gfin[j];
        }
    }
#undef IN
#undef SEAM
#undef tid
#undef lane
#undef args
}

extern "C" void kernel_launch(void* const* d_in, const int* in_sizes, int n_in, void* d_out, int out_size, void* d_ws, size_t ws_size, hipStream_t stream) {
    static int grid = 0;
    if (grid == 0) {
        if (n_in != 25 || in_sizes[0] != T * D || out_size != T * D || ws_size < WS_END) { fprintf(stderr, "kernel_launch: unexpected shapes / workspace (n_in %d, ws %zu); nothing launched\n", n_in, ws_size); grid = -1; return; }
        int dev = 0, cus = 0, per_cu = 0;
        if (hipGetDevice(&dev) != hipSuccess || hipDeviceGetAttribute(&cus, hipDeviceAttributeMultiprocessorCount, dev) != hipSuccess) { grid = -1; return; }
        if (hipFuncSetAttribute((const void*)fwd_kernel, hipFuncAttributeMaxDynamicSharedMemorySize, LDS_BYTES) != hipSuccess) { fprintf(stderr, "kernel_launch: hipFuncSetAttribute failed\n"); grid = -1; return; }
        if (hipOccupancyMaxActiveBlocksPerMultiprocessor(&per_cu, (const void*)fwd_kernel, NTHR, LDS_BYTES) != hipSuccess || per_cu < 1) { fprintf(stderr, "kernel_launch: occupancy query says %d\n", per_cu); }
        (void)hipGetLastError();
        grid = cus;
    }
    if (grid < 0) return;
    if (hipMemsetAsync((char*)d_ws, 0, ZERO_BYTES, stream) != hipSuccess) return;
    Args a{};
    for (int i = 0; i < 25; ++i) a.in[i] = (const float*)d_in[i];
    a.out = (float*)d_out; a.ws = (unsigned char*)d_ws;
    a.ph_lo = 0; a.ph_hi = N_PHASES;
    hipLaunchKernelGGL(fwd_kernel, dim3(grid), dim3(NTHR), LDS_BYTES, stream, a);
}
```
